# Optimizing an MI355X kernel written in HIP

```python
import math
import jax, jax.numpy as jnp
from jax import lax
import numpy as np

D_MODEL = 1024
BATCH = 4
SEQ = 4096
DEPTH = 1

GRID_W = 64
D_A = D_MODEL
A_BLOCKS = 16
A_BW = D_A // A_BLOCKS
CONV_W = 4
RG_C = 8.0
N_HEADS = 16
HEAD_DIM = 64
D_B = N_HEADS * HEAD_DIM
WIN_R = 8
WIN_C = 16
IN_SPLITS = (D_A, D_A, D_B, D_B, D_B, D_B, D_MODEL, D_MODEL)
IN_COLS = sum(IN_SPLITS)
EPS = 1e-6

kernel_name = "hybrid_rglru_natten_gated_encoder"


def rms_norm(x, g):
    x32 = x.astype(jnp.float32)
    y = x32 * lax.rsqrt(jnp.mean(x32 * x32, axis=-1, keepdims=True) + EPS)
    return (y * g.astype(jnp.float32)).astype(x.dtype)


def block_diag(x, w, b):
    B, S, C = x.shape
    xr = x.reshape(B, S, A_BLOCKS, A_BW)
    return jnp.einsum('bshi,hij->bshj', xr, w).reshape(B, S, C) + b


def centred_dwconv(x, w, b):
    C = x.shape[-1]
    y = lax.conv_general_dilated(
        x, w[:, None, :].astype(x.dtype), window_strides=(1,),
        padding=[(CONV_W // 2, CONV_W - 1 - CONV_W // 2)],
        dimension_numbers=('NWC', 'WIO', 'NWC'), feature_group_count=C)
    return y + b


def _lin_combine(e1, e2):
    a1, b1 = e1
    a2, b2 = e2
    return a1 * a2, a2 * b1 + b2


def rg_lru(x, w_r, b_r, w_i, b_i, lam, reverse):
    x32 = x.astype(jnp.float32)
    r = jax.nn.sigmoid(block_diag(x, w_r, b_r).astype(jnp.float32))
    i = jax.nn.sigmoid(block_diag(x, w_i, b_i).astype(jnp.float32))
    log_a = -RG_C * r * jax.nn.softplus(-lam.astype(jnp.float32))
    a = jnp.exp(log_a)
    u = jnp.sqrt(-jnp.expm1(2.0 * log_a)) * (i * x32)
    _, h = lax.associative_scan(_lin_combine, (a, u), axis=1, reverse=reverse)
    return h


def neighbourhood_attention(q, k, v, rpb):
    B, S, H, dh = q.shape
    rows = S // GRID_W
    win_r = min(WIN_R, rows)
    qg = q.reshape(B, rows, GRID_W, H, dh)
    kg = k.reshape(B, rows, GRID_W, H, dh)
    vg = v.reshape(B, rows, GRID_W, H, dh)
    cols = jnp.arange(GRID_W)
    c0 = jnp.clip(cols - WIN_C // 2, 0, GRID_W - WIN_C)
    cidx = c0[:, None] + jnp.arange(WIN_C)[None, :]
    dcol = cidx - cols[:, None] + (WIN_C - 1)
    scale = dh ** -0.5

    def row_fn(r):
        r0 = jnp.clip(r - win_r // 2, 0, rows - win_r)
        q_r = lax.dynamic_index_in_dim(qg, r, axis=1, keepdims=False)
        k_rows = lax.dynamic_slice_in_dim(kg, r0, win_r, axis=1)
        v_rows = lax.dynamic_slice_in_dim(vg, r0, win_r, axis=1)
        k_win = k_rows[:, :, cidx]
        v_win = v_rows[:, :, cidx]
        s = jnp.einsum('bqhd,bwqkhd->bhqwk', q_r, k_win).astype(jnp.float32) * scale
        drow = r0 + jnp.arange(win_r) - r + (WIN_R - 1)
        bias = rpb[:, drow][:, :, dcol]
        s = s + jnp.transpose(bias, (0, 2, 1, 3)).astype(jnp.float32)[None]
        p = jax.nn.softmax(s.reshape(B, H, GRID_W, win_r * WIN_C), axis=-1)
        p = p.reshape(B, H, GRID_W, win_r, WIN_C).astype(v.dtype)
        return jnp.einsum('bhqwk,bwqkhd->bqhd', p, v_win)

    out = lax.map(row_fn, jnp.arange(rows))
    return jnp.transpose(out, (1, 0, 2, 3, 4)).reshape(B, S, H * dh)


def setup_inputs(seed: int = 0) -> dict:
    key = jax.random.key(seed)
    ks = jax.random.split(key, 26)
    n = lambda k, shp, s: jax.random.normal(k, shp, jnp.float32) * s

    def lam_init(k):
        a0 = jax.random.uniform(k, (DEPTH, D_A), jnp.float32, 0.9, 0.999)
        u = a0 ** (1.0 / RG_C)
        return jnp.log(u) - jnp.log1p(-u)

    return {
        "x": n(ks[0], (BATCH, SEQ, D_MODEL), 1.0),
        "c": n(ks[1], (BATCH, D_MODEL), 1.0),
        "g_pre": 1.0 + n(ks[2], (DEPTH, D_MODEL), 0.02),
        "w_c": n(ks[3], (DEPTH, D_MODEL, 3 * D_MODEL), D_MODEL ** -0.5),
        "b_c": n(ks[4], (DEPTH, 3 * D_MODEL), 0.02),
        "w_in": n(ks[5], (DEPTH, D_MODEL, IN_COLS), D_MODEL ** -0.5),
        "conv_w": n(ks[6], (DEPTH, CONV_W, D_A), CONV_W ** -0.5),
        "conv_b": n(ks[7], (DEPTH, D_A), 0.02),
        "w_r_f": n(ks[8], (DEPTH, A_BLOCKS, A_BW, A_BW), A_BW ** -0.5),
        "b_r_f": n(ks[9], (DEPTH, D_A), 0.02),
        "w_i_f": n(ks[10], (DEPTH, A_BLOCKS, A_BW, A_BW), A_BW ** -0.5),
        "b_i_f": n(ks[11], (DEPTH, D_A), 0.02),
        "lam_f": lam_init(ks[12]),
        "w_r_b": n(ks[13], (DEPTH, A_BLOCKS, A_BW, A_BW), A_BW ** -0.5),
        "b_r_b": n(ks[14], (DEPTH, D_A), 0.02),
        "w_i_b": n(ks[15], (DEPTH, A_BLOCKS, A_BW, A_BW), A_BW ** -0.5),
        "b_i_b": n(ks[16], (DEPTH, D_A), 0.02),
        "lam_b": lam_init(ks[17]),
        "rpb": n(ks[18], (DEPTH, N_HEADS, 2 * WIN_R - 1, 2 * WIN_C - 1), 0.1),
        "w_pa": n(ks[19], (DEPTH, D_A, D_MODEL), D_A ** -0.5),
        "w_pb": n(ks[20], (DEPTH, D_B, D_MODEL), D_B ** -0.5),
        "w_o": n(ks[21], (DEPTH, D_MODEL, D_MODEL), D_MODEL ** -0.5),
        "g_final": 1.0 + n(ks[22], (D_MODEL,), 0.02),
    }


def reference(x, c, g_pre, w_c, b_c, w_in, conv_w, conv_b, w_r_f, b_r_f, w_i_f, b_i_f, lam_f,
              w_r_b, b_r_b, w_i_b, b_i_b, lam_b, rpb, w_pa, w_pb, w_o, g_final):
    B, S, D = x.shape
    split_pts = list(np.cumsum(IN_SPLITS)[:-1])
    for l in range(DEPTH):
        mod = jax.nn.silu(c) @ w_c[l] + b_c[l]
        shift, scl, gate = jnp.split(mod, 3, axis=-1)
        h = rms_norm(x, g_pre[l]) * (1.0 + scl[:, None, :]) + shift[:, None, :]

        proj = h @ w_in[l]
        xa, za, q, k, v, zb, ga, gb = jnp.split(proj, split_pts, axis=-1)

        xa = centred_dwconv(xa, conv_w[l], conv_b[l])
        h_fwd = rg_lru(xa, w_r_f[l], b_r_f[l], w_i_f[l], b_i_f[l], lam_f[l], reverse=False)
        h_bwd = rg_lru(xa, w_r_b[l], b_r_b[l], w_i_b[l], b_i_b[l], lam_b[l], reverse=True)
        y_a = (h_fwd + h_bwd).astype(x.dtype) * jax.nn.silu(za)
        y_a = y_a @ w_pa[l]

        qh = q.reshape(B, S, N_HEADS, HEAD_DIM)
        kh = k.reshape(B, S, N_HEADS, HEAD_DIM)
        vh = v.reshape(B, S, N_HEADS, HEAD_DIM)
        y_b = neighbourhood_attention(qh, kh, vh, rpb[l]) * jax.nn.silu(zb)
        y_b = y_b @ w_pb[l]

        merged = jax.nn.sigmoid(ga) * y_a + jax.nn.sigmoid(gb) * y_b
        x = x + gate[:, None, :] * (merged @ w_o[l])
    return rms_norm(x, g_final)
```

```cpp
#include <hip/hip_runtime.h>
#include <hip/hip_cooperative_groups.h>
#include <cstdio>
#include <cstdint>
namespace cg = cooperative_groups;
namespace pg8 {
#define PG8_LAS __attribute__((address_space(3)))
typedef unsigned short bf16_t;
typedef short bf16x8 __attribute__((ext_vector_type(8)));
typedef float f32x4 __attribute__((ext_vector_type(4)));
typedef unsigned u32x4 __attribute__((ext_vector_type(4)));
constexpr int BM = 256, BK = 64, HALF = 128, HTB = HALF * BK * 2  , STAGE_BYTES = 8 * HTB, NXCD = 8, WGM = 8;

__host__ __device__ __forceinline__ int lds_byte(int r, int c) { const int st = (r >> 4) * 2 + (c >> 5), rr = r & 15, cc = c & 31, ob = rr * 64 + cc * 2; return st * 1024 + (ob ^ (((ob >> 9) & 1) << 5)); }
__host__ __device__ __forceinline__ void stage_rc(int b, int& R, int& C) { const int st = b / 1024, sb = b % 1024, swz = sb ^ (((sb >> 9) & 1) << 5); R = (st >> 1) * 16 + swz / 64; C = (st & 1) * 32 + (swz % 64) / 2; }
__host__ __device__ __forceinline__ int perm32(int rho) { const int n = rho >> 4, i = rho & 15; return 8 * (i >> 2) + 4 * n + (i & 3); }

struct Unit { int pm, pn; };
struct Gemm { const bf16_t* A; const bf16_t* Bt; int M, N, K; };

struct StaticOrder {
    int nM, nN, nwg, G, c;
    __host__ __device__ void init(int M, int N, int G_, int c_) { nM = M / BM; nN = N / BM; nwg = nM * nN; G = G_; c = c_; }
    __host__ __device__ bool next(int i, Unit& u) const {
        const long L = (long)i * G + c; if (L >= nwg) return false;
        int wgid = (int)L; { const int q = nwg / NXCD, r = nwg % NXCD, xcd = wgid % NXCD, off = wgid / NXCD; wgid = (xcd < r ? xcd * (q + 1) : r * (q + 1) + (xcd - r) * q) + off; }
        const int nig = WGM * nN, gid = wgid / nig, fm = gid * WGM, gsz = (nM - fm) < WGM ? (nM - fm) : WGM;
        u.pm = fm + ((wgid % nig) % gsz); u.pn = (wgid % nig) / gsz; return true;
    }
    __device__ __forceinline__ void a_ready(const Unit&) const {}
    __device__ __forceinline__ void done(const Unit&) const {}
};
__device__ __forceinline__ unsigned cvt_pk_bf16(float lo, float hi) { unsigned r; asm volatile("v_cvt_pk_bf16_f32 %0, %1, %2" : "=v"(r) : "v"(lo), "v"(hi)); return r; }
typedef float f32x2 __attribute__((ext_vector_type(2)));
template <class Epi, class Sched, bool ALIGN_EPI = false, bool SP2 = false>
__device__ __forceinline__ void gemm_phase(PG8_LAS unsigned char* lds, const Gemm g, const Sched& S, const Epi& E) {
    const int tid = threadIdx.x, wid = __builtin_amdgcn_readfirstlane(tid >> 6), lane = tid & 63, wr = wid >> 2, wc = wid & 3, fr = lane & 15, fq = lane >> 4;
    const int K = g.K, nt = K / BK;
    unsigned voffA[2], voffB[2];
#pragma unroll
    for (int i = 0; i < 2; ++i) { int R, C; stage_rc(tid * 16 + i * 8192, R, C); const int Rb = Epi::PERM ? ((R & ~31) + perm32(R & 31)) : R;
        voffA[i] = (unsigned)(R * K + C) * 2u; voffB[i] = (unsigned)(Rb * K + C) * 2u; }
    const size_t kstep = (size_t)(BK * 2);
    const size_t hstep = (size_t)HALF * K * 2;
    const size_t tstep = 2 * hstep;
    const unsigned ldsw = (unsigned)wid * 1024u;
    const int aoff = lds_byte(wr * 64 + fr, fq * 8), boff = lds_byte(wc * 32 + fr, fq * 8);
#define PG8_SA(b, h) (((b) * 2 + (h)) * HTB)
#define PG8_SB(b, h) ((4 + (b) * 2 + (h)) * HTB)
#define PG8_STAGE(bufoff, gbase, voff) do { _Pragma("unroll") for (int _i = 0; _i < 2; ++_i) \
        __builtin_amdgcn_global_load_lds((const unsigned*)((const char*)(gbase) + (voff)[_i]), (PG8_LAS unsigned*)(lds + (bufoff) + ldsw + _i * 8192), 16, 0, 0); } while (0)
#define PG8_LDA(dst, b, h) do { _Pragma("unroll") for (int m = 0; m < 4; ++m) _Pragma("unroll") for (int k = 0; k < 2; ++k) dst[m][k] = *(const PG8_LAS bf16x8*)(lds + PG8_SA(b, h) + aoff + m * 2048 + k * 1024); } while (0)
#define PG8_LDB(dst, b, h) do { _Pragma("unroll") for (int n = 0; n < 2; ++n) _Pragma("unroll") for (int k = 0; k < 2; ++k) dst[n][k] = *(const PG8_LAS bf16x8*)(lds + PG8_SB(b, h) + boff + n * 2048 + k * 1024); } while (0)
#define PG8_MMA(ai, bj, At, Bt) do { __builtin_amdgcn_s_setprio(1); _Pragma("unroll") for (int m = 0; m < 4; ++m) _Pragma("unroll") for (int n = 0; n < 2; ++n) _Pragma("unroll") for (int k = 0; k < 2; ++k) \
        acc[ai][bj][m][n] = __builtin_amdgcn_mfma_f32_16x16x32_bf16(Bt[n][k], At[m][k], acc[ai][bj][m][n], 0, 0, 0); __builtin_amdgcn_s_setprio(0); } while (0)
#define PG8_WAIT_V(n) asm volatile("s_waitcnt vmcnt(" #n ")" ::: "memory")
#define PG8_WAIT_L(n) asm volatile("s_waitcnt lgkmcnt(" #n ")" ::: "memory")
#define PG8_BAR __builtin_amdgcn_s_barrier()
#define PG8_SCHED __builtin_amdgcn_sched_barrier(0)
    Unit cur, nxt; int ui = 0;
    if (!S.next(0, cur)) return;
    f32x4 acc[2][2][4][2];
#pragma unroll
    for (int a = 0; a < 2; ++a)
#pragma unroll
        for (int b = 0; b < 2; ++b)
#pragma unroll
            for (int m = 0; m < 4; ++m)
#pragma unroll
                for (int n = 0; n < 2; ++n) acc[a][b][m][n] = (f32x4){0.f, 0.f, 0.f, 0.f};
    bf16x8 At[4][2], B0[2][2], B1[2][2];
    const char* cA = (const char*)g.A + (size_t)cur.pm * tstep; const char* cB = (const char*)g.Bt + (size_t)cur.pn * tstep;
    S.a_ready(cur);
    if constexpr (SP2) {
        PG8_STAGE(PG8_SB(0, 0), cB, voffB); PG8_STAGE(PG8_SB(0, 1), cB + hstep, voffB); PG8_STAGE(PG8_SA(0, 0), cA, voffA); PG8_STAGE(PG8_SA(0, 1), cA + hstep, voffA);
        if (wr == 1) PG8_BAR;
        PG8_WAIT_V(2); PG8_BAR;
        PG8_STAGE(PG8_SB(1, 0), cB + kstep, voffB); PG8_STAGE(PG8_SA(1, 0), cA + kstep, voffA); PG8_STAGE(PG8_SB(1, 1), cB + hstep + kstep, voffB);
        PG8_WAIT_V(6); PG8_BAR;
    } else {
        PG8_STAGE(PG8_SB(0, 0), cB, voffB); PG8_STAGE(PG8_SA(0, 0), cA, voffA); PG8_STAGE(PG8_SB(0, 1), cB + hstep, voffB); PG8_STAGE(PG8_SA(0, 1), cA + hstep, voffA);
        if (wr == 1) PG8_BAR;
        PG8_WAIT_V(4); PG8_BAR;
        PG8_STAGE(PG8_SB(1, 0), cB + kstep, voffB); PG8_STAGE(PG8_SA(1, 0), cA + kstep, voffA); PG8_STAGE(PG8_SB(1, 1), cB + hstep + kstep, voffB);
        PG8_WAIT_V(6); PG8_BAR;
    }
    for (;;) {
        const bool has_next = S.next(ui + 1, nxt);
        const char* nA = has_next ? (const char*)g.A + (size_t)nxt.pm * tstep : cA; const char* nB = has_next ? (const char*)g.Bt + (size_t)nxt.pn * tstep : cB;
        for (int t = 0; t < nt; t += 2) {
            const bool last = (t == nt - 2);
            const char* a1 = cA + (size_t)(t + 1) * kstep;
            const char* a2 = last ? nA : cA + (size_t)(t + 2) * kstep; const char* b2 = last ? nB : cB + (size_t)(t + 2) * kstep;
            const char* a3 = a2 + kstep; const char* b3 = b2 + kstep;
            if (last && has_next) S.a_ready(nxt);
            if constexpr (SP2) {
            PG8_LDB(B0, 0, 0); PG8_LDB(B1, 0, 1); PG8_SCHED; PG8_LDA(At, 0, 0); PG8_STAGE(PG8_SA(1, 1), a1 + hstep, voffA);
            PG8_WAIT_V(8); PG8_WAIT_L(0); PG8_BAR; PG8_MMA(0, 0, At, B0); PG8_MMA(0, 1, At, B1); PG8_BAR; PG8_SCHED;
            PG8_LDA(At, 0, 1); PG8_STAGE(PG8_SB(0, 0), b2, voffB); PG8_STAGE(PG8_SB(0, 1), b2 + hstep, voffB); PG8_STAGE(PG8_SA(0, 0), a2, voffA);
            PG8_WAIT_V(8); PG8_WAIT_L(0); PG8_BAR; PG8_MMA(1, 0, At, B0); PG8_MMA(1, 1, At, B1); PG8_BAR; PG8_SCHED;
            PG8_LDB(B0, 1, 0); PG8_LDB(B1, 1, 1); PG8_SCHED; PG8_LDA(At, 1, 0); PG8_STAGE(PG8_SA(0, 1), a2 + hstep, voffA);
            PG8_WAIT_V(8); PG8_WAIT_L(0); PG8_BAR; PG8_MMA(0, 0, At, B0); PG8_MMA(0, 1, At, B1); PG8_BAR; PG8_SCHED;
            PG8_LDA(At, 1, 1); PG8_STAGE(PG8_SB(1, 0), b3, voffB); PG8_STAGE(PG8_SB(1, 1), b3 + hstep, voffB); PG8_STAGE(PG8_SA(1, 0), a3, voffA);
            PG8_WAIT_V(8); PG8_WAIT_L(0); PG8_BAR; PG8_MMA(1, 0, At, B0); PG8_MMA(1, 1, At, B1); PG8_BAR; PG8_SCHED;
            } else {
            PG8_LDB(B0, 0, 0); PG8_SCHED; PG8_LDA(At, 0, 0); PG8_STAGE(PG8_SA(1, 1), a1 + hstep, voffA);
            PG8_WAIT_L(8); PG8_BAR; PG8_WAIT_L(0); PG8_MMA(0, 0, At, B0); PG8_BAR; PG8_SCHED;
            PG8_LDB(B1, 0, 1); PG8_STAGE(PG8_SB(0, 0), b2, voffB);
            PG8_BAR; PG8_WAIT_L(0); PG8_MMA(0, 1, At, B1); PG8_BAR;
            PG8_LDA(At, 0, 1); PG8_STAGE(PG8_SA(0, 0), a2, voffA);
            PG8_BAR; PG8_WAIT_L(0); PG8_MMA(1, 0, At, B0); PG8_BAR; PG8_SCHED;
            PG8_STAGE(PG8_SB(0, 1), b2 + hstep, voffB);
            PG8_WAIT_V(6); PG8_BAR; PG8_MMA(1, 1, At, B1); PG8_BAR;
            PG8_LDB(B0, 1, 0); PG8_SCHED; PG8_LDA(At, 1, 0); PG8_STAGE(PG8_SA(0, 1), a2 + hstep, voffA);
            PG8_WAIT_L(8); PG8_BAR; PG8_WAIT_L(0); PG8_MMA(0, 0, At, B0); PG8_BAR; PG8_SCHED;
            PG8_LDB(B1, 1, 1); PG8_STAGE(PG8_SB(1, 0), b3, voffB);
            PG8_BAR; PG8_WAIT_L(0); PG8_MMA(0, 1, At, B1); PG8_BAR;
            PG8_LDA(At, 1, 1); PG8_STAGE(PG8_SA(1, 0), a3, voffA);
            PG8_BAR; PG8_WAIT_L(0); PG8_MMA(1, 0, At, B0); PG8_BAR; PG8_SCHED;
            PG8_STAGE(PG8_SB(1, 1), b3 + hstep, voffB);
            PG8_WAIT_V(6); PG8_BAR; PG8_MMA(1, 1, At, B1); PG8_BAR;
            }
        }
        if constexpr (ALIGN_EPI) { if (wr == 0) PG8_BAR; }
        if constexpr (!Epi::AFTER_DRAIN) { E(acc, cur, wr, wc, fr, fq); S.done(cur); }
        if (!has_next) break;
#pragma unroll
        for (int a = 0; a < 2; ++a)
#pragma unroll
            for (int b = 0; b < 2; ++b)
#pragma unroll
                for (int m = 0; m < 4; ++m)
#pragma unroll
                    for (int n = 0; n < 2; ++n) acc[a][b][m][n] = (f32x4){0.f, 0.f, 0.f, 0.f};
        cur = nxt; cA = nA; cB = nB; ++ui;
        if constexpr (ALIGN_EPI) { if (wr == 1) PG8_BAR; }
    }
    PG8_WAIT_V(0);
    if constexpr (!ALIGN_EPI) { if (wr == 0) PG8_BAR; }
    PG8_BAR;
    if constexpr (Epi::AFTER_DRAIN) { E.fused(acc, cur, wr, wc, fr, fq, lds, wid, lane); S.done(cur); }
#undef PG8_SA
#undef PG8_SB
#undef PG8_STAGE
#undef PG8_LDA
#undef PG8_LDB
#undef PG8_MMA
#undef PG8_WAIT_V
#undef PG8_WAIT_L
#undef PG8_BAR
#undef PG8_SCHED
}
}
#ifndef PG8_SP2
#define PG8_SP2 true
#endif
#ifndef PG8_ALIGN
#define PG8_ALIGN true
#endif

#define LAS __attribute__((address_space(3)))
typedef unsigned short bf16_t;
typedef short bf16x8 __attribute__((ext_vector_type(8)));
typedef short bf16x4 __attribute__((ext_vector_type(4)));
typedef float f32x4 __attribute__((ext_vector_type(4)));
typedef float f32x16 __attribute__((ext_vector_type(16)));
typedef unsigned u32x4 __attribute__((ext_vector_type(4)));
typedef unsigned u32x2 __attribute__((ext_vector_type(2)));

constexpr int MTOK = 16384, DM = 1024, SEQ = 4096, NB = 4;
constexpr size_t MiB = 1u << 20;
constexpr size_t ARR = (size_t)MTOK * DM;
constexpr size_t WS_MODP = 0;
constexpr size_t WS_GATE = 786432;
constexpr size_t WS_AGG = 1 * MiB;
constexpr size_t WS_RSS = 5 * MiB;
constexpr size_t WS_WG = 6 * MiB;
constexpr size_t WS_WPA = 8 * MiB, WS_WPB = 10 * MiB, WS_WO = 12 * MiB, WS_WV = 14 * MiB;
constexpr size_t WS_WIN = 16 * MiB;
constexpr size_t WS_H = 32 * MiB;
constexpr size_t WS_XA = 64 * MiB, WS_ZA = 96 * MiB, WS_Q = 128 * MiB, WS_K = 160 * MiB, WS_ZB = 192 * MiB;
constexpr size_t WS_VT = 224 * MiB;
constexpr int LDS_BYTES = 131072;

__device__ __forceinline__ float bf2f(unsigned short b) { return __uint_as_float(((unsigned)b) << 16); }
__device__ __forceinline__ unsigned pk2(float lo, float hi) { return pg8::cvt_pk_bf16(lo, hi); }
__device__ __forceinline__ float sigm(float v) { return __builtin_amdgcn_rcpf(1.f + __builtin_amdgcn_exp2f(-1.44269504089f * v)); }
__device__ __forceinline__ float wave_sum(float v) {
#pragma unroll
    for (int o = 1; o < 64; o <<= 1) v += __shfl_xor(v, o);
    return v;
}
#define LDS_WAIT() asm volatile("s_waitcnt lgkmcnt(0)" ::: "memory")

struct EpiProj {
    static constexpr bool PERM = true, AFTER_DRAIN = false;
    bf16_t* O5; bf16_t* OG;
    __device__ __forceinline__ void operator()(const f32x4 (&acc)[2][2][4][2], const pg8::Unit& u, int wr, int wc, int fr, int fq) const {
        const int arr = u.pn >> 2, colt = (u.pn & 3) * 256;
        bf16_t* base = arr < 5 ? O5 + (size_t)arr * ARR : OG + (size_t)(arr - 5) * ARR;
        const int mode = (arr == 1 || arr == 4) ? 1 : (arr >= 5 ? 2 : (arr == 2 ? 3 : 0));
        const int row0 = u.pm * 256 + wr * 64 + fr, col0 = colt + wc * 32 + 8 * fq;
#pragma unroll
        for (int ai = 0; ai < 2; ++ai)
#pragma unroll
            for (int m = 0; m < 4; ++m) { bf16_t* rowp = base + (size_t)(row0 + ai * 128 + m * 16) * DM + col0;
#pragma unroll
                for (int bj = 0; bj < 2; ++bj) { f32x4 v0 = acc[ai][bj][m][0], v1 = acc[ai][bj][m][1];
                    if (mode == 1) {
#pragma unroll
                        for (int j = 0; j < 4; ++j) { v0[j] = v0[j] * sigm(v0[j]); v1[j] = v1[j] * sigm(v1[j]); } }
                    else if (mode == 2) {
#pragma unroll
                        for (int j = 0; j < 4; ++j) { v0[j] = sigm(v0[j]); v1[j] = sigm(v1[j]); } }
                    else if (mode == 3) { v0 = v0 * 0.125f; v1 = v1 * 0.125f; }
                    u32x4 w; w.x = pk2(v0[0], v0[1]); w.y = pk2(v0[2], v0[3]); w.z = pk2(v1[0], v1[1]); w.w = pk2(v1[2], v1[3]);
                    *(u32x4*)(rowp + bj * 128) = w; } }
    }
};
struct EpiPlain {
    static constexpr bool PERM = true, AFTER_DRAIN = false;
    bf16_t* O; int ldc;
    __device__ __forceinline__ void operator()(const f32x4 (&acc)[2][2][4][2], const pg8::Unit& u, int wr, int wc, int fr, int fq) const {
        const int row0 = u.pm * 256 + wr * 64 + fr, col0 = u.pn * 256 + wc * 32 + 8 * fq;
#pragma unroll
        for (int ai = 0; ai < 2; ++ai)
#pragma unroll
            for (int m = 0; m < 4; ++m) { bf16_t* rowp = O + (size_t)(row0 + ai * 128 + m * 16) * ldc + col0;
#pragma unroll
                for (int bj = 0; bj < 2; ++bj) { const f32x4 v0 = acc[ai][bj][m][0], v1 = acc[ai][bj][m][1];
                    u32x4 w; w.x = pk2(v0[0], v0[1]); w.y = pk2(v0[2], v0[3]); w.z = pk2(v1[0], v1[1]); w.w = pk2(v1[2], v1[3]);
                    *(u32x4*)(rowp + bj * 128) = w; } }
    }
};
template <bool HAS_T> struct EpiGate {
    static constexpr bool PERM = true, AFTER_DRAIN = false;
    const bf16_t* G; const bf16_t* Tin; bf16_t* O;
    __device__ __forceinline__ void operator()(const f32x4 (&acc)[2][2][4][2], const pg8::Unit& u, int wr, int wc, int fr, int fq) const {
        const int row0 = u.pm * 256 + wr * 64 + fr, col0 = u.pn * 256 + wc * 32 + 8 * fq;
#pragma unroll
        for (int ai = 0; ai < 2; ++ai)
#pragma unroll
            for (int m = 0; m < 4; ++m) { const size_t off = (size_t)(row0 + ai * 128 + m * 16) * DM + col0;
#pragma unroll
                for (int bj = 0; bj < 2; ++bj) { const f32x4 v0 = acc[ai][bj][m][0], v1 = acc[ai][bj][m][1];
                    const bf16x8 g = *(const bf16x8*)(G + off + bj * 128);
                    float o[8];
#pragma unroll
                    for (int j = 0; j < 4; ++j) { o[j] = bf2f((unsigned short)g[j]) * v0[j]; o[4 + j] = bf2f((unsigned short)g[4 + j]) * v1[j]; }
                    if (HAS_T) { const bf16x8 t = *(const bf16x8*)(Tin + off + bj * 128);
#pragma unroll
                        for (int j = 0; j < 8; ++j) o[j] += bf2f((unsigned short)t[j]); }
                    u32x4 w; w.x = pk2(o[0], o[1]); w.y = pk2(o[2], o[3]); w.z = pk2(o[4], o[5]); w.w = pk2(o[6], o[7]);
                    *(u32x4*)(O + off + bj * 128) = w; } }
    }
};
struct EpiOut {
    static constexpr bool PERM = false, AFTER_DRAIN = false;
    const float* X; const float* gate; float* out; float* rss;
    __device__ __forceinline__ void operator()(const f32x4 (&acc)[2][2][4][2], const pg8::Unit& u, int wr, int wc, int fr, int fq) const {
        const int row0 = u.pm * 256 + wr * 64 + fr, col0 = u.pn * 256 + wc * 32 + 4 * fq;
        const float* gp = gate + (size_t)(u.pm >> 4) * DM + col0;
        f32x4 gv[2][2];
#pragma unroll
        for (int bj = 0; bj < 2; ++bj)
#pragma unroll
            for (int n = 0; n < 2; ++n) gv[bj][n] = *(const f32x4*)(gp + bj * 128 + n * 16);
#pragma unroll
        for (int ai = 0; ai < 2; ++ai)
#pragma unroll
            for (int m = 0; m < 4; ++m) { const int row = row0 + ai * 128 + m * 16; const size_t off = (size_t)row * DM + col0; float ss = 0.f;
#pragma unroll
                for (int bj = 0; bj < 2; ++bj)
#pragma unroll
                    for (int n = 0; n < 2; ++n) { const f32x4 xv = *(const f32x4*)(X + off + bj * 128 + n * 16); const f32x4 o = xv + gv[bj][n] * acc[ai][bj][m][n];
                        ss += (o[0] * o[0] + o[1] * o[1]) + (o[2] * o[2] + o[3] * o[3]); *(f32x4*)(out + off + bj * 128 + n * 16) = o; }
                ss += __shfl_xor(ss, 16); ss += __shfl_xor(ss, 32);
                if (fq == 0) rss[(size_t)row * 16 + u.pn * 4 + wc] = ss; }
    }
};

__device__ __forceinline__ void p0_transpose_item(const float* W, int K, int N, bf16_t* WT, int dst_row0, int k0, int n0, LAS float* scr, int lane) {
#pragma unroll 8
    for (int i = 0; i < 32; ++i) { const int kk = 2 * i + (lane >> 5); scr[kk * 33 + (lane & 31)] = W[(size_t)(k0 + kk) * N + n0 + (lane & 31)]; }
    LDS_WAIT(); asm volatile("" ::: "memory");
    const int c = lane & 7;
#pragma unroll
    for (int j = 0; j < 4; ++j) { const int n = (lane >> 3) + 8 * j; const LAS float* s = scr + (8 * c) * 33 + n;
        u32x4 o; o.x = pk2(s[0 * 33], s[1 * 33]); o.y = pk2(s[2 * 33], s[3 * 33]); o.z = pk2(s[4 * 33], s[5 * 33]); o.w = pk2(s[6 * 33], s[7 * 33]);
        *(u32x4*)(WT + (size_t)(dst_row0 + n) * K + k0 + 8 * c) = o; }
    LDS_WAIT(); asm volatile("" ::: "memory");
}

struct Args { const float* in[23]; float* out; unsigned char* ws; };

__device__ __forceinline__ void p0_prologue(const Args& a, LAS unsigned char* lds, int gw, int NGW, int wave, int lane) {
    LAS float* scr = (LAS float*)(lds + wave * 16384);
    unsigned char* ws = a.ws;
    const float* c = a.in[1]; const float* w_c = a.in[3]; const float* w_in = a.in[5];
    float* modp = (float*)(ws + WS_MODP);
    constexpr int I_MOD = 768, I_IN = 16 * 256, I_SQ = 16 * 32, I_G = 4 * 16 * 2;
    constexpr int NITEMS = I_MOD + I_IN + 3 * I_SQ + I_G;
    for (int it = gw; it < NITEMS; it += NGW) {
        int r = it;
        if (r < I_MOD) {
            const int cgi = r % 48, kc = r / 48, col = cgi * 64 + lane, k0 = kc * 64;
            float sv[4];
#pragma unroll
            for (int b = 0; b < 4; ++b) { const float cv = c[b * DM + k0 + lane]; sv[b] = cv * sigm(cv); }
            float acc[4] = {0.f, 0.f, 0.f, 0.f};
#pragma unroll 8
            for (int kk = 0; kk < 64; ++kk) { const float w = w_c[(size_t)(k0 + kk) * 3072 + col];
#pragma unroll
                for (int b = 0; b < 4; ++b) acc[b] += __shfl(sv[b], kk) * w; }
#pragma unroll
            for (int b = 0; b < 4; ++b) modp[(size_t)(kc * 4 + b) * 3072 + col] = acc[b];
            continue;
        }
        r -= I_MOD;
        if (r < I_IN) { const int kb = r / 256, nb = r % 256, n0 = nb * 32, cb = n0 >> 10;
            if (cb == 4) p0_transpose_item(w_in, 1024, 8192, (bf16_t*)(ws + WS_WV), n0 - 4096, kb * 64, n0, scr, lane);
            else p0_transpose_item(w_in, 1024, 8192, (bf16_t*)(ws + WS_WIN), (cb < 4 ? cb : cb - 1) * 1024 + (n0 & 1023), kb * 64, n0, scr, lane);
            continue; }
        r -= I_IN;
        if (r < 3 * I_SQ) { const int which = r / I_SQ, rr = r % I_SQ, kb = rr / 32, nb = rr % 32;
            const float* W = which == 0 ? a.in[19] : (which == 1 ? a.in[20] : a.in[21]);
            bf16_t* WT = (bf16_t*)(ws + (which == 0 ? WS_WPA : (which == 1 ? WS_WPB : WS_WO)));
            p0_transpose_item(W, 1024, 1024, WT, nb * 32, kb * 64, nb * 32, scr, lane);
            continue; }
        r -= 3 * I_SQ;
        { const int g = r / 32, rr = r % 32, hb = rr / 2, nb = rr % 2;
            const float* W = (g == 0 ? a.in[8] : (g == 1 ? a.in[10] : (g == 2 ? a.in[13] : a.in[15]))) + (size_t)hb * 4096;
            bf16_t* WT = (bf16_t*)(ws + WS_WG) + (size_t)(g * 16 + hb) * 4096;
            p0_transpose_item(W, 64, 64, WT, nb * 32, 0, nb * 32, scr, lane); }
    }
}

__device__ __forceinline__ void p1_hpass(const Args& a, LAS unsigned char* lds, int G, int tid, int wave, int lane) {
    unsigned char* ws = a.ws;
    const float* x = a.in[0]; const float* g_pre = a.in[2]; const float* b_c = a.in[4];
    const float* modp = (const float*)(ws + WS_MODP);
    bf16_t* H = (bf16_t*)(ws + WS_H);
    LAS float* sh = (LAS float*)lds;
    for (int rb = blockIdx.x; rb < MTOK / 64; rb += G) {
        const int b = rb >> 6;
        __syncthreads();
        for (int idx = tid; idx < 2048; idx += 512) { float s = b_c[idx];
#pragma unroll
            for (int kc = 0; kc < 16; ++kc) s += modp[(size_t)(kc * 4 + b) * 3072 + idx];
            sh[idx] = idx < 1024 ? s : 1.f + s; }
        __syncthreads();
        for (int rr = wave; rr < 64; rr += 8) { const int row = rb * 64 + rr;
            const f32x4* xr = (const f32x4*)(x + (size_t)row * DM) + lane;
            f32x4 v[4]; float s = 0.f;
#pragma unroll
            for (int j = 0; j < 4; ++j) { v[j] = xr[64 * j]; s += (v[j][0] * v[j][0] + v[j][1] * v[j][1]) + (v[j][2] * v[j][2] + v[j][3] * v[j][3]); }
            const float rstd = __builtin_amdgcn_rsqf(wave_sum(s) * (1.f / 1024.f) + 1e-6f);
#pragma unroll
            for (int j = 0; j < 4; ++j) { const int col = 4 * lane + 256 * j;
                const f32x4 g = *(const f32x4*)(g_pre + col); const f32x4 sc = *(const LAS f32x4*)(sh + 1024 + col); const f32x4 sf = *(const LAS f32x4*)(sh + col);
                const f32x4 o = (v[j] * rstd) * g * sc + sf;
                u32x2 w; w.x = pk2(o[0], o[1]); w.y = pk2(o[2], o[3]);
                *(u32x2*)(H + (size_t)row * DM + col) = w; }
        }
    }
    float* gate = (float*)(ws + WS_GATE);
    for (int idx = blockIdx.x * 512 + tid; idx < 4096; idx += G * 512) { const int b = idx >> 10, col = idx & 1023; float s = b_c[2048 + col];
#pragma unroll
        for (int kc = 0; kc < 16; ++kc) s += modp[(size_t)(kc * 4 + b) * 3072 + 2048 + col];
        gate[idx] = s; }
}

__device__ __forceinline__ void attn_phase(const bf16_t* Q, const bf16_t* Kb, const bf16_t* VT, const bf16_t* ZB, const float* rpb, bf16_t* YB, int vcu, int G, int wave, int lane) {
    const int fr = lane & 15, fq = lane >> 4;
    constexpr int NQ = 4 * 64 * 16 * 4;
    constexpr float L2E = 1.44269504089f;
    for (int qi = vcu * 8 + wave; qi < NQ; qi += G * 8) {
        const int j = qi & 3, item = qi >> 2, r = item & 63, hb = item >> 6, h = hb & 15, b = hb >> 4;
        const int r0 = min(max(r - 4, 0), 56);
        const int cs = min(max(16 * j - 8, 0), 32);
        const int qc = 16 * j + fr, c0 = min(max(qc - 8, 0), 48);
        const size_t tokq = (size_t)b * SEQ + r * 64 + qc;
        bf16x8 qf[2];
#pragma unroll
        for (int ks = 0; ks < 2; ++ks) qf[ks] = *(const bf16x8*)(Q + tokq * DM + h * 64 + ks * 32 + fq * 8);
        f32x4 s[8][2];
#pragma unroll
        for (int w = 0; w < 8; ++w) { const size_t tokrow = (size_t)b * SEQ + (size_t)(r0 + w) * 64;
#pragma unroll
            for (int t = 0; t < 2; ++t) { const int kc = cs + 8 * (fr >> 2) + (fr & 3) + 4 * t;
                f32x4 acc = {0.f, 0.f, 0.f, 0.f};
#pragma unroll
                for (int ks = 0; ks < 2; ++ks) { const bf16x8 kf = *(const bf16x8*)(Kb + (tokrow + kc) * DM + h * 64 + ks * 32 + fq * 8);
                    acc = __builtin_amdgcn_mfma_f32_16x16x32_bf16(kf, qf[ks], acc, 0, 0, 0); }
                s[w][t] = acc; } }
        float mx = -1e30f;
#pragma unroll
        for (int w = 0; w < 8; ++w) { const float* rp = rpb + (size_t)(h * 15 + (r0 + w - r + 7)) * 31;
#pragma unroll
            for (int t = 0; t < 2; ++t)
#pragma unroll
                for (int i = 0; i < 4; ++i) { const int kcol = cs + 8 * fq + 4 * t + i; const bool ok = (kcol >= c0) && (kcol < c0 + 16);
                    const int dcol = min(max(kcol - qc + 15, 0), 30);
                    const float v = ok ? (s[w][t][i] + rp[dcol]) * L2E : -1e30f; s[w][t][i] = v; mx = fmaxf(mx, v); } }
        mx = fmaxf(mx, __shfl_xor(mx, 16)); mx = fmaxf(mx, __shfl_xor(mx, 32));
        float sum = 0.f; bf16x8 pf[8];
#pragma unroll
        for (int w = 0; w < 8; ++w) { float p[8];
#pragma unroll
            for (int t = 0; t < 2; ++t)
#pragma unroll
                for (int i = 0; i < 4; ++i) { const float e = __builtin_amdgcn_exp2f(s[w][t][i] - mx); p[4 * t + i] = e; sum += e; }
            u32x4 pw; pw.x = pk2(p[0], p[1]); pw.y = pk2(p[2], p[3]); pw.z = pk2(p[4], p[5]); pw.w = pk2(p[6], p[7]);
            pf[w] = __builtin_bit_cast(bf16x8, pw); }
        sum += __shfl_xor(sum, 16); sum += __shfl_xor(sum, 32);
        const float inv = 1.f / sum;
        f32x4 o[4];
#pragma unroll
        for (int dt = 0; dt < 4; ++dt) o[dt] = (f32x4){0.f, 0.f, 0.f, 0.f};
#pragma unroll
        for (int w = 0; w < 8; ++w) { const size_t tokrow = (size_t)b * SEQ + (size_t)(r0 + w) * 64;
#pragma unroll
            for (int dt = 0; dt < 4; ++dt) { const bf16x8 vf = *(const bf16x8*)(VT + (size_t)(h * 64 + dt * 16 + fr) * MTOK + tokrow + cs + 8 * fq);
                o[dt] = __builtin_amdgcn_mfma_f32_16x16x32_bf16(vf, pf[w], o[dt], 0, 0, 0); } }
#pragma unroll
        for (int dt = 0; dt < 4; ++dt) { const size_t off = tokq * DM + h * 64 + dt * 16 + 4 * fq;
            const bf16x4 z = *(const bf16x4*)(ZB + off);
            u32x2 w; w.x = pk2(o[dt][0] * inv * bf2f((unsigned short)z[0]), o[dt][1] * inv * bf2f((unsigned short)z[1]));
            w.y = pk2(o[dt][2] * inv * bf2f((unsigned short)z[2]), o[dt][3] * inv * bf2f((unsigned short)z[3]));
            *(u32x2*)(YB + off) = w; }
    }
}

template <bool FINAL, int DIR>
__device__ __forceinline__ void scan_dir(const LAS bf16x8* afrL, int lane, int ct, const bf16_t* WGr, const bf16_t* WGi, float br, float bi, float cl, float Hin,
                                         const bf16x8 (&idf)[2], float& Aout, float& Uout, const bf16_t* ZAp, bf16_t* YAp) {
    const int n = lane & 31, hf = lane >> 5;
    bf16x8 Br[4], Bi[4];
#pragma unroll
    for (int kk = 0; kk < 4; ++kk) { Br[kk] = *(const bf16x8*)(WGr + (size_t)(32 * ct + n) * 64 + 16 * kk + 8 * hf); Bi[kk] = *(const bf16x8*)(WGi + (size_t)(32 * ct + n) * 64 + 16 * kk + 8 * hf); }
    float H = Hin, Ap = 1.f;
#pragma unroll 1
    for (int si = 0; si < 4; ++si) { const int s = DIR ? 3 - si : si;
        f32x16 ar, ai, ax;
#pragma unroll
        for (int e = 0; e < 16; ++e) { ar[e] = 0.f; ai[e] = 0.f; ax[e] = 0.f; }
#pragma unroll
        for (int kk = 0; kk < 4; ++kk) { const bf16x8 av = afrL[(s * 4 + kk) * 64 + lane];
            ar = __builtin_amdgcn_mfma_f32_32x32x16_bf16(av, Br[kk], ar, 0, 0, 0); ai = __builtin_amdgcn_mfma_f32_32x32x16_bf16(av, Bi[kk], ai, 0, 0, 0); }
        { const bf16x8 a0 = afrL[(s * 4 + 2 * ct) * 64 + lane], a1 = afrL[(s * 4 + 2 * ct + 1) * 64 + lane];
            ax = __builtin_amdgcn_mfma_f32_32x32x16_bf16(a0, idf[0], ax, 0, 0, 0); ax = __builtin_amdgcn_mfma_f32_32x32x16_bf16(a1, idf[1], ax, 0, 0, 0); }
        const bf16_t* zs = ZAp + (size_t)(16 * s) * DM; bf16_t* ys = YAp + (size_t)(16 * s) * DM;
#pragma unroll
        for (int ei = 0; ei < 16; ++ei) { const int e = DIR ? 15 - ei : ei;
            const float r = sigm(ar[e] + br), ig = sigm(ai[e] + bi);
            const float av = __builtin_amdgcn_exp2f(cl * r);
            const float om = fmaxf(fmaf(-av, av, 1.f), 0.f);
            const float u = __builtin_amdgcn_sqrtf(om) * (ig * ax[e]);
            H = fmaf(av, H, u);
            if (FINAL) { const float hz = H * bf2f(zs[(size_t)e * DM]);
                if (DIR == 0) ys[(size_t)e * DM] = (bf16_t)(pk2(hz, 0.f) & 0xffffu);
                else ys[(size_t)e * DM] = (bf16_t)(pk2(hz + bf2f(ys[(size_t)e * DM]), 0.f) & 0xffffu); }
            else Ap *= av; }
    }
    Aout = Ap; Uout = H;
}

template <bool FINAL>
__device__ __forceinline__ void scan_phase(const Args& a, LAS unsigned char* lds, int gw, int NGW, int wave, int lane) {
    unsigned char* ws = a.ws;
    const bf16_t* XA = (const bf16_t*)(ws + WS_XA); const bf16_t* ZA = (const bf16_t*)(ws + WS_ZA);
    const bf16_t* WG = (const bf16_t*)(ws + WS_WG);
    const float* conv_w = a.in[6]; const float* conv_b = a.in[7];
    typedef float f32x2 __attribute__((ext_vector_type(2)));
    f32x2* AGG = (f32x2*)(ws + WS_AGG);
    bf16_t* YA = (bf16_t*)(ws + WS_H);
    LAS bf16x8* afrL = (LAS bf16x8*)(lds + wave * 16384);
    const int n = lane & 31, hf = lane >> 5;
    bf16x8 idf[2];
#pragma unroll
    for (int k2 = 0; k2 < 2; ++k2)
#pragma unroll
        for (int jj = 0; jj < 8; ++jj) idf[k2][jj] = (16 * k2 + 8 * hf + jj == n) ? (short)0x3F80 : (short)0;
    for (int wt = gw; wt < 2048; wt += NGW) {
        const int cp = wt & 31, jb = (wt >> 5) & 15, b = wt >> 9, ch0 = jb * 64;
        { const int a_half = (n >> 2) & 1, a_idx = (n & 3) + 4 * (n >> 3), a_chunk = 2 * cp + a_half;
#pragma unroll 1
          for (int kk = 0; kk < 4; ++kk) { const int ch = ch0 + 16 * kk + 8 * hf;
              float cw[4][8], cb[8];
#pragma unroll
              for (int w = 0; w < 4; ++w) { const f32x4 c0 = *(const f32x4*)(conv_w + w * DM + ch), c1 = *(const f32x4*)(conv_w + w * DM + ch + 4);
#pragma unroll
                  for (int jj = 0; jj < 4; ++jj) { cw[w][jj] = c0[jj]; cw[w][4 + jj] = c1[jj]; } }
              { const f32x4 c0 = *(const f32x4*)(conv_b + ch), c1 = *(const f32x4*)(conv_b + ch + 4);
#pragma unroll
                  for (int jj = 0; jj < 4; ++jj) { cb[jj] = c0[jj]; cb[4 + jj] = c1[jj]; } }
#pragma unroll
              for (int s = 0; s < 4; ++s) { const int p = a_chunk * 64 + 16 * s + a_idx;
                  float acc[8];
#pragma unroll
                  for (int jj = 0; jj < 8; ++jj) acc[jj] = cb[jj];
#pragma unroll
                  for (int w = 0; w < 4; ++w) { const int pp = p + w - 2; const bool ok = (pp >= 0) && (pp < SEQ); const int pc = min(max(pp, 0), SEQ - 1);
                      const bf16x8 xv = *(const bf16x8*)(XA + ((size_t)b * SEQ + pc) * DM + ch);
#pragma unroll
                      for (int jj = 0; jj < 8; ++jj) acc[jj] = fmaf(cw[w][jj], ok ? bf2f((unsigned short)xv[jj]) : 0.f, acc[jj]); }
                  u32x4 pw; pw.x = pk2(acc[0], acc[1]); pw.y = pk2(acc[2], acc[3]); pw.z = pk2(acc[4], acc[5]); pw.w = pk2(acc[6], acc[7]);
                  afrL[(s * 4 + kk) * 64 + lane] = __builtin_bit_cast(bf16x8, pw); } } }
        LDS_WAIT(); asm volatile("" ::: "memory");
        const int chunk = 2 * cp + hf;
#pragma unroll 1
        for (int ct = 0; ct < 2; ++ct) { const int ch = ch0 + 32 * ct + n;
            float Af, Uf, Ab, Ub;
            {
                const float br = a.in[9][ch], bi = a.in[11][ch]; const float lam = a.in[12][ch];
                const float cl = -8.f * 1.44269504089f * log1pf(expf(-lam));
                float Hin = 0.f;
                if (FINAL) {
#pragma unroll 4
                    for (int k = 0; k < 63; ++k) { if (k < chunk) { const f32x2 g = AGG[((size_t)(b * 2 + 0) * 64 + k) * DM + ch]; Hin = fmaf(g[0], Hin, g[1]); } } }
                scan_dir<FINAL, 0>(afrL, lane, ct, WG + (size_t)(0 * 16 + jb) * 4096, WG + (size_t)(1 * 16 + jb) * 4096, br, bi, cl, Hin, idf, Af, Uf, ZA + ((size_t)b * SEQ + chunk * 64) * DM + ch, YA + ((size_t)b * SEQ + chunk * 64) * DM + ch);
            }
            {
                const float br = a.in[14][ch], bi = a.in[16][ch]; const float lam = a.in[17][ch];
                const float cl = -8.f * 1.44269504089f * log1pf(expf(-lam));
                float Hin = 0.f;
                if (FINAL) {
#pragma unroll 4
                    for (int k = 63; k > 0; --k) { if (k > chunk) { const f32x2 g = AGG[((size_t)(b * 2 + 1) * 64 + k) * DM + ch]; Hin = fmaf(g[0], Hin, g[1]); } } }
                scan_dir<FINAL, 1>(afrL, lane, ct, WG + (size_t)(2 * 16 + jb) * 4096, WG + (size_t)(3 * 16 + jb) * 4096, br, bi, cl, Hin, idf, Ab, Ub, ZA + ((size_t)b * SEQ + chunk * 64) * DM + ch, YA + ((size_t)b * SEQ + chunk * 64) * DM + ch);
            }
            if (!FINAL) {
                AGG[((size_t)(b * 2 + 0) * 64 + chunk) * DM + ch] = (f32x2){Af, Uf};
                AGG[((size_t)(b * 2 + 1) * 64 + chunk) * DM + ch] = (f32x2){Ab, Ub};
            }
        }
        LDS_WAIT(); asm volatile("" ::: "memory");
    }
}

__device__ __forceinline__ void final_norm(const Args& a, int gw, int NGW, int lane) {
    const float* rss = (const float*)(a.ws + WS_RSS); const float* g_final = a.in[22]; float* out = a.out;
    for (int row = gw; row < MTOK; row += NGW) {
        float ss = rss[(size_t)row * 16 + (lane & 15)];
        ss += __shfl_xor(ss, 1); ss += __shfl_xor(ss, 2); ss += __shfl_xor(ss, 4); ss += __shfl_xor(ss, 8);
        const float rstd = __builtin_amdgcn_rsqf(ss * (1.f / 1024.f) + 1e-6f);
        f32x4* orow = (f32x4*)(out + (size_t)row * DM) + lane;
#pragma unroll
        for (int j = 0; j < 4; ++j) { const f32x4 g = *((const f32x4*)g_final + lane + 64 * j); const f32x4 v = orow[64 * j]; orow[64 * j] = v * rstd * g; }
    }
}

__global__ void __launch_bounds__(512, 2) fwd_kernel(Args a) {
    extern __shared__ __attribute__((aligned(16))) unsigned char lds_raw[];
    LAS unsigned char* lds = (LAS unsigned char*)lds_raw;
    cg::grid_group grid = cg::this_grid();
    const int tid = threadIdx.x, lane = tid & 63, wave = __builtin_amdgcn_readfirstlane(tid >> 6);
    const int G = gridDim.x, bx = blockIdx.x;
    const int vcu = (G % 8 == 0) ? (bx % 8) * (G / 8) + bx / 8 : bx;
    const int gw = bx * 8 + wave, NGW = G * 8;
    unsigned char* ws = a.ws;

#define PH(k) (!defined(ONLY) || ONLY == (k))
#if !defined(ONLY) || ONLY == 0
    p0_prologue(a, lds, gw, NGW, wave, lane);
#endif
    grid.sync();
#if !defined(ONLY) || ONLY == 1
    p1_hpass(a, lds, G, tid, wave, lane);
#endif
    grid.sync();
#if !defined(ONLY) || ONLY == 2
    {
        pg8::Gemm g{(const bf16_t*)(ws + WS_H), (const bf16_t*)(ws + WS_WIN), MTOK, 7168, 1024}; pg8::StaticOrder S; S.init(MTOK, 7168, G, bx);
        EpiProj E{(bf16_t*)(ws + WS_XA), (bf16_t*)a.out};
        pg8::gemm_phase<EpiProj, pg8::StaticOrder, PG8_ALIGN, PG8_SP2>(lds, g, S, E);
    }
    {
        pg8::Gemm g{(const bf16_t*)(ws + WS_WV), (const bf16_t*)(ws + WS_H), 1024, MTOK, 1024}; pg8::StaticOrder S; S.init(1024, MTOK, G, bx);
        EpiPlain E{(bf16_t*)(ws + WS_VT), MTOK};
        pg8::gemm_phase<EpiPlain, pg8::StaticOrder, PG8_ALIGN, PG8_SP2>(lds, g, S, E);
    }
#endif
    grid.sync();
#if !defined(ONLY) || ONLY == 3
    attn_phase((const bf16_t*)(ws + WS_Q), (const bf16_t*)(ws + WS_K), (const bf16_t*)(ws + WS_VT), (const bf16_t*)(ws + WS_ZB), a.in[18], (bf16_t*)(ws + WS_Q), vcu, G, wave, lane);
#endif
#if !defined(ONLY) || ONLY == 4
    scan_phase<false>(a, lds, gw, NGW, wave, lane);
#endif
    grid.sync();
#if !defined(ONLY) || ONLY == 5
    scan_phase<true>(a, lds, gw, NGW, wave, lane);
#endif
    grid.sync();
#if !defined(ONLY) || ONLY == 6
    {
        pg8::Gemm g{(const bf16_t*)(ws + WS_H), (const bf16_t*)(ws + WS_WPA), MTOK, 1024, 1024}; pg8::StaticOrder S; S.init(MTOK, 1024, G, bx);
        EpiGate<false> E{(const bf16_t*)a.out, nullptr, (bf16_t*)(ws + WS_K)};
        pg8::gemm_phase<EpiGate<false>, pg8::StaticOrder, PG8_ALIGN, PG8_SP2>(lds, g, S, E);
    }
    __threadfence();
    {
        pg8::Gemm g{(const bf16_t*)(ws + WS_Q), (const bf16_t*)(ws + WS_WPB), MTOK, 1024, 1024}; pg8::StaticOrder S; S.init(MTOK, 1024, G, bx);
        EpiGate<true> E{(const bf16_t*)a.out + ARR, (const bf16_t*)(ws + WS_K), (bf16_t*)(ws + WS_XA)};
        pg8::gemm_phase<EpiGate<true>, pg8::StaticOrder, PG8_ALIGN, PG8_SP2>(lds, g, S, E);
    }
#endif
    grid.sync();
#if !defined(ONLY) || ONLY == 7
    {
        pg8::Gemm g{(const bf16_t*)(ws + WS_XA), (const bf16_t*)(ws + WS_WO), MTOK, 1024, 1024}; pg8::StaticOrder S; S.init(MTOK, 1024, G, bx);
        EpiOut E{a.in[0], (const float*)(ws + WS_GATE), a.out, (float*)(ws + WS_RSS)};
        pg8::gemm_phase<EpiOut, pg8::StaticOrder, PG8_ALIGN, PG8_SP2>(lds, g, S, E);
    }
#endif
    grid.sync();
#if !defined(ONLY) || ONLY == 8
    final_norm(a, gw, NGW, lane);
#endif
}

extern "C" void kernel_launch(void* const* d_in, const int* in_sizes, int n_in, void* d_out, int out_size, void* d_ws, size_t ws_size, hipStream_t stream) {
    static int grid = 0;
    if (grid == 0) {
        if (n_in != 23 || out_size != MTOK * DM || ws_size < 256 * MiB) { fprintf(stderr, "kernel_launch: unexpected problem shape (n_in %d, out %d, ws %zu)\n", n_in, out_size, ws_size); grid = -1; return; }
        int dev = 0, cus = 0, per_cu = 0;
        (void)hipGetDevice(&dev);
        (void)hipDeviceGetAttribute(&cus, hipDeviceAttributeMultiprocessorCount, dev);
        if (hipFuncSetAttribute((const void*)fwd_kernel, hipFuncAttributeMaxDynamicSharedMemorySize, LDS_BYTES) != hipSuccess) { fprintf(stderr, "kernel_launch: hipFuncSetAttribute failed\n"); grid = -1; return; }
        if (hipOccupancyMaxActiveBlocksPerMultiprocessor(&per_cu, (const void*)fwd_kernel, 512, LDS_BYTES) != hipSuccess || per_cu < 1) { fprintf(stderr, "kernel_launch: occupancy query failed (%d)\n", per_cu); per_cu = 1; (void)hipGetLastError(); }
        grid = cus * per_cu;
        if (grid <= 0) { grid = -1; return; }
    }
    if (grid < 0) return;
    Args a{};
    for (int i = 0; i < 23; ++i) a.in[i] = (const float*)d_in[i];
    a.out = (float*)d_out; a.ws = (unsigned char*)d_ws;
    void* args[] = {&a};
    hipError_t e = hipLaunchCooperativeKernel((const void*)fwd_kernel, dim3(grid), dim3(512), args, LDS_BYTES, stream);
    if (e != hipSuccess) fprintf(stderr, "kernel_launch: cooperative launch failed: %s (grid %d)\n", hipGetErrorString(e), grid);
}
```

```cpp
#include <hip/hip_runtime.h>
#include <hip/hip_cooperative_groups.h>
#include <cstdio>
#include <cstdint>
namespace cg = cooperative_groups;
namespace pg8 {
#define PG8_LAS __attribute__((address_space(3)))
typedef unsigned short bf16_t;
typedef short bf16x8 __attribute__((ext_vector_type(8)));
typedef float f32x4 __attribute__((ext_vector_type(4)));
typedef unsigned u32x4 __attribute__((ext_vector_type(4)));
constexpr int BM = 256, BK = 64, HALF = 128, HTB = HALF * BK * 2  , STAGE_BYTES = 8 * HTB, NXCD = 8, WGM = 8;

__host__ __device__ __forceinline__ int lds_byte(int r, int c) { const int st = (r >> 4) * 2 + (c >> 5), rr = r & 15, cc = c & 31, ob = rr * 64 + cc * 2; return st * 1024 + (ob ^ (((ob >> 9) & 1) << 5)); }
__host__ __device__ __forceinline__ void stage_rc(int b, int& R, int& C) { const int st = b / 1024, sb = b % 1024, swz = sb ^ (((sb >> 9) & 1) << 5); R = (st >> 1) * 16 + swz / 64; C = (st & 1) * 32 + (swz % 64) / 2; }
__host__ __device__ __forceinline__ int perm32(int rho) { const int n = rho >> 4, i = rho & 15; return 8 * (i >> 2) + 4 * n + (i & 3); }

struct Unit { int pm, pn; };
struct Gemm { const bf16_t* A; const bf16_t* Bt; int M, N, K; };

struct StaticOrder {
    int nM, nN, nwg, G, c;
    __host__ __device__ void init(int M, int N, int G_, int c_) { nM = M / BM; nN = N / BM; nwg = nM * nN; G = G_; c = c_; }
    __host__ __device__ bool next(int i, Unit& u) const {
        const long L = (long)i * G + c; if (L >= nwg) return false;
        int wgid = (int)L; { const int q = nwg / NXCD, r = nwg % NXCD, xcd = wgid % NXCD, off = wgid / NXCD; wgid = (xcd < r ? xcd * (q + 1) : r * (q + 1) + (xcd - r) * q) + off; }
        const int nig = WGM * nN, gid = wgid / nig, fm = gid * WGM, gsz = (nM - fm) < WGM ? (nM - fm) : WGM;
        u.pm = fm + ((wgid % nig) % gsz); u.pn = (wgid % nig) / gsz; return true;
    }
    __device__ __forceinline__ void a_ready(const Unit&) const {}
    __device__ __forceinline__ void done(const Unit&) const {}
};
__device__ __forceinline__ unsigned cvt_pk_bf16(float lo, float hi) { unsigned r; asm volatile("v_cvt_pk_bf16_f32 %0, %1, %2" : "=v"(r) : "v"(lo), "v"(hi)); return r; }
typedef float f32x2 __attribute__((ext_vector_type(2)));
template <class Epi, class Sched, bool ALIGN_EPI = false, bool SP2 = false>
__device__ __forceinline__ void gemm_phase(PG8_LAS unsigned char* lds, const Gemm g, const Sched& S, const Epi& E) {
    const int tid = threadIdx.x, wid = __builtin_amdgcn_readfirstlane(tid >> 6), lane = tid & 63, wr = wid >> 2, wc = wid & 3, fr = lane & 15, fq = lane >> 4;
    const int K = g.K, nt = K / BK;
    unsigned voffA[2], voffB[2];
#pragma unroll
    for (int i = 0; i < 2; ++i) { int R, C; stage_rc(tid * 16 + i * 8192, R, C); const int Rb = Epi::PERM ? ((R & ~31) + perm32(R & 31)) : R;
        voffA[i] = (unsigned)(R * K + C) * 2u; voffB[i] = (unsigned)(Rb * K + C) * 2u; }
    const size_t kstep = (size_t)(BK * 2);
    const size_t hstep = (size_t)HALF * K * 2;
    const size_t tstep = 2 * hstep;
    const unsigned ldsw = (unsigned)wid * 1024u;
    const int aoff = lds_byte(wr * 64 + fr, fq * 8), boff = lds_byte(wc * 32 + fr, fq * 8);
#define PG8_SA(b, h) (((b) * 2 + (h)) * HTB)
#define PG8_SB(b, h) ((4 + (b) * 2 + (h)) * HTB)
#define PG8_STAGE(bufoff, gbase, voff) do { _Pragma("unroll") for (int _i = 0; _i < 2; ++_i) \
        __builtin_amdgcn_global_load_lds((const unsigned*)((const char*)(gbase) + (voff)[_i]), (PG8_LAS unsigned*)(lds + (bufoff) + ldsw + _i * 8192), 16, 0, 0); } while (0)
#define PG8_LDA(dst, b, h) do { _Pragma("unroll") for (int m = 0; m < 4; ++m) _Pragma("unroll") for (int k = 0; k < 2; ++k) dst[m][k] = *(const PG8_LAS bf16x8*)(lds + PG8_SA(b, h) + aoff + m * 2048 + k * 1024); } while (0)
#define PG8_LDB(dst, b, h) do { _Pragma("unroll") for (int n = 0; n < 2; ++n) _Pragma("unroll") for (int k = 0; k < 2; ++k) dst[n][k] = *(const PG8_LAS bf16x8*)(lds + PG8_SB(b, h) + boff + n * 2048 + k * 1024); } while (0)
#define PG8_MMA(ai, bj, At, Bt) do { __builtin_amdgcn_s_setprio(1); _Pragma("unroll") for (int m = 0; m < 4; ++m) _Pragma("unroll") for (int n = 0; n < 2; ++n) _Pragma("unroll") for (int k = 0; k < 2; ++k) \
        acc[ai][bj][m][n] = __builtin_amdgcn_mfma_f32_16x16x32_bf16(Bt[n][k], At[m][k], acc[ai][bj][m][n], 0, 0, 0); __builtin_amdgcn_s_setprio(0); } while (0)
#define PG8_WAIT_V(n) asm volatile("s_waitcnt vmcnt(" #n ")" ::: "memory")
#define PG8_WAIT_L(n) asm volatile("s_waitcnt lgkmcnt(" #n ")" ::: "memory")
#define PG8_BAR __builtin_amdgcn_s_barrier()
#define PG8_SCHED __builtin_amdgcn_sched_barrier(0)
    Unit cur, nxt; int ui = 0;
    if (!S.next(0, cur)) return;
    f32x4 acc[2][2][4][2];
#pragma unroll
    for (int a = 0; a < 2; ++a)
#pragma unroll
        for (int b = 0; b < 2; ++b)
#pragma unroll
            for (int m = 0; m < 4; ++m)
#pragma unroll
                for (int n = 0; n < 2; ++n) acc[a][b][m][n] = (f32x4){0.f, 0.f, 0.f, 0.f};
    bf16x8 At[4][2], B0[2][2], B1[2][2];
    const char* cA = (const char*)g.A + (size_t)cur.pm * tstep; const char* cB = (const char*)g.Bt + (size_t)cur.pn * tstep;
    S.a_ready(cur);
    if constexpr (SP2) {
        PG8_STAGE(PG8_SB(0, 0), cB, voffB); PG8_STAGE(PG8_SB(0, 1), cB + hstep, voffB); PG8_STAGE(PG8_SA(0, 0), cA, voffA); PG8_STAGE(PG8_SA(0, 1), cA + hstep, voffA);
        if (wr == 1) PG8_BAR;
        PG8_WAIT_V(2); PG8_BAR;
        PG8_STAGE(PG8_SB(1, 0), cB + kstep, voffB); PG8_STAGE(PG8_SA(1, 0), cA + kstep, voffA); PG8_STAGE(PG8_SB(1, 1), cB + hstep + kstep, voffB);
        PG8_WAIT_V(6); PG8_BAR;
    } else {
        PG8_STAGE(PG8_SB(0, 0), cB, voffB); PG8_STAGE(PG8_SA(0, 0), cA, voffA); PG8_STAGE(PG8_SB(0, 1), cB + hstep, voffB); PG8_STAGE(PG8_SA(0, 1), cA + hstep, voffA);
        if (wr == 1) PG8_BAR;
        PG8_WAIT_V(4); PG8_BAR;
        PG8_STAGE(PG8_SB(1, 0), cB + kstep, voffB); PG8_STAGE(PG8_SA(1, 0), cA + kstep, voffA); PG8_STAGE(PG8_SB(1, 1), cB + hstep + kstep, voffB);
        PG8_WAIT_V(6); PG8_BAR;
    }
    for (;;) {
        const bool has_next = S.next(ui + 1, nxt);
        const char* nA = has_next ? (const char*)g.A + (size_t)nxt.pm * tstep : cA; const char* nB = has_next ? (const char*)g.Bt + (size_t)nxt.pn * tstep : cB;
        for (int t = 0; t < nt; t += 2) {
            const bool last = (t == nt - 2);
            const char* a1 = cA + (size_t)(t + 1) * kstep;
            const char* a2 = last ? nA : cA + (size_t)(t + 2) * kstep; const char* b2 = last ? nB : cB + (size_t)(t + 2) * kstep;
            const char* a3 = a2 + kstep; const char* b3 = b2 + kstep;
            if (last && has_next) S.a_ready(nxt);
            if constexpr (SP2) {
            PG8_LDB(B0, 0, 0); PG8_LDB(B1, 0, 1); PG8_SCHED; PG8_LDA(At, 0, 0); PG8_STAGE(PG8_SA(1, 1), a1 + hstep, voffA);
            PG8_WAIT_V(8); PG8_WAIT_L(0); PG8_BAR; PG8_MMA(0, 0, At, B0); PG8_MMA(0, 1, At, B1); PG8_BAR; PG8_SCHED;
            PG8_LDA(At, 0, 1); PG8_STAGE(PG8_SB(0, 0), b2, voffB); PG8_STAGE(PG8_SB(0, 1), b2 + hstep, voffB); PG8_STAGE(PG8_SA(0, 0), a2, voffA);
            PG8_WAIT_V(8); PG8_WAIT_L(0); PG8_BAR; PG8_MMA(1, 0, At, B0); PG8_MMA(1, 1, At, B1); PG8_BAR; PG8_SCHED;
            PG8_LDB(B0, 1, 0); PG8_LDB(B1, 1, 1); PG8_SCHED; PG8_LDA(At, 1, 0); PG8_STAGE(PG8_SA(0, 1), a2 + hstep, voffA);
            PG8_WAIT_V(8); PG8_WAIT_L(0); PG8_BAR; PG8_MMA(0, 0, At, B0); PG8_MMA(0, 1, At, B1); PG8_BAR; PG8_SCHED;
            PG8_LDA(At, 1, 1); PG8_STAGE(PG8_SB(1, 0), b3, voffB); PG8_STAGE(PG8_SB(1, 1), b3 + hstep, voffB); PG8_STAGE(PG8_SA(1, 0), a3, voffA);
            PG8_WAIT_V(8); PG8_WAIT_L(0); PG8_BAR; PG8_MMA(1, 0, At, B0); PG8_MMA(1, 1, At, B1); PG8_BAR; PG8_SCHED;
            } else {
            PG8_LDB(B0, 0, 0); PG8_SCHED; PG8_LDA(At, 0, 0); PG8_STAGE(PG8_SA(1, 1), a1 + hstep, voffA);
            PG8_WAIT_L(8); PG8_BAR; PG8_WAIT_L(0); PG8_MMA(0, 0, At, B0); PG8_BAR; PG8_SCHED;
            PG8_LDB(B1, 0, 1); PG8_STAGE(PG8_SB(0, 0), b2, voffB);
            PG8_BAR; PG8_WAIT_L(0); PG8_MMA(0, 1, At, B1); PG8_BAR;
            PG8_LDA(At, 0, 1); PG8_STAGE(PG8_SA(0, 0), a2, voffA);
            PG8_BAR; PG8_WAIT_L(0); PG8_MMA(1, 0, At, B0); PG8_BAR; PG8_SCHED;
            PG8_STAGE(PG8_SB(0, 1), b2 + hstep, voffB);
            PG8_WAIT_V(6); PG8_BAR; PG8_MMA(1, 1, At, B1); PG8_BAR;
            PG8_LDB(B0, 1, 0); PG8_SCHED; PG8_LDA(At, 1, 0); PG8_STAGE(PG8_SA(0, 1), a2 + hstep, voffA);
            PG8_WAIT_L(8); PG8_BAR; PG8_WAIT_L(0); PG8_MMA(0, 0, At, B0); PG8_BAR; PG8_SCHED;
            PG8_LDB(B1, 1, 1); PG8_STAGE(PG8_SB(1, 0), b3, voffB);
            PG8_BAR; PG8_WAIT_L(0); PG8_MMA(0, 1, At, B1); PG8_BAR;
            PG8_LDA(At, 1, 1); PG8_STAGE(PG8_SA(1, 0), a3, voffA);
            PG8_BAR; PG8_WAIT_L(0); PG8_MMA(1, 0, At, B0); PG8_BAR; PG8_SCHED;
            PG8_STAGE(PG8_SB(1, 1), b3 + hstep, voffB);
            PG8_WAIT_V(6); PG8_BAR; PG8_MMA(1, 1, At, B1); PG8_BAR;
            }
        }
        if constexpr (ALIGN_EPI) { if (wr == 0) PG8_BAR; }
        if constexpr (!Epi::AFTER_DRAIN) { E(acc, cur, wr, wc, fr, fq); S.done(cur); }
        if (!has_next) break;
#pragma unroll
        for (int a = 0; a < 2; ++a)
#pragma unroll
            for (int b = 0; b < 2; ++b)
#pragma unroll
                for (int m = 0; m < 4; ++m)
#pragma unroll
                    for (int n = 0; n < 2; ++n) acc[a][b][m][n] = (f32x4){0.f, 0.f, 0.f, 0.f};
        cur = nxt; cA = nA; cB = nB; ++ui;
        if constexpr (ALIGN_EPI) { if (wr == 1) PG8_BAR; }
    }
    PG8_WAIT_V(0);
    if constexpr (!ALIGN_EPI) { if (wr == 0) PG8_BAR; }
    PG8_BAR;
    if constexpr (Epi::AFTER_DRAIN) { E.fused(acc, cur, wr, wc, fr, fq, lds, wid, lane); S.done(cur); }
#undef PG8_SA
#undef PG8_SB
#undef PG8_STAGE
#undef PG8_LDA
#undef PG8_LDB
#undef PG8_MMA
#undef PG8_WAIT_V
#undef PG8_WAIT_L
#undef PG8_BAR
#undef PG8_SCHED
}
}
#ifndef PG8_SP2
#define PG8_SP2 true
#endif
#ifndef PG8_ALIGN
#define PG8_ALIGN true
#endif

#define LAS __attribute__((address_space(3)))
typedef unsigned short bf16_t;
typedef short bf16x8 __attribute__((ext_vector_type(8)));
typedef short bf16x4 __attribute__((ext_vector_type(4)));
typedef float f32x4 __attribute__((ext_vector_type(4)));
typedef float f32x16 __attribute__((ext_vector_type(16)));
typedef unsigned u32x4 __attribute__((ext_vector_type(4)));
typedef unsigned u32x2 __attribute__((ext_vector_type(2)));

constexpr int MTOK = 16384, DM = 1024, SEQ = 4096, NB = 4;
constexpr size_t MiB = 1u << 20;
constexpr size_t ARR = (size_t)MTOK * DM;
constexpr size_t WS_MODP = 0;
constexpr size_t WS_GATE = 786432;
constexpr size_t WS_AGG = 1 * MiB;
constexpr size_t WS_RSS = 5 * MiB;
constexpr size_t WS_WG = 6 * MiB;
constexpr size_t WS_WPA = 8 * MiB, WS_WPB = 10 * MiB, WS_WO = 12 * MiB, WS_WV = 14 * MiB;
constexpr size_t WS_WIN = 16 * MiB;
constexpr size_t WS_H = 32 * MiB;
constexpr size_t WS_XA = 64 * MiB, WS_ZA = 96 * MiB, WS_Q = 128 * MiB, WS_K = 160 * MiB, WS_ZB = 192 * MiB;
constexpr size_t WS_VT = 224 * MiB;
constexpr size_t WS_BAR = 802816;
constexpr int LDS_CIN = 131072, LDS_SEG = 131072 + 8192, LDS_MISC = 131072 + 12288;
constexpr int LDS_BYTES = 131072 + 12288 + 256;

__device__ __forceinline__ float bf2f(unsigned short b) { return __uint_as_float(((unsigned)b) << 16); }
__device__ __forceinline__ unsigned pk2(float lo, float hi) { return pg8::cvt_pk_bf16(lo, hi); }
__device__ __forceinline__ float sigm(float v) { return __builtin_amdgcn_rcpf(1.f + __builtin_amdgcn_exp2f(-1.44269504089f * v)); }
__device__ __forceinline__ float wave_sum(float v) {
#pragma unroll
    for (int o = 1; o < 64; o <<= 1) v += __shfl_xor(v, o);
    return v;
}
#define LDS_WAIT() asm volatile("s_waitcnt lgkmcnt(0)" ::: "memory")

struct EpiProj {
    static constexpr bool PERM = true, AFTER_DRAIN = false;
    bf16_t* O5; bf16_t* OG;
    __device__ __forceinline__ void operator()(const f32x4 (&acc)[2][2][4][2], const pg8::Unit& u, int wr, int wc, int fr, int fq) const {
        const int arr = u.pn >> 2, colt = (u.pn & 3) * 256;
        bf16_t* base = arr < 5 ? O5 + (size_t)arr * ARR : OG + (size_t)(arr - 5) * ARR;
        const int mode = (arr == 1 || arr == 4) ? 1 : (arr >= 5 ? 2 : (arr == 2 ? 3 : 0));
        const int row0 = u.pm * 256 + wr * 64 + fr, col0 = colt + wc * 32 + 8 * fq;
#pragma unroll
        for (int ai = 0; ai < 2; ++ai)
#pragma unroll
            for (int m = 0; m < 4; ++m) { bf16_t* rowp = base + (size_t)(row0 + ai * 128 + m * 16) * DM + col0;
#pragma unroll
                for (int bj = 0; bj < 2; ++bj) { f32x4 v0 = acc[ai][bj][m][0], v1 = acc[ai][bj][m][1];
                    if (mode == 1) {
#pragma unroll
                        for (int j = 0; j < 4; ++j) { v0[j] = v0[j] * sigm(v0[j]); v1[j] = v1[j] * sigm(v1[j]); } }
                    else if (mode == 2) {
#pragma unroll
                        for (int j = 0; j < 4; ++j) { v0[j] = sigm(v0[j]); v1[j] = sigm(v1[j]); } }
                    else if (mode == 3) { v0 = v0 * 0.125f; v1 = v1 * 0.125f; }
                    u32x4 w; w.x = pk2(v0[0], v0[1]); w.y = pk2(v0[2], v0[3]); w.z = pk2(v1[0], v1[1]); w.w = pk2(v1[2], v1[3]);
                    *(u32x4*)(rowp + bj * 128) = w; } }
    }
};
struct EpiPlain {
    static constexpr bool PERM = true, AFTER_DRAIN = false;
    bf16_t* O; int ldc;
    __device__ __forceinline__ void operator()(const f32x4 (&acc)[2][2][4][2], const pg8::Unit& u, int wr, int wc, int fr, int fq) const {
        const int row0 = u.pm * 256 + wr * 64 + fr, col0 = u.pn * 256 + wc * 32 + 8 * fq;
#pragma unroll
        for (int ai = 0; ai < 2; ++ai)
#pragma unroll
            for (int m = 0; m < 4; ++m) { bf16_t* rowp = O + (size_t)(row0 + ai * 128 + m * 16) * ldc + col0;
#pragma unroll
                for (int bj = 0; bj < 2; ++bj) { const f32x4 v0 = acc[ai][bj][m][0], v1 = acc[ai][bj][m][1];
                    u32x4 w; w.x = pk2(v0[0], v0[1]); w.y = pk2(v0[2], v0[3]); w.z = pk2(v1[0], v1[1]); w.w = pk2(v1[2], v1[3]);
                    *(u32x4*)(rowp + bj * 128) = w; } }
    }
};
template <bool HAS_T> struct EpiGate {
    static constexpr bool PERM = true, AFTER_DRAIN = false;
    const bf16_t* G; const bf16_t* Tin; bf16_t* O;
    __device__ __forceinline__ void operator()(const f32x4 (&acc)[2][2][4][2], const pg8::Unit& u, int wr, int wc, int fr, int fq) const {
        const int row0 = u.pm * 256 + wr * 64 + fr, col0 = u.pn * 256 + wc * 32 + 8 * fq;
#pragma unroll
        for (int ai = 0; ai < 2; ++ai)
#pragma unroll
            for (int m = 0; m < 4; ++m) { const size_t off = (size_t)(row0 + ai * 128 + m * 16) * DM + col0;
#pragma unroll
                for (int bj = 0; bj < 2; ++bj) { const f32x4 v0 = acc[ai][bj][m][0], v1 = acc[ai][bj][m][1];
                    const bf16x8 g = *(const bf16x8*)(G + off + bj * 128);
                    float o[8];
#pragma unroll
                    for (int j = 0; j < 4; ++j) { o[j] = bf2f((unsigned short)g[j]) * v0[j]; o[4 + j] = bf2f((unsigned short)g[4 + j]) * v1[j]; }
                    if (HAS_T) { const bf16x8 t = *(const bf16x8*)(Tin + off + bj * 128);
#pragma unroll
                        for (int j = 0; j < 8; ++j) o[j] += bf2f((unsigned short)t[j]); }
                    u32x4 w; w.x = pk2(o[0], o[1]); w.y = pk2(o[2], o[3]); w.z = pk2(o[4], o[5]); w.w = pk2(o[6], o[7]);
                    *(u32x4*)(O + off + bj * 128) = w; } }
    }
};
struct EpiOut {
    static constexpr bool PERM = false, AFTER_DRAIN = false;
    const float* X; const float* gate; float* out; float* rss;
    __device__ __forceinline__ void operator()(const f32x4 (&acc)[2][2][4][2], const pg8::Unit& u, int wr, int wc, int fr, int fq) const {
        const int row0 = u.pm * 256 + wr * 64 + fr, col0 = u.pn * 256 + wc * 32 + 4 * fq;
        const float* gp = gate + (size_t)(u.pm >> 4) * DM + col0;
        f32x4 gv[2][2];
#pragma unroll
        for (int bj = 0; bj < 2; ++bj)
#pragma unroll
            for (int n = 0; n < 2; ++n) gv[bj][n] = *(const f32x4*)(gp + bj * 128 + n * 16);
#pragma unroll
        for (int ai = 0; ai < 2; ++ai)
#pragma unroll
            for (int m = 0; m < 4; ++m) { const int row = row0 + ai * 128 + m * 16; const size_t off = (size_t)row * DM + col0; float ss = 0.f;
#pragma unroll
                for (int bj = 0; bj < 2; ++bj)
#pragma unroll
                    for (int n = 0; n < 2; ++n) { const f32x4 xv = *(const f32x4*)(X + off + bj * 128 + n * 16); const f32x4 o = xv + gv[bj][n] * acc[ai][bj][m][n];
                        ss += (o[0] * o[0] + o[1] * o[1]) + (o[2] * o[2] + o[3] * o[3]); *(f32x4*)(out + off + bj * 128 + n * 16) = o; }
                ss += __shfl_xor(ss, 16); ss += __shfl_xor(ss, 32);
                if (fq == 0) rss[(size_t)row * 16 + u.pn * 4 + wc] = ss; }
    }
};

__device__ __forceinline__ void p0_transpose_item(const float* W, int K, int N, bf16_t* WT, int dst_row0, int k0, int n0, LAS float* scr, int lane) {
#pragma unroll 8
    for (int i = 0; i < 32; ++i) { const int kk = 2 * i + (lane >> 5); scr[kk * 33 + (lane & 31)] = W[(size_t)(k0 + kk) * N + n0 + (lane & 31)]; }
    LDS_WAIT(); asm volatile("" ::: "memory");
    const int c = lane & 7;
#pragma unroll
    for (int j = 0; j < 4; ++j) { const int n = (lane >> 3) + 8 * j; const LAS float* s = scr + (8 * c) * 33 + n;
        u32x4 o; o.x = pk2(s[0 * 33], s[1 * 33]); o.y = pk2(s[2 * 33], s[3 * 33]); o.z = pk2(s[4 * 33], s[5 * 33]); o.w = pk2(s[6 * 33], s[7 * 33]);
        *(u32x4*)(WT + (size_t)(dst_row0 + n) * K + k0 + 8 * c) = o; }
    LDS_WAIT(); asm volatile("" ::: "memory");
}

struct Args { const float* in[23]; float* out; unsigned char* ws; };

__device__ __forceinline__ void p0_prologue(const Args& a, LAS unsigned char* lds, int gw, int NGW, int wave, int lane) {
    LAS float* scr = (LAS float*)(lds + wave * 16384);
    unsigned char* ws = a.ws;
    const float* c = a.in[1]; const float* w_c = a.in[3]; const float* w_in = a.in[5];
    float* modp = (float*)(ws + WS_MODP);
    constexpr int I_MOD = 768, I_IN = 16 * 256, I_SQ = 16 * 32, I_G = 4 * 16 * 2;
    constexpr int NITEMS = I_MOD + I_IN + 3 * I_SQ + I_G;
    for (int it = gw; it < NITEMS; it += NGW) {
        int r = it;
        if (r < I_MOD) {
            const int cgi = r % 48, kc = r / 48, col = cgi * 64 + lane, k0 = kc * 64;
            float sv[4];
#pragma unroll
            for (int b = 0; b < 4; ++b) { const float cv = c[b * DM + k0 + lane]; sv[b] = cv * sigm(cv); }
            float acc[4] = {0.f, 0.f, 0.f, 0.f};
#pragma unroll 8
            for (int kk = 0; kk < 64; ++kk) { const float w = w_c[(size_t)(k0 + kk) * 3072 + col];
#pragma unroll
                for (int b = 0; b < 4; ++b) acc[b] += __shfl(sv[b], kk) * w; }
#pragma unroll
            for (int b = 0; b < 4; ++b) modp[(size_t)(kc * 4 + b) * 3072 + col] = acc[b];
            continue;
        }
        r -= I_MOD;
        if (r < I_IN) { const int kb = r / 256, nb = r % 256, n0 = nb * 32, cb = n0 >> 10;
            if (cb == 4) p0_transpose_item(w_in, 1024, 8192, (bf16_t*)(ws + WS_WV), n0 - 4096, kb * 64, n0, scr, lane);
            else p0_transpose_item(w_in, 1024, 8192, (bf16_t*)(ws + WS_WIN), (cb < 4 ? cb : cb - 1) * 1024 + (n0 & 1023), kb * 64, n0, scr, lane);
            continue; }
        r -= I_IN;
        if (r < 3 * I_SQ) { const int which = r / I_SQ, rr = r % I_SQ, kb = rr / 32, nb = rr % 32;
            const float* W = which == 0 ? a.in[19] : (which == 1 ? a.in[20] : a.in[21]);
            bf16_t* WT = (bf16_t*)(ws + (which == 0 ? WS_WPA : (which == 1 ? WS_WPB : WS_WO)));
            p0_transpose_item(W, 1024, 1024, WT, nb * 32, kb * 64, nb * 32, scr, lane);
            continue; }
        r -= 3 * I_SQ;
        { const int g = r / 32, rr = r % 32, hb = rr / 2, nb = rr % 2;
            const float* W = (g == 0 ? a.in[8] : (g == 1 ? a.in[10] : (g == 2 ? a.in[13] : a.in[15]))) + (size_t)hb * 4096;
            bf16_t* WT = (bf16_t*)(ws + WS_WG) + (size_t)(g * 16 + hb) * 4096;
            p0_transpose_item(W, 64, 64, WT, nb * 32, 0, nb * 32, scr, lane); }
    }
}

__device__ __forceinline__ void p1_hpass(const Args& a, LAS unsigned char* lds, int G, int tid, int wave, int lane) {
    unsigned char* ws = a.ws;
    const float* x = a.in[0]; const float* g_pre = a.in[2]; const float* b_c = a.in[4];
    const float* modp = (const float*)(ws + WS_MODP);
    bf16_t* H = (bf16_t*)(ws + WS_H);
    LAS float* sh = (LAS float*)lds;
    for (int rb = blockIdx.x; rb < MTOK / 64; rb += G) {
        const int b = rb >> 6;
        __syncthreads();
        for (int idx = tid; idx < 2048; idx += 512) { float s = b_c[idx];
#pragma unroll
            for (int kc = 0; kc < 16; ++kc) s += modp[(size_t)(kc * 4 + b) * 3072 + idx];
            sh[idx] = idx < 1024 ? s : 1.f + s; }
        __syncthreads();
        for (int rr = wave; rr < 64; rr += 8) { const int row = rb * 64 + rr;
            const f32x4* xr = (const f32x4*)(x + (size_t)row * DM) + lane;
            f32x4 v[4]; float s = 0.f;
#pragma unroll
            for (int j = 0; j < 4; ++j) { v[j] = xr[64 * j]; s += (v[j][0] * v[j][0] + v[j][1] * v[j][1]) + (v[j][2] * v[j][2] + v[j][3] * v[j][3]); }
            const float rstd = __builtin_amdgcn_rsqf(wave_sum(s) * (1.f / 1024.f) + 1e-6f);
#pragma unroll
            for (int j = 0; j < 4; ++j) { const int col = 4 * lane + 256 * j;
                const f32x4 g = *(const f32x4*)(g_pre + col); const f32x4 sc = *(const LAS f32x4*)(sh + 1024 + col); const f32x4 sf = *(const LAS f32x4*)(sh + col);
                const f32x4 o = (v[j] * rstd) * g * sc + sf;
                u32x2 w; w.x = pk2(o[0], o[1]); w.y = pk2(o[2], o[3]);
                *(u32x2*)(H + (size_t)row * DM + col) = w; }
        }
    }
    float* gate = (float*)(ws + WS_GATE);
    for (int idx = blockIdx.x * 512 + tid; idx < 4096; idx += G * 512) { const int b = idx >> 10, col = idx & 1023; float s = b_c[2048 + col];
#pragma unroll
        for (int kc = 0; kc < 16; ++kc) s += modp[(size_t)(kc * 4 + b) * 3072 + 2048 + col];
        gate[idx] = s; }
}

__device__ __forceinline__ void attn_phase(const bf16_t* Q, const bf16_t* Kb, const bf16_t* VT, const bf16_t* ZB, const float* rpb, bf16_t* YB, int vcu, int G, int wave, int lane) {
    const int fr = lane & 15, fq = lane >> 4;
    constexpr int NQ = 4 * 64 * 16 * 4;
    constexpr float L2E = 1.44269504089f;
    for (int qi = vcu * 8 + wave; qi < NQ; qi += G * 8) {
        const int j = qi & 3, item = qi >> 2, r = item & 63, hb = item >> 6, h = hb & 15, b = hb >> 4;
        const int r0 = min(max(r - 4, 0), 56);
        const int cs = min(max(16 * j - 8, 0), 32);
        const int qc = 16 * j + fr, c0 = min(max(qc - 8, 0), 48);
        const size_t tokq = (size_t)b * SEQ + r * 64 + qc;
        bf16x8 qf[2];
#pragma unroll
        for (int ks = 0; ks < 2; ++ks) qf[ks] = *(const bf16x8*)(Q + tokq * DM + h * 64 + ks * 32 + fq * 8);
        f32x4 s[8][2];
#pragma unroll
        for (int w = 0; w < 8; ++w) { const size_t tokrow = (size_t)b * SEQ + (size_t)(r0 + w) * 64;
#pragma unroll
            for (int t = 0; t < 2; ++t) { const int kc = cs + 8 * (fr >> 2) + (fr & 3) + 4 * t;
                f32x4 acc = {0.f, 0.f, 0.f, 0.f};
#pragma unroll
                for (int ks = 0; ks < 2; ++ks) { const bf16x8 kf = *(const bf16x8*)(Kb + (tokrow + kc) * DM + h * 64 + ks * 32 + fq * 8);
                    acc = __builtin_amdgcn_mfma_f32_16x16x32_bf16(kf, qf[ks], acc, 0, 0, 0); }
                s[w][t] = acc; } }
        float mx = -1e30f;
#pragma unroll
        for (int w = 0; w < 8; ++w) { const float* rp = rpb + (size_t)(h * 15 + (r0 + w - r + 7)) * 31;
#pragma unroll
            for (int t = 0; t < 2; ++t)
#pragma unroll
                for (int i = 0; i < 4; ++i) { const int kcol = cs + 8 * fq + 4 * t + i; const bool ok = (kcol >= c0) && (kcol < c0 + 16);
                    const int dcol = min(max(kcol - qc + 15, 0), 30);
                    const float v = ok ? (s[w][t][i] + rp[dcol]) * L2E : -1e30f; s[w][t][i] = v; mx = fmaxf(mx, v); } }
        mx = fmaxf(mx, __shfl_xor(mx, 16)); mx = fmaxf(mx, __shfl_xor(mx, 32));
        float sum = 0.f; bf16x8 pf[8];
#pragma unroll
        for (int w = 0; w < 8; ++w) { float p[8];
#pragma unroll
            for (int t = 0; t < 2; ++t)
#pragma unroll
                for (int i = 0; i < 4; ++i) { const float e = __builtin_amdgcn_exp2f(s[w][t][i] - mx); p[4 * t + i] = e; sum += e; }
            u32x4 pw; pw.x = pk2(p[0], p[1]); pw.y = pk2(p[2], p[3]); pw.z = pk2(p[4], p[5]); pw.w = pk2(p[6], p[7]);
            pf[w] = __builtin_bit_cast(bf16x8, pw); }
        sum += __shfl_xor(sum, 16); sum += __shfl_xor(sum, 32);
        const float inv = 1.f / sum;
        f32x4 o[4];
#pragma unroll
        for (int dt = 0; dt < 4; ++dt) o[dt] = (f32x4){0.f, 0.f, 0.f, 0.f};
#pragma unroll
        for (int w = 0; w < 8; ++w) { const size_t tokrow = (size_t)b * SEQ + (size_t)(r0 + w) * 64;
#pragma unroll
            for (int dt = 0; dt < 4; ++dt) { const bf16x8 vf = *(const bf16x8*)(VT + (size_t)(h * 64 + dt * 16 + fr) * MTOK + tokrow + cs + 8 * fq);
                o[dt] = __builtin_amdgcn_mfma_f32_16x16x32_bf16(vf, pf[w], o[dt], 0, 0, 0); } }
#pragma unroll
        for (int dt = 0; dt < 4; ++dt) { const size_t off = tokq * DM + h * 64 + dt * 16 + 4 * fq;
            const bf16x4 z = *(const bf16x4*)(ZB + off);
            u32x2 w; w.x = pk2(o[dt][0] * inv * bf2f((unsigned short)z[0]), o[dt][1] * inv * bf2f((unsigned short)z[1]));
            w.y = pk2(o[dt][2] * inv * bf2f((unsigned short)z[2]), o[dt][3] * inv * bf2f((unsigned short)z[3]));
            *(u32x2*)(YB + off) = w; }
    }
}

template <bool FINAL, int DIR>
__device__ __forceinline__ void scan_dir(const LAS bf16x8* afrL, int lane, int ct, const bf16_t* WGr, const bf16_t* WGi, float br, float bi, float cl, float Hin,
                                         const bf16x8 (&idf)[2], float& Aout, float& Uout, const bf16_t* ZAp, bf16_t* YAp) {
    const int n = lane & 31, hf = lane >> 5;
    bf16x8 Br[4], Bi[4];
#pragma unroll
    for (int kk = 0; kk < 4; ++kk) { Br[kk] = *(const bf16x8*)(WGr + (size_t)(32 * ct + n) * 64 + 16 * kk + 8 * hf); Bi[kk] = *(const bf16x8*)(WGi + (size_t)(32 * ct + n) * 64 + 16 * kk + 8 * hf); }
    float H = Hin, Ap = 1.f;
#pragma unroll 1
    for (int si = 0; si < 4; ++si) { const int s = DIR ? 3 - si : si;
        f32x16 ar, ai, ax;
#pragma unroll
        for (int e = 0; e < 16; ++e) { ar[e] = 0.f; ai[e] = 0.f; ax[e] = 0.f; }
#pragma unroll
        for (int kk = 0; kk < 4; ++kk) { const bf16x8 av = afrL[(s * 4 + kk) * 64 + lane];
            ar = __builtin_amdgcn_mfma_f32_32x32x16_bf16(av, Br[kk], ar, 0, 0, 0); ai = __builtin_amdgcn_mfma_f32_32x32x16_bf16(av, Bi[kk], ai, 0, 0, 0); }
        { const bf16x8 a0 = afrL[(s * 4 + 2 * ct) * 64 + lane], a1 = afrL[(s * 4 + 2 * ct + 1) * 64 + lane];
            ax = __builtin_amdgcn_mfma_f32_32x32x16_bf16(a0, idf[0], ax, 0, 0, 0); ax = __builtin_amdgcn_mfma_f32_32x32x16_bf16(a1, idf[1], ax, 0, 0, 0); }
        const bf16_t* zs = ZAp + (size_t)(16 * s) * DM; bf16_t* ys = YAp + (size_t)(16 * s) * DM;
#pragma unroll
        for (int ei = 0; ei < 16; ++ei) { const int e = DIR ? 15 - ei : ei;
            const float r = sigm(ar[e] + br), ig = sigm(ai[e] + bi);
            const float av = __builtin_amdgcn_exp2f(cl * r);
            const float om = fmaxf(fmaf(-av, av, 1.f), 0.f);
            const float u = __builtin_amdgcn_sqrtf(om) * (ig * ax[e]);
            H = fmaf(av, H, u);
            if (FINAL) {
                if (DIR == 0) ys[(size_t)e * DM] = (bf16_t)(pk2(H, 0.f) & 0xffffu);
                else ys[(size_t)e * DM] = (bf16_t)(pk2((H + bf2f(ys[(size_t)e * DM])) * bf2f(zs[(size_t)e * DM]), 0.f) & 0xffffu); }
            else Ap *= av; }
    }
    Aout = Ap; Uout = H;
}

template <bool FINAL>
__device__ __forceinline__ void scan_phase(const Args& a, LAS unsigned char* lds, int gw, int NGW, int wave, int lane) {
    unsigned char* ws = a.ws;
    const bf16_t* XA = (const bf16_t*)(ws + WS_XA); const bf16_t* ZA = (const bf16_t*)(ws + WS_ZA);
    const bf16_t* WG = (const bf16_t*)(ws + WS_WG);
    const float* conv_w = a.in[6]; const float* conv_b = a.in[7];
    typedef float f32x2 __attribute__((ext_vector_type(2)));
    f32x2* AGG = (f32x2*)(ws + WS_AGG);
    bf16_t* YA = (bf16_t*)(ws + WS_H);
    LAS bf16x8* afrL = (LAS bf16x8*)(lds + wave * 16384);
    const int n = lane & 31, hf = lane >> 5;
    bf16x8 idf[2];
#pragma unroll
    for (int k2 = 0; k2 < 2; ++k2)
#pragma unroll
        for (int jj = 0; jj < 8; ++jj) idf[k2][jj] = (16 * k2 + 8 * hf + jj == n) ? (short)0x3F80 : (short)0;
    for (int wt = gw; wt < 2048; wt += NGW) {
        const int cp = wt & 31, jb = (wt >> 5) & 15, b = wt >> 9, ch0 = jb * 64;
        { const int a_half = (n >> 2) & 1, a_idx = (n & 3) + 4 * (n >> 3), a_chunk = 2 * cp + a_half;
#pragma unroll 1
          for (int kk = 0; kk < 4; ++kk) { const int ch = ch0 + 16 * kk + 8 * hf;
              float cw[4][8], cb[8];
#pragma unroll
              for (int w = 0; w < 4; ++w) { const f32x4 c0 = *(const f32x4*)(conv_w + w * DM + ch), c1 = *(const f32x4*)(conv_w + w * DM + ch + 4);
#pragma unroll
                  for (int jj = 0; jj < 4; ++jj) { cw[w][jj] = c0[jj]; cw[w][4 + jj] = c1[jj]; } }
              { const f32x4 c0 = *(const f32x4*)(conv_b + ch), c1 = *(const f32x4*)(conv_b + ch + 4);
#pragma unroll
                  for (int jj = 0; jj < 4; ++jj) { cb[jj] = c0[jj]; cb[4 + jj] = c1[jj]; } }
#pragma unroll
              for (int s = 0; s < 4; ++s) { const int p = a_chunk * 64 + 16 * s + a_idx;
                  float acc[8];
#pragma unroll
                  for (int jj = 0; jj < 8; ++jj) acc[jj] = cb[jj];
#pragma unroll
                  for (int w = 0; w < 4; ++w) { const int pp = p + w - 2; const bool ok = (pp >= 0) && (pp < SEQ); const int pc = min(max(pp, 0), SEQ - 1);
                      const bf16x8 xv = *(const bf16x8*)(XA + ((size_t)b * SEQ + pc) * DM + ch);
#pragma unroll
                      for (int jj = 0; jj < 8; ++jj) acc[jj] = fmaf(cw[w][jj], ok ? bf2f((unsigned short)xv[jj]) : 0.f, acc[jj]); }
                  u32x4 pw; pw.x = pk2(acc[0], acc[1]); pw.y = pk2(acc[2], acc[3]); pw.z = pk2(acc[4], acc[5]); pw.w = pk2(acc[6], acc[7]);
                  afrL[(s * 4 + kk) * 64 + lane] = __builtin_bit_cast(bf16x8, pw); } } }
        LDS_WAIT(); asm volatile("" ::: "memory");
        const int chunk = 2 * cp + hf;
        if (FINAL) {
            const int tid = threadIdx.x, pdir = tid >> 8, pseg = (tid >> 6) & 3, pch = tid & 63, q = cp >> 3;
            LAS f32x2* segL = (LAS f32x2*)(lds + LDS_SEG);
            LAS float* cinL = (LAS float*)(lds + LDS_CIN);
            f32x2 g[16];
#pragma unroll
            for (int i = 0; i < 16; ++i) g[i] = AGG[((size_t)(b * 2 + pdir) * 64 + 16 * pseg + i) * DM + ch0 + pch];
            float As = 1.f, Us = 0.f;
#pragma unroll
            for (int ii = 0; ii < 16; ++ii) { const int i = pdir ? 15 - ii : ii; Us = fmaf(g[i][0], Us, g[i][1]); As *= g[i][0]; }
            __syncthreads();
            segL[(pdir * 4 + pseg) * 64 + pch] = (f32x2){As, Us};
            __syncthreads();
            if (pseg == q) { float Hc = 0.f;
                if (pdir == 0) { for (int s2 = 0; s2 < pseg; ++s2) { const f32x2 sg = segL[(0 * 4 + s2) * 64 + pch]; Hc = fmaf(sg[0], Hc, sg[1]); } }
                else { for (int s2 = 3; s2 > pseg; --s2) { const f32x2 sg = segL[(1 * 4 + s2) * 64 + pch]; Hc = fmaf(sg[0], Hc, sg[1]); } }
#pragma unroll
                for (int ii = 0; ii < 16; ++ii) { const int i = pdir ? 15 - ii : ii; cinL[(pdir * 16 + i) * 64 + pch] = Hc; Hc = fmaf(g[i][0], Hc, g[i][1]); } }
            __syncthreads();
        }
#pragma unroll 1
        for (int ct = 0; ct < 2; ++ct) { const int ch = ch0 + 32 * ct + n;
            float Af, Uf, Ab, Ub;
            {
                const float br = a.in[9][ch], bi = a.in[11][ch]; const float lam = a.in[12][ch];
                const float cl = -8.f * 1.44269504089f * log1pf(expf(-lam));
                float Hin = 0.f;
                if (FINAL) Hin = ((const LAS float*)(lds + LDS_CIN))[(0 * 16 + (chunk & 15)) * 64 + 32 * ct + n];
                scan_dir<FINAL, 0>(afrL, lane, ct, WG + (size_t)(0 * 16 + jb) * 4096, WG + (size_t)(1 * 16 + jb) * 4096, br, bi, cl, Hin, idf, Af, Uf, ZA + ((size_t)b * SEQ + chunk * 64) * DM + ch, YA + ((size_t)b * SEQ + chunk * 64) * DM + ch);
            }
            {
                const float br = a.in[14][ch], bi = a.in[16][ch]; const float lam = a.in[17][ch];
                const float cl = -8.f * 1.44269504089f * log1pf(expf(-lam));
                float Hin = 0.f;
                if (FINAL) Hin = ((const LAS float*)(lds + LDS_CIN))[(1 * 16 + (chunk & 15)) * 64 + 32 * ct + n];
                scan_dir<FINAL, 1>(afrL, lane, ct, WG + (size_t)(2 * 16 + jb) * 4096, WG + (size_t)(3 * 16 + jb) * 4096, br, bi, cl, Hin, idf, Ab, Ub, ZA + ((size_t)b * SEQ + chunk * 64) * DM + ch, YA + ((size_t)b * SEQ + chunk * 64) * DM + ch);
            }
            if (!FINAL) {
                AGG[((size_t)(b * 2 + 0) * 64 + chunk) * DM + ch] = (f32x2){Af, Uf};
                AGG[((size_t)(b * 2 + 1) * 64 + chunk) * DM + ch] = (f32x2){Ab, Ub};
            }
        }
        LDS_WAIT(); asm volatile("" ::: "memory");
    }
}

__device__ __forceinline__ void final_norm(const Args& a, int gw, int NGW, int lane) {
    const float* rss = (const float*)(a.ws + WS_RSS); const float* g_final = a.in[22]; float* out = a.out;
    for (int row = gw; row < MTOK; row += NGW) {
        float ss = rss[(size_t)row * 16 + (lane & 15)];
        ss += __shfl_xor(ss, 1); ss += __shfl_xor(ss, 2); ss += __shfl_xor(ss, 4); ss += __shfl_xor(ss, 8);
        const float rstd = __builtin_amdgcn_rsqf(ss * (1.f / 1024.f) + 1e-6f);
        f32x4* orow = (f32x4*)(out + (size_t)row * DM) + lane;
#pragma unroll
        for (int j = 0; j < 4; ++j) { const f32x4 g = *((const f32x4*)g_final + lane + 64 * j); const f32x4 v = orow[64 * j]; orow[64 * j] = v * rstd * g; }
    }
}


#define XB_TMO      128
#define XB_XCNT(j)  (256  + 64 * (j))
#define XB_XSUB(j)  (1280 + 64 * (j))
#define XB_XGEN(j)  (2304 + 64 * (j))
#define XB_TOP      3328
#define XB_TOPGEN   3392
#define XCD_BAR_WORDS 3456
#define XB_SPIN_CAP (1u << 18)
__device__ __forceinline__ unsigned xb_ld(unsigned* p)              { return __hip_atomic_load(p, __ATOMIC_RELAXED, __HIP_MEMORY_SCOPE_AGENT); }
__device__ __forceinline__ unsigned xb_add(unsigned* p, unsigned v) { return __hip_atomic_fetch_add(p, v, __ATOMIC_RELAXED, __HIP_MEMORY_SCOPE_AGENT); }
__device__ __forceinline__ unsigned xb_xcc_id() { return (unsigned)__builtin_amdgcn_s_getreg((3 << 11) | 20) & 0xFu; }
#define XB_SPIN(cond, bar) do { unsigned _sp = 0; while (cond) { __builtin_amdgcn_s_sleep(1); \
    if ((++_sp & 255u) == 0u) { if (xb_ld(&(bar)[XB_TMO])) break; if (_sp > XB_SPIN_CAP) { atomicAdd(&(bar)[XB_TMO], 1u); break; } } } } while (0)
struct XcdBarrier { unsigned* bar; unsigned x; volatile LAS unsigned* st; };
__device__ __forceinline__ XcdBarrier xcd_barrier_post(unsigned* bar, volatile LAS unsigned* st) {
    XcdBarrier b; b.bar = bar; b.x = xb_xcc_id(); b.st = st;
    if (threadIdx.x == 0) (void)xb_add(&bar[XB_XCNT(b.x)], 1u);
    return b;
}
__device__ __forceinline__ void xcd_barrier_complete(unsigned* bar, unsigned x, unsigned& nloc, unsigned& nx) {
    const unsigned G = gridDim.x * gridDim.y * gridDim.z;
    unsigned sum, cnt, mine, sp = 0u;
    for (;;) {
        sum = 0u; cnt = 0u; mine = 0u;
#pragma unroll
        for (unsigned j = 0; j < 16; ++j) { const unsigned c = xb_ld(&bar[XB_XCNT(j)]); sum += c; cnt += (c > 0u) ? 1u : 0u; mine = (j == x) ? c : mine; }
        if (sum == G) break;
        __builtin_amdgcn_s_sleep(1);
        if ((++sp & 255u) == 0u) { if (xb_ld(&bar[XB_TMO])) break; if (sp > XB_SPIN_CAP) { atomicAdd(&bar[XB_TMO], 1u); break; } }
    }
    nloc = mine > 0u ? mine : 1u; nx = cnt > 0u ? cnt : 1u;
}
__device__ __forceinline__ void xcd_barrier(const XcdBarrier& b) {
    asm volatile("s_waitcnt vmcnt(0)" ::: "memory");
    __syncthreads();
    if (threadIdx.x == 0) {
        unsigned* bar = b.bar;
        __builtin_amdgcn_s_waitcnt(0);
        unsigned nloc = b.st[0], nx = b.st[1];
        if (nloc == 0u) { xcd_barrier_complete(bar, b.x, nloc, nx); b.st[0] = nloc; b.st[1] = nx; }
        const unsigned old = xb_add(&bar[XB_XSUB(b.x)], 1u);
        const unsigned gen = old / nloc;
        if (old + 1u == (gen + 1u) * nloc) {
            __builtin_amdgcn_fence(__ATOMIC_RELEASE, "agent");
            asm volatile("s_waitcnt vmcnt(0)" ::: "memory");
            const unsigned og = xb_add(&bar[XB_TOP], 1u);
            const unsigned tg = og / nx;
            if (og + 1u == (tg + 1u) * nx) xb_add(&bar[XB_TOPGEN], 1u);
            else XB_SPIN(xb_ld(&bar[XB_TOPGEN]) == tg, bar);
            __builtin_amdgcn_fence(__ATOMIC_ACQUIRE, "agent");
            xb_add(&bar[XB_XGEN(b.x)], 1u);
            asm volatile("s_waitcnt vmcnt(0)" ::: "memory");
        } else {
            XB_SPIN(xb_ld(&bar[XB_XGEN(b.x)]) == gen, bar);
            __builtin_amdgcn_fence(__ATOMIC_ACQUIRE, "agent");
            asm volatile("s_waitcnt vmcnt(0)" ::: "memory");
        }
    }
    __syncthreads();
}

__global__ void __launch_bounds__(512, 2) fwd_kernel(Args a) {
    extern __shared__ __attribute__((aligned(16))) unsigned char lds_raw[];
    LAS unsigned char* lds = (LAS unsigned char*)lds_raw;
    cg::grid_group grid = cg::this_grid();
    const int tid = threadIdx.x, lane = tid & 63, wave = __builtin_amdgcn_readfirstlane(tid >> 6);
    const int G = gridDim.x, bx = blockIdx.x;
    const int vcu = (G % 8 == 0) ? (bx % 8) * (G / 8) + bx / 8 : bx;
    const int gw = bx * 8 + wave, NGW = G * 8;
    unsigned char* ws = a.ws;
#ifdef PROBE_A0
    unsigned long long tA0 = 0, tA1 = 0, tB0 = 0, tB1 = 0;
#define STAMP(k) do { const unsigned long long _t = __builtin_amdgcn_s_memrealtime(); if ((k) == PROBE_A0) tA0 = _t; if ((k) == PROBE_A1) tA1 = _t; if ((k) == PROBE_B0) tB0 = _t; if ((k) == PROBE_B1) tB1 = _t; } while (0)
#else
#define STAMP(k) do {} while (0)
#endif
    STAMP(0);
    unsigned* barw = (unsigned*)(ws + WS_BAR);
    if (bx == 0) for (int i = tid; i < XCD_BAR_WORDS; i += 512) barw[i] = 0u;
    if (tid < 4) ((volatile LAS unsigned*)(lds + LDS_MISC))[tid] = 0u;

#define PH(k) (!defined(ONLY) || ONLY == (k))
#if !defined(ONLY) || ONLY == 0
    p0_prologue(a, lds, gw, NGW, wave, lane);
#endif
    STAMP(1);
    grid.sync();
    XcdBarrier xb = xcd_barrier_post(barw, (volatile LAS unsigned*)(lds + LDS_MISC));
    STAMP(2);
#if !defined(ONLY) || ONLY == 1
    p1_hpass(a, lds, G, tid, wave, lane);
#endif
    STAMP(3);
    xcd_barrier(xb);
    STAMP(4);
#if !defined(ONLY) || ONLY == 2
    {
        pg8::Gemm g{(const bf16_t*)(ws + WS_H), (const bf16_t*)(ws + WS_WIN), MTOK, 7168, 1024}; pg8::StaticOrder S; S.init(MTOK, 7168, G, bx);
        EpiProj E{(bf16_t*)(ws + WS_XA), (bf16_t*)a.out};
        pg8::gemm_phase<EpiProj, pg8::StaticOrder, PG8_ALIGN, PG8_SP2>(lds, g, S, E);
    }
    STAMP(5);
    {
        pg8::Gemm g{(const bf16_t*)(ws + WS_WV), (const bf16_t*)(ws + WS_H), 1024, MTOK, 1024}; pg8::StaticOrder S; S.init(1024, MTOK, G, bx);
        EpiPlain E{(bf16_t*)(ws + WS_VT), MTOK};
        pg8::gemm_phase<EpiPlain, pg8::StaticOrder, PG8_ALIGN, PG8_SP2>(lds, g, S, E);
    }
    STAMP(6);
#endif
    xcd_barrier(xb);
    STAMP(7);
#if !defined(ONLY) || ONLY == 3
    attn_phase((const bf16_t*)(ws + WS_Q), (const bf16_t*)(ws + WS_K), (const bf16_t*)(ws + WS_VT), (const bf16_t*)(ws + WS_ZB), a.in[18], (bf16_t*)(ws + WS_Q), vcu, G, wave, lane);
#endif
    STAMP(8);
#if !defined(ONLY) || ONLY == 4
    scan_phase<false>(a, lds, gw, NGW, wave, lane);
#endif
    STAMP(9);
    xcd_barrier(xb);
    STAMP(10);
#if !defined(ONLY) || ONLY == 5
    scan_phase<true>(a, lds, gw, NGW, wave, lane);
#endif
    STAMP(11);
    xcd_barrier(xb);
    STAMP(12);
#if !defined(ONLY) || ONLY == 6
    {
        pg8::Gemm g{(const bf16_t*)(ws + WS_H), (const bf16_t*)(ws + WS_WPA), MTOK, 1024, 1024}; pg8::StaticOrder S; S.init(MTOK, 1024, G, bx);
        EpiGate<false> E{(const bf16_t*)a.out, nullptr, (bf16_t*)(ws + WS_K)};
        pg8::gemm_phase<EpiGate<false>, pg8::StaticOrder, PG8_ALIGN, PG8_SP2>(lds, g, S, E);
    }
    STAMP(13);
    __threadfence();
    {
        pg8::Gemm g{(const bf16_t*)(ws + WS_Q), (const bf16_t*)(ws + WS_WPB), MTOK, 1024, 1024}; pg8::StaticOrder S; S.init(MTOK, 1024, G, bx);
        EpiGate<true> E{(const bf16_t*)a.out + ARR, (const bf16_t*)(ws + WS_K), (bf16_t*)(ws + WS_XA)};
        pg8::gemm_phase<EpiGate<true>, pg8::StaticOrder, PG8_ALIGN, PG8_SP2>(lds, g, S, E);
    }
    STAMP(14);
#endif
    xcd_barrier(xb);
    STAMP(15);
#if !defined(ONLY) || ONLY == 7
    {
        pg8::Gemm g{(const bf16_t*)(ws + WS_XA), (const bf16_t*)(ws + WS_WO), MTOK, 1024, 1024}; pg8::StaticOrder S; S.init(MTOK, 1024, G, bx);
        EpiOut E{a.in[0], (const float*)(ws + WS_GATE), a.out, (float*)(ws + WS_RSS)};
        pg8::gemm_phase<EpiOut, pg8::StaticOrder, PG8_ALIGN, PG8_SP2>(lds, g, S, E);
    }
    STAMP(16);
#endif
    xcd_barrier(xb);
    STAMP(17);
#if !defined(ONLY) || ONLY == 8
    final_norm(a, gw, NGW, lane);
#endif
#ifdef PROBE_A0
    STAMP(18);
    if (bx == 0) {
        const float dA = (float)(tA1 - tA0) * 0.01f, dB = (float)(tB1 - tB0) * 0.01f;
        __syncthreads();
        float* orow = a.out + (size_t)wave * DM;
        for (int i = lane; i < DM; i += 64) orow[i] += dB;
        __syncthreads();
        if (tid == 0) a.out[0] += dA;
    }
#endif
}

extern "C" void kernel_launch(void* const* d_in, const int* in_sizes, int n_in, void* d_out, int out_size, void* d_ws, size_t ws_size, hipStream_t stream) {
    static int grid = 0;
    if (grid == 0) {
        if (n_in != 23 || out_size != MTOK * DM || ws_size < 256 * MiB) { fprintf(stderr, "kernel_launch: unexpected problem shape (n_in %d, out %d, ws %zu)\n", n_in, out_size, ws_size); grid = -1; return; }
        int dev = 0, cus = 0, per_cu = 0;
        (void)hipGetDevice(&dev);
        (void)hipDeviceGetAttribute(&cus, hipDeviceAttributeMultiprocessorCount, dev);
        if (hipFuncSetAttribute((const void*)fwd_kernel, hipFuncAttributeMaxDynamicSharedMemorySize, LDS_BYTES) != hipSuccess) { fprintf(stderr, "kernel_launch: hipFuncSetAttribute failed\n"); grid = -1; return; }
        if (hipOccupancyMaxActiveBlocksPerMultiprocessor(&per_cu, (const void*)fwd_kernel, 512, LDS_BYTES) != hipSuccess || per_cu < 1) { fprintf(stderr, "kernel_launch: occupancy query failed (%d)\n", per_cu); per_cu = 1; (void)hipGetLastError(); }
        grid = cus * per_cu;
        if (grid <= 0) { grid = -1; return; }
    }
    if (grid < 0) return;
    Args a{};
    for (int i = 0; i < 23; ++i) a.in[i] = (const float*)d_in[i];
    a.out = (float*)d_out; a.ws = (unsigned char*)d_ws;
    void* args[] = {&a};
    hipError_t e = hipLaunchCooperativeKernel((const void*)fwd_kernel, dim3(grid), dim3(512), args, LDS_BYTES, stream);
    if (e != hipSuccess) fprintf(stderr, "kernel_launch: cooperative launch failed: %s (grid %d)\n", hipGetErrorString(e), grid);
}
```

```cpp
#include <hip/hip_runtime.h>
#include <hip/hip_cooperative_groups.h>
#include <cstdio>
#include <cstdint>
namespace cg = cooperative_groups;
namespace pg8 {
#define PG8_LAS __attribute__((address_space(3)))
typedef unsigned short bf16_t;
typedef short bf16x8 __attribute__((ext_vector_type(8)));
typedef float f32x4 __attribute__((ext_vector_type(4)));
typedef unsigned u32x4 __attribute__((ext_vector_type(4)));
constexpr int BM = 256, BK = 64, HALF = 128, HTB = HALF * BK * 2  , STAGE_BYTES = 8 * HTB, NXCD = 8, WGM = 8;

__host__ __device__ __forceinline__ int lds_byte(int r, int c) { const int st = (r >> 4) * 2 + (c >> 5), rr = r & 15, cc = c & 31, ob = rr * 64 + cc * 2; return st * 1024 + (ob ^ (((ob >> 9) & 1) << 5)); }
__host__ __device__ __forceinline__ void stage_rc(int b, int& R, int& C) { const int st = b / 1024, sb = b % 1024, swz = sb ^ (((sb >> 9) & 1) << 5); R = (st >> 1) * 16 + swz / 64; C = (st & 1) * 32 + (swz % 64) / 2; }
__host__ __device__ __forceinline__ int perm32(int rho) { const int n = rho >> 4, i = rho & 15; return 8 * (i >> 2) + 4 * n + (i & 3); }

struct Unit { int pm, pn, w; };
struct Gemm { const bf16_t* A; const bf16_t* Bt; int M, N, K; const bf16_t* A2; const bf16_t* Bt2; };

struct StaticOrder {
    int nM, nN, nwg, G, c;
    __host__ __device__ void init(int M, int N, int G_, int c_) { nM = M / BM; nN = N / BM; nwg = nM * nN; G = G_; c = c_; }
    __host__ __device__ bool next(int i, Unit& u) const {
        const long L = (long)i * G + c; if (L >= nwg) return false;
        int wgid = (int)L; { const int q = nwg / NXCD, r = nwg % NXCD, xcd = wgid % NXCD, off = wgid / NXCD; wgid = (xcd < r ? xcd * (q + 1) : r * (q + 1) + (xcd - r) * q) + off; }
        const int nig = WGM * nN, gid = wgid / nig, fm = gid * WGM, gsz = (nM - fm) < WGM ? (nM - fm) : WGM;
        u.pm = fm + ((wgid % nig) % gsz); u.pn = (wgid % nig) / gsz; u.w = 0; return true;
    }
    __device__ __forceinline__ void a_ready(const Unit&) const {}
    __device__ __forceinline__ void done(const Unit&) const {}
};
struct PairOrder : StaticOrder {
    __host__ __device__ bool next(int i, Unit& u) const { if (!StaticOrder::next(i >> 1, u)) return false; u.w = i & 1; return true; }
};
__device__ __forceinline__ unsigned cvt_pk_bf16(float lo, float hi) { unsigned r; asm volatile("v_cvt_pk_bf16_f32 %0, %1, %2" : "=v"(r) : "v"(lo), "v"(hi)); return r; }
typedef float f32x2 __attribute__((ext_vector_type(2)));
template <class Epi, class Sched, bool ALIGN_EPI = false, bool SP2 = false>
__device__ __forceinline__ void gemm_phase(PG8_LAS unsigned char* lds, const Gemm g, const Sched& S, const Epi& E) {
    const int tid = threadIdx.x, wid = __builtin_amdgcn_readfirstlane(tid >> 6), lane = tid & 63, wr = wid >> 2, wc = wid & 3, fr = lane & 15, fq = lane >> 4;
    const int K = g.K, nt = K / BK;
    unsigned voffA[2], voffB[2];
#pragma unroll
    for (int i = 0; i < 2; ++i) { int R, C; stage_rc(tid * 16 + i * 8192, R, C); const int Rb = Epi::PERM ? ((R & ~31) + perm32(R & 31)) : R;
        voffA[i] = (unsigned)(R * K + C) * 2u; voffB[i] = (unsigned)(Rb * K + C) * 2u; }
    const size_t kstep = (size_t)(BK * 2);
    const size_t hstep = (size_t)HALF * K * 2;
    const size_t tstep = 2 * hstep;
    const unsigned ldsw = (unsigned)wid * 1024u;
    const int aoff = lds_byte(wr * 64 + fr, fq * 8), boff = lds_byte(wc * 32 + fr, fq * 8);
#define PG8_SA(b, h) (((b) * 2 + (h)) * HTB)
#define PG8_SB(b, h) ((4 + (b) * 2 + (h)) * HTB)
#define PG8_STAGE(bufoff, gbase, voff) do { _Pragma("unroll") for (int _i = 0; _i < 2; ++_i) \
        __builtin_amdgcn_global_load_lds((const unsigned*)((const char*)(gbase) + (voff)[_i]), (PG8_LAS unsigned*)(lds + (bufoff) + ldsw + _i * 8192), 16, 0, 0); } while (0)
#define PG8_LDA(dst, b, h) do { _Pragma("unroll") for (int m = 0; m < 4; ++m) _Pragma("unroll") for (int k = 0; k < 2; ++k) dst[m][k] = *(const PG8_LAS bf16x8*)(lds + PG8_SA(b, h) + aoff + m * 2048 + k * 1024); } while (0)
#define PG8_LDB(dst, b, h) do { _Pragma("unroll") for (int n = 0; n < 2; ++n) _Pragma("unroll") for (int k = 0; k < 2; ++k) dst[n][k] = *(const PG8_LAS bf16x8*)(lds + PG8_SB(b, h) + boff + n * 2048 + k * 1024); } while (0)
#define PG8_MMA(ai, bj, At, Bt) do { __builtin_amdgcn_s_setprio(1); _Pragma("unroll") for (int m = 0; m < 4; ++m) _Pragma("unroll") for (int n = 0; n < 2; ++n) _Pragma("unroll") for (int k = 0; k < 2; ++k) \
        acc[ai][bj][m][n] = __builtin_amdgcn_mfma_f32_16x16x32_bf16(Bt[n][k], At[m][k], acc[ai][bj][m][n], 0, 0, 0); __builtin_amdgcn_s_setprio(0); } while (0)
#define PG8_WAIT_V(n) asm volatile("s_waitcnt vmcnt(" #n ")" ::: "memory")
#define PG8_WAIT_L(n) asm volatile("s_waitcnt lgkmcnt(" #n ")" ::: "memory")
#define PG8_BAR __builtin_amdgcn_s_barrier()
#define PG8_SCHED __builtin_amdgcn_sched_barrier(0)
    Unit cur, nxt; int ui = 0;
    if (!S.next(0, cur)) return;
    f32x4 acc[2][2][4][2];
#pragma unroll
    for (int a = 0; a < 2; ++a)
#pragma unroll
        for (int b = 0; b < 2; ++b)
#pragma unroll
            for (int m = 0; m < 4; ++m)
#pragma unroll
                for (int n = 0; n < 2; ++n) acc[a][b][m][n] = (f32x4){0.f, 0.f, 0.f, 0.f};
    bf16x8 At[4][2], B0[2][2], B1[2][2];
    const char* cA = (const char*)(cur.w ? g.A2 : g.A) + (size_t)cur.pm * tstep; const char* cB = (const char*)(cur.w ? g.Bt2 : g.Bt) + (size_t)cur.pn * tstep;
    S.a_ready(cur);
    if constexpr (SP2) {
        PG8_STAGE(PG8_SB(0, 0), cB, voffB); PG8_STAGE(PG8_SB(0, 1), cB + hstep, voffB); PG8_STAGE(PG8_SA(0, 0), cA, voffA); PG8_STAGE(PG8_SA(0, 1), cA + hstep, voffA);
        if (wr == 1) PG8_BAR;
        PG8_WAIT_V(2); PG8_BAR;
        PG8_STAGE(PG8_SB(1, 0), cB + kstep, voffB); PG8_STAGE(PG8_SA(1, 0), cA + kstep, voffA); PG8_STAGE(PG8_SB(1, 1), cB + hstep + kstep, voffB);
        PG8_WAIT_V(6); PG8_BAR;
    } else {
        PG8_STAGE(PG8_SB(0, 0), cB, voffB); PG8_STAGE(PG8_SA(0, 0), cA, voffA); PG8_STAGE(PG8_SB(0, 1), cB + hstep, voffB); PG8_STAGE(PG8_SA(0, 1), cA + hstep, voffA);
        if (wr == 1) PG8_BAR;
        PG8_WAIT_V(4); PG8_BAR;
        PG8_STAGE(PG8_SB(1, 0), cB + kstep, voffB); PG8_STAGE(PG8_SA(1, 0), cA + kstep, voffA); PG8_STAGE(PG8_SB(1, 1), cB + hstep + kstep, voffB);
        PG8_WAIT_V(6); PG8_BAR;
    }
    for (;;) {
        const bool has_next = S.next(ui + 1, nxt);
        const char* nA = has_next ? (const char*)(nxt.w ? g.A2 : g.A) + (size_t)nxt.pm * tstep : cA; const char* nB = has_next ? (const char*)(nxt.w ? g.Bt2 : g.Bt) + (size_t)nxt.pn * tstep : cB;
        for (int t = 0; t < nt; t += 2) {
            const bool last = (t == nt - 2);
            const char* a1 = cA + (size_t)(t + 1) * kstep;
            const char* a2 = last ? nA : cA + (size_t)(t + 2) * kstep; const char* b2 = last ? nB : cB + (size_t)(t + 2) * kstep;
            const char* a3 = a2 + kstep; const char* b3 = b2 + kstep;
            if (last && has_next) S.a_ready(nxt);
            if constexpr (SP2) {
            PG8_LDB(B0, 0, 0); PG8_LDB(B1, 0, 1); PG8_SCHED; PG8_LDA(At, 0, 0); PG8_STAGE(PG8_SA(1, 1), a1 + hstep, voffA);
            PG8_WAIT_V(8); PG8_WAIT_L(0); PG8_BAR; PG8_MMA(0, 0, At, B0); PG8_MMA(0, 1, At, B1); PG8_BAR; PG8_SCHED;
            PG8_LDA(At, 0, 1); PG8_STAGE(PG8_SB(0, 0), b2, voffB); PG8_STAGE(PG8_SB(0, 1), b2 + hstep, voffB); PG8_STAGE(PG8_SA(0, 0), a2, voffA);
            PG8_WAIT_V(8); PG8_WAIT_L(0); PG8_BAR; PG8_MMA(1, 0, At, B0); PG8_MMA(1, 1, At, B1); PG8_BAR; PG8_SCHED;
            PG8_LDB(B0, 1, 0); PG8_LDB(B1, 1, 1); PG8_SCHED; PG8_LDA(At, 1, 0); PG8_STAGE(PG8_SA(0, 1), a2 + hstep, voffA);
            PG8_WAIT_V(8); PG8_WAIT_L(0); PG8_BAR; PG8_MMA(0, 0, At, B0); PG8_MMA(0, 1, At, B1); PG8_BAR; PG8_SCHED;
            PG8_LDA(At, 1, 1); PG8_STAGE(PG8_SB(1, 0), b3, voffB); PG8_STAGE(PG8_SB(1, 1), b3 + hstep, voffB); PG8_STAGE(PG8_SA(1, 0), a3, voffA);
            PG8_WAIT_V(8); PG8_WAIT_L(0); PG8_BAR; PG8_MMA(1, 0, At, B0); PG8_MMA(1, 1, At, B1); PG8_BAR; PG8_SCHED;
            } else {
            PG8_LDB(B0, 0, 0); PG8_SCHED; PG8_LDA(At, 0, 0); PG8_STAGE(PG8_SA(1, 1), a1 + hstep, voffA);
            PG8_WAIT_L(8); PG8_BAR; PG8_WAIT_L(0); PG8_MMA(0, 0, At, B0); PG8_BAR; PG8_SCHED;
            PG8_LDB(B1, 0, 1); PG8_STAGE(PG8_SB(0, 0), b2, voffB);
            PG8_BAR; PG8_WAIT_L(0); PG8_MMA(0, 1, At, B1); PG8_BAR;
            PG8_LDA(At, 0, 1); PG8_STAGE(PG8_SA(0, 0), a2, voffA);
            PG8_BAR; PG8_WAIT_L(0); PG8_MMA(1, 0, At, B0); PG8_BAR; PG8_SCHED;
            PG8_STAGE(PG8_SB(0, 1), b2 + hstep, voffB);
            PG8_WAIT_V(6); PG8_BAR; PG8_MMA(1, 1, At, B1); PG8_BAR;
            PG8_LDB(B0, 1, 0); PG8_SCHED; PG8_LDA(At, 1, 0); PG8_STAGE(PG8_SA(0, 1), a2 + hstep, voffA);
            PG8_WAIT_L(8); PG8_BAR; PG8_WAIT_L(0); PG8_MMA(0, 0, At, B0); PG8_BAR; PG8_SCHED;
            PG8_LDB(B1, 1, 1); PG8_STAGE(PG8_SB(1, 0), b3, voffB);
            PG8_BAR; PG8_WAIT_L(0); PG8_MMA(0, 1, At, B1); PG8_BAR;
            PG8_LDA(At, 1, 1); PG8_STAGE(PG8_SA(1, 0), a3, voffA);
            PG8_BAR; PG8_WAIT_L(0); PG8_MMA(1, 0, At, B0); PG8_BAR; PG8_SCHED;
            PG8_STAGE(PG8_SB(1, 1), b3 + hstep, voffB);
            PG8_WAIT_V(6); PG8_BAR; PG8_MMA(1, 1, At, B1); PG8_BAR;
            }
        }
        if constexpr (ALIGN_EPI) { if (wr == 0) PG8_BAR; }
        if constexpr (!Epi::AFTER_DRAIN) { E(acc, cur, wr, wc, fr, fq); S.done(cur); }
        if (!has_next) break;
#pragma unroll
        for (int a = 0; a < 2; ++a)
#pragma unroll
            for (int b = 0; b < 2; ++b)
#pragma unroll
                for (int m = 0; m < 4; ++m)
#pragma unroll
                    for (int n = 0; n < 2; ++n) acc[a][b][m][n] = (f32x4){0.f, 0.f, 0.f, 0.f};
        cur = nxt; cA = nA; cB = nB; ++ui;
        if constexpr (ALIGN_EPI) { if (wr == 1) PG8_BAR; }
    }
    PG8_WAIT_V(0);
    if constexpr (!ALIGN_EPI) { if (wr == 0) PG8_BAR; }
    PG8_BAR;
    if constexpr (Epi::AFTER_DRAIN) { E.fused(acc, cur, wr, wc, fr, fq, lds, wid, lane); S.done(cur); }
#undef PG8_SA
#undef PG8_SB
#undef PG8_STAGE
#undef PG8_LDA
#undef PG8_LDB
#undef PG8_MMA
#undef PG8_WAIT_V
#undef PG8_WAIT_L
#undef PG8_BAR
#undef PG8_SCHED
}
}
#ifndef PG8_SP2
#define PG8_SP2 true
#endif
#ifndef PG8_ALIGN
#define PG8_ALIGN true
#endif

#define LAS __attribute__((address_space(3)))
typedef unsigned short bf16_t;
typedef short bf16x8 __attribute__((ext_vector_type(8)));
typedef short bf16x4 __attribute__((ext_vector_type(4)));
typedef float f32x4 __attribute__((ext_vector_type(4)));
typedef float f32x16 __attribute__((ext_vector_type(16)));
typedef unsigned u32x4 __attribute__((ext_vector_type(4)));
typedef unsigned u32x2 __attribute__((ext_vector_type(2)));

constexpr int MTOK = 16384, DM = 1024, SEQ = 4096, NB = 4;
constexpr size_t MiB = 1u << 20;
constexpr size_t ARR = (size_t)MTOK * DM;
constexpr size_t WS_MODP = 0;
constexpr size_t WS_GATE = 786432;
constexpr size_t WS_AGG = 1 * MiB;
constexpr size_t WS_RSS = 5 * MiB;
constexpr size_t WS_WG = 6 * MiB;
constexpr size_t WS_WPA = 8 * MiB, WS_WPB = 10 * MiB, WS_WO = 12 * MiB, WS_WV = 14 * MiB;
constexpr size_t WS_WIN = 16 * MiB;
constexpr size_t WS_H = 32 * MiB;
constexpr size_t WS_XA = 64 * MiB, WS_ZA = 96 * MiB, WS_Q = 128 * MiB, WS_K = 160 * MiB, WS_ZB = 192 * MiB;
constexpr size_t WS_VT = 224 * MiB;
constexpr size_t WS_BAR = 802816;
constexpr int LDS_CIN = 131072, LDS_SEG = 131072 + 8192, LDS_MISC = 131072 + 12288;
constexpr int LDS_BYTES = 131072 + 12288 + 256;

__device__ __forceinline__ float bf2f(unsigned short b) { return __uint_as_float(((unsigned)b) << 16); }
__device__ __forceinline__ unsigned pk2(float lo, float hi) { return pg8::cvt_pk_bf16(lo, hi); }
__device__ __forceinline__ float sigm(float v) { return __builtin_amdgcn_rcpf(1.f + __builtin_amdgcn_exp2f(-1.44269504089f * v)); }
__device__ __forceinline__ float wave_sum(float v) {
#pragma unroll
    for (int o = 1; o < 64; o <<= 1) v += __shfl_xor(v, o);
    return v;
}
#define LDS_WAIT() asm volatile("s_waitcnt lgkmcnt(0)" ::: "memory")

struct EpiProj {
    static constexpr bool PERM = true, AFTER_DRAIN = false;
    bf16_t* O5; bf16_t* OG;
    __device__ __forceinline__ void operator()(const f32x4 (&acc)[2][2][4][2], const pg8::Unit& u, int wr, int wc, int fr, int fq) const {
        const int arr = u.pn >> 2, colt = (u.pn & 3) * 256;
        bf16_t* base = arr < 5 ? O5 + (size_t)arr * ARR : OG + (size_t)(arr - 5) * ARR;
        const int mode = (arr == 1 || arr == 4) ? 1 : (arr >= 5 ? 2 : (arr == 2 ? 3 : 0));
        const int row0 = u.pm * 256 + wr * 64 + fr, col0 = colt + wc * 32 + 8 * fq;
#pragma unroll
        for (int ai = 0; ai < 2; ++ai)
#pragma unroll
            for (int m = 0; m < 4; ++m) { bf16_t* rowp = base + (size_t)(row0 + ai * 128 + m * 16) * DM + col0;
#pragma unroll
                for (int bj = 0; bj < 2; ++bj) { f32x4 v0 = acc[ai][bj][m][0], v1 = acc[ai][bj][m][1];
                    if (mode == 1) {
#pragma unroll
                        for (int j = 0; j < 4; ++j) { v0[j] = v0[j] * sigm(v0[j]); v1[j] = v1[j] * sigm(v1[j]); } }
                    else if (mode == 2) {
#pragma unroll
                        for (int j = 0; j < 4; ++j) { v0[j] = sigm(v0[j]); v1[j] = sigm(v1[j]); } }
                    else if (mode == 3) { v0 = v0 * 0.125f; v1 = v1 * 0.125f; }
                    u32x4 w; w.x = pk2(v0[0], v0[1]); w.y = pk2(v0[2], v0[3]); w.z = pk2(v1[0], v1[1]); w.w = pk2(v1[2], v1[3]);
                    *(u32x4*)(rowp + bj * 128) = w; } }
    }
};
struct EpiPlain {
    static constexpr bool PERM = true, AFTER_DRAIN = false;
    bf16_t* O; int ldc;
    __device__ __forceinline__ void operator()(const f32x4 (&acc)[2][2][4][2], const pg8::Unit& u, int wr, int wc, int fr, int fq) const {
        const int row0 = u.pm * 256 + wr * 64 + fr, col0 = u.pn * 256 + wc * 32 + 8 * fq;
#pragma unroll
        for (int ai = 0; ai < 2; ++ai)
#pragma unroll
            for (int m = 0; m < 4; ++m) { bf16_t* rowp = O + (size_t)(row0 + ai * 128 + m * 16) * ldc + col0;
#pragma unroll
                for (int bj = 0; bj < 2; ++bj) { const f32x4 v0 = acc[ai][bj][m][0], v1 = acc[ai][bj][m][1];
                    u32x4 w; w.x = pk2(v0[0], v0[1]); w.y = pk2(v0[2], v0[3]); w.z = pk2(v1[0], v1[1]); w.w = pk2(v1[2], v1[3]);
                    *(u32x4*)(rowp + bj * 128) = w; } }
    }
};
struct EpiGate2 {
    static constexpr bool PERM = true, AFTER_DRAIN = false;
    const bf16_t* Ga; const bf16_t* Gb; bf16_t* Tb; bf16_t* O;
    __device__ __forceinline__ void operator()(const f32x4 (&acc)[2][2][4][2], const pg8::Unit& u, int wr, int wc, int fr, int fq) const {
        const int row0 = u.pm * 256 + wr * 64 + fr, col0 = u.pn * 256 + wc * 32 + 8 * fq;
        const bf16_t* G = u.w ? Gb : Ga; bf16_t* dst = u.w ? O : Tb;
#pragma unroll
        for (int ai = 0; ai < 2; ++ai) {
            bf16x8 g[4][2], t[4][2];
#pragma unroll
            for (int m = 0; m < 4; ++m)
#pragma unroll
                for (int bj = 0; bj < 2; ++bj) { const size_t off = (size_t)(row0 + ai * 128 + m * 16) * DM + col0 + bj * 128;
                    g[m][bj] = *(const bf16x8*)(G + off);
                    if (u.w) t[m][bj] = *(const bf16x8*)(Tb + off); else t[m][bj] = (bf16x8){0, 0, 0, 0, 0, 0, 0, 0}; }
            asm volatile("" ::: "memory");
#pragma unroll
            for (int m = 0; m < 4; ++m)
#pragma unroll
                for (int bj = 0; bj < 2; ++bj) { const size_t off = (size_t)(row0 + ai * 128 + m * 16) * DM + col0 + bj * 128;
                    const f32x4 v0 = acc[ai][bj][m][0], v1 = acc[ai][bj][m][1];
                    float o[8];
#pragma unroll
                    for (int j = 0; j < 4; ++j) { o[j] = fmaf(bf2f((unsigned short)g[m][bj][j]), v0[j], bf2f((unsigned short)t[m][bj][j])); o[4 + j] = fmaf(bf2f((unsigned short)g[m][bj][4 + j]), v1[j], bf2f((unsigned short)t[m][bj][4 + j])); }
                    u32x4 w; w.x = pk2(o[0], o[1]); w.y = pk2(o[2], o[3]); w.z = pk2(o[4], o[5]); w.w = pk2(o[6], o[7]);
                    *(u32x4*)(dst + off) = w; }
            asm volatile("" ::: "memory");
        }
    }
};
struct EpiOut {
    static constexpr bool PERM = false, AFTER_DRAIN = false;
    const float* gate; float* out;
    __device__ __forceinline__ void operator()(const f32x4 (&acc)[2][2][4][2], const pg8::Unit& u, int wr, int wc, int fr, int fq) const {
        const int row0 = u.pm * 256 + wr * 64 + fr, col0 = u.pn * 256 + wc * 32 + 4 * fq;
        const float* gp = gate + (size_t)(u.pm >> 4) * DM + col0;
        f32x4 gv[2][2];
#pragma unroll
        for (int bj = 0; bj < 2; ++bj)
#pragma unroll
            for (int n = 0; n < 2; ++n) gv[bj][n] = *(const f32x4*)(gp + bj * 128 + n * 16);
#pragma unroll
        for (int ai = 0; ai < 2; ++ai)
#pragma unroll
            for (int m = 0; m < 4; ++m) { const size_t off = (size_t)(row0 + ai * 128 + m * 16) * DM + col0;
#pragma unroll
                for (int bj = 0; bj < 2; ++bj)
#pragma unroll
                    for (int n = 0; n < 2; ++n) *(f32x4*)(out + off + bj * 128 + n * 16) = gv[bj][n] * acc[ai][bj][m][n]; }
    }
};

__device__ __forceinline__ void p0_transpose_item(const float* W, int K, int N, bf16_t* WT, int dst_row0, int k0, int n0, LAS float* scr, int lane) {
#pragma unroll 8
    for (int i = 0; i < 32; ++i) { const int kk = 2 * i + (lane >> 5); scr[kk * 33 + (lane & 31)] = W[(size_t)(k0 + kk) * N + n0 + (lane & 31)]; }
    LDS_WAIT(); asm volatile("" ::: "memory");
    const int c = lane & 7;
#pragma unroll
    for (int j = 0; j < 4; ++j) { const int n = (lane >> 3) + 8 * j; const LAS float* s = scr + (8 * c) * 33 + n;
        u32x4 o; o.x = pk2(s[0 * 33], s[1 * 33]); o.y = pk2(s[2 * 33], s[3 * 33]); o.z = pk2(s[4 * 33], s[5 * 33]); o.w = pk2(s[6 * 33], s[7 * 33]);
        *(u32x4*)(WT + (size_t)(dst_row0 + n) * K + k0 + 8 * c) = o; }
    LDS_WAIT(); asm volatile("" ::: "memory");
}

struct Args { const float* in[23]; float* out; unsigned char* ws; };

__device__ __forceinline__ void p0_prologue(const Args& a, LAS unsigned char* lds, int gw, int NGW, int wave, int lane) {
    LAS float* scr = (LAS float*)(lds + wave * 16384);
    unsigned char* ws = a.ws;
    const float* c = a.in[1]; const float* w_c = a.in[3]; const float* w_in = a.in[5];
    float* modp = (float*)(ws + WS_MODP);
    constexpr int I_MOD = 768, I_IN = 16 * 256, I_SQ = 16 * 32, I_G = 4 * 16 * 2;
    constexpr int NITEMS = I_MOD + I_IN + 3 * I_SQ + I_G;
    for (int it = gw; it < NITEMS; it += NGW) {
        int r = it;
        if (r < I_MOD) {
            const int cgi = r % 48, kc = r / 48, col = cgi * 64 + lane, k0 = kc * 64;
            float sv[4];
#pragma unroll
            for (int b = 0; b < 4; ++b) { const float cv = c[b * DM + k0 + lane]; sv[b] = cv * sigm(cv); }
            float acc[4] = {0.f, 0.f, 0.f, 0.f};
#pragma unroll 8
            for (int kk = 0; kk < 64; ++kk) { const float w = w_c[(size_t)(k0 + kk) * 3072 + col];
#pragma unroll
                for (int b = 0; b < 4; ++b) acc[b] += __shfl(sv[b], kk) * w; }
#pragma unroll
            for (int b = 0; b < 4; ++b) modp[(size_t)(kc * 4 + b) * 3072 + col] = acc[b];
            continue;
        }
        r -= I_MOD;
        if (r < I_IN) { const int kb = r / 256, nb = r % 256, n0 = nb * 32, cb = n0 >> 10;
            if (cb == 4) p0_transpose_item(w_in, 1024, 8192, (bf16_t*)(ws + WS_WV), n0 - 4096, kb * 64, n0, scr, lane);
            else p0_transpose_item(w_in, 1024, 8192, (bf16_t*)(ws + WS_WIN), (cb < 4 ? cb : cb - 1) * 1024 + (n0 & 1023), kb * 64, n0, scr, lane);
            continue; }
        r -= I_IN;
        if (r < 3 * I_SQ) { const int which = r / I_SQ, rr = r % I_SQ, kb = rr / 32, nb = rr % 32;
            const float* W = which == 0 ? a.in[19] : (which == 1 ? a.in[20] : a.in[21]);
            bf16_t* WT = (bf16_t*)(ws + (which == 0 ? WS_WPA : (which == 1 ? WS_WPB : WS_WO)));
            p0_transpose_item(W, 1024, 1024, WT, nb * 32, kb * 64, nb * 32, scr, lane);
            continue; }
        r -= 3 * I_SQ;
        { const int g = r / 32, rr = r % 32, hb = rr / 2, nb = rr % 2;
            const float* W = (g == 0 ? a.in[8] : (g == 1 ? a.in[10] : (g == 2 ? a.in[13] : a.in[15]))) + (size_t)hb * 4096;
            bf16_t* WT = (bf16_t*)(ws + WS_WG) + (size_t)(g * 16 + hb) * 4096;
            p0_transpose_item(W, 64, 64, WT, nb * 32, 0, nb * 32, scr, lane); }
    }
}

__device__ __forceinline__ void p1_hpass(const Args& a, LAS unsigned char* lds, int G, int tid, int wave, int lane) {
    unsigned char* ws = a.ws;
    const float* x = a.in[0]; const float* g_pre = a.in[2]; const float* b_c = a.in[4];
    const float* modp = (const float*)(ws + WS_MODP);
    bf16_t* H = (bf16_t*)(ws + WS_H);
    LAS float* sh = (LAS float*)lds;
    for (int rb = blockIdx.x; rb < MTOK / 64; rb += G) {
        const int b = rb >> 6;
        __syncthreads();
        for (int idx = tid; idx < 2048; idx += 512) { float s = b_c[idx];
#pragma unroll
            for (int kc = 0; kc < 16; ++kc) s += modp[(size_t)(kc * 4 + b) * 3072 + idx];
            sh[idx] = idx < 1024 ? s : 1.f + s; }
        __syncthreads();
        for (int rr = wave; rr < 64; rr += 8) { const int row = rb * 64 + rr;
            const f32x4* xr = (const f32x4*)(x + (size_t)row * DM) + lane;
            f32x4 v[4]; float s = 0.f;
#pragma unroll
            for (int j = 0; j < 4; ++j) { v[j] = xr[64 * j]; s += (v[j][0] * v[j][0] + v[j][1] * v[j][1]) + (v[j][2] * v[j][2] + v[j][3] * v[j][3]); }
            const float rstd = __builtin_amdgcn_rsqf(wave_sum(s) * (1.f / 1024.f) + 1e-6f);
#pragma unroll
            for (int j = 0; j < 4; ++j) { const int col = 4 * lane + 256 * j;
                const f32x4 g = *(const f32x4*)(g_pre + col); const f32x4 sc = *(const LAS f32x4*)(sh + 1024 + col); const f32x4 sf = *(const LAS f32x4*)(sh + col);
                const f32x4 o = (v[j] * rstd) * g * sc + sf;
                u32x2 w; w.x = pk2(o[0], o[1]); w.y = pk2(o[2], o[3]);
                *(u32x2*)(H + (size_t)row * DM + col) = w; }
        }
    }
    float* gate = (float*)(ws + WS_GATE);
    for (int idx = blockIdx.x * 512 + tid; idx < 4096; idx += G * 512) { const int b = idx >> 10, col = idx & 1023; float s = b_c[2048 + col];
#pragma unroll
        for (int kc = 0; kc < 16; ++kc) s += modp[(size_t)(kc * 4 + b) * 3072 + 2048 + col];
        gate[idx] = s; }
}

__device__ __forceinline__ void attn_phase(const bf16_t* Q, const bf16_t* Kb, const bf16_t* VT, const bf16_t* ZB, const float* rpb, bf16_t* YB, int vcu, int G, int wave, int lane) {
    const int fr = lane & 15, fq = lane >> 4;
    constexpr int NQ = 4 * 64 * 16 * 4;
    constexpr float L2E = 1.44269504089f;
    for (int qi = vcu * 8 + wave; qi < NQ; qi += G * 8) {
        const int j = qi & 3, item = qi >> 2, r = item & 63, hb = item >> 6, h = hb & 15, b = hb >> 4;
        const int r0 = min(max(r - 4, 0), 56);
        const int cs = min(max(16 * j - 8, 0), 32);
        const int qc = 16 * j + fr, c0 = min(max(qc - 8, 0), 48);
        const size_t tokq = (size_t)b * SEQ + r * 64 + qc;
        bf16x8 qf[2];
#pragma unroll
        for (int ks = 0; ks < 2; ++ks) qf[ks] = *(const bf16x8*)(Q + tokq * DM + h * 64 + ks * 32 + fq * 8);
        f32x4 s[8][2];
#pragma unroll
        for (int w = 0; w < 8; ++w) { const size_t tokrow = (size_t)b * SEQ + (size_t)(r0 + w) * 64;
#pragma unroll
            for (int t = 0; t < 2; ++t) { const int kc = cs + 8 * (fr >> 2) + (fr & 3) + 4 * t;
                f32x4 acc = {0.f, 0.f, 0.f, 0.f};
#pragma unroll
                for (int ks = 0; ks < 2; ++ks) { const bf16x8 kf = *(const bf16x8*)(Kb + (tokrow + kc) * DM + h * 64 + ks * 32 + fq * 8);
                    acc = __builtin_amdgcn_mfma_f32_16x16x32_bf16(kf, qf[ks], acc, 0, 0, 0); }
                s[w][t] = acc; } }
        float mx = -1e30f;
#pragma unroll
        for (int w = 0; w < 8; ++w) { const float* rp = rpb + (size_t)(h * 15 + (r0 + w - r + 7)) * 31;
#pragma unroll
            for (int t = 0; t < 2; ++t)
#pragma unroll
                for (int i = 0; i < 4; ++i) { const int kcol = cs + 8 * fq + 4 * t + i; const bool ok = (kcol >= c0) && (kcol < c0 + 16);
                    const int dcol = min(max(kcol - qc + 15, 0), 30);
                    const float v = ok ? (s[w][t][i] + rp[dcol]) * L2E : -1e30f; s[w][t][i] = v; mx = fmaxf(mx, v); } }
        mx = fmaxf(mx, __shfl_xor(mx, 16)); mx = fmaxf(mx, __shfl_xor(mx, 32));
        float sum = 0.f; bf16x8 pf[8];
#pragma unroll
        for (int w = 0; w < 8; ++w) { float p[8];
#pragma unroll
            for (int t = 0; t < 2; ++t)
#pragma unroll
                for (int i = 0; i < 4; ++i) { const float e = __builtin_amdgcn_exp2f(s[w][t][i] - mx); p[4 * t + i] = e; sum += e; }
            u32x4 pw; pw.x = pk2(p[0], p[1]); pw.y = pk2(p[2], p[3]); pw.z = pk2(p[4], p[5]); pw.w = pk2(p[6], p[7]);
            pf[w] = __builtin_bit_cast(bf16x8, pw); }
        sum += __shfl_xor(sum, 16); sum += __shfl_xor(sum, 32);
        const float inv = 1.f / sum;
        f32x4 o[4];
#pragma unroll
        for (int dt = 0; dt < 4; ++dt) o[dt] = (f32x4){0.f, 0.f, 0.f, 0.f};
#pragma unroll
        for (int w = 0; w < 8; ++w) { const size_t tokrow = (size_t)b * SEQ + (size_t)(r0 + w) * 64;
#pragma unroll
            for (int dt = 0; dt < 4; ++dt) { const bf16x8 vf = *(const bf16x8*)(VT + (size_t)(h * 64 + dt * 16 + fr) * MTOK + tokrow + cs + 8 * fq);
                o[dt] = __builtin_amdgcn_mfma_f32_16x16x32_bf16(vf, pf[w], o[dt], 0, 0, 0); } }
#pragma unroll
        for (int dt = 0; dt < 4; ++dt) { const size_t off = tokq * DM + h * 64 + dt * 16 + 4 * fq;
            const bf16x4 z = *(const bf16x4*)(ZB + off);
            u32x2 w; w.x = pk2(o[dt][0] * inv * bf2f((unsigned short)z[0]), o[dt][1] * inv * bf2f((unsigned short)z[1]));
            w.y = pk2(o[dt][2] * inv * bf2f((unsigned short)z[2]), o[dt][3] * inv * bf2f((unsigned short)z[3]));
            *(u32x2*)(YB + off) = w; }
    }
}

template <bool FINAL, int DIR>
__device__ __forceinline__ void scan_dir(const LAS bf16x8* afrL, int lane, int ct, const bf16_t* WGr, const bf16_t* WGi, float br, float bi, float cl, float Hin,
                                         const bf16x8 (&idf)[2], float& Aout, float& Uout, const bf16_t* ZAp, bf16_t* YAp) {
    const int n = lane & 31, hf = lane >> 5;
    bf16x8 Br[4], Bi[4];
#pragma unroll
    for (int kk = 0; kk < 4; ++kk) { Br[kk] = *(const bf16x8*)(WGr + (size_t)(32 * ct + n) * 64 + 16 * kk + 8 * hf); Bi[kk] = *(const bf16x8*)(WGi + (size_t)(32 * ct + n) * 64 + 16 * kk + 8 * hf); }
    float H = Hin, Ap = 1.f;
#pragma unroll 1
    for (int si = 0; si < 4; ++si) { const int s = DIR ? 3 - si : si;
        f32x16 ar, ai, ax;
#pragma unroll
        for (int e = 0; e < 16; ++e) { ar[e] = 0.f; ai[e] = 0.f; ax[e] = 0.f; }
#pragma unroll
        for (int kk = 0; kk < 4; ++kk) { const bf16x8 av = afrL[(s * 4 + kk) * 64 + lane];
            ar = __builtin_amdgcn_mfma_f32_32x32x16_bf16(av, Br[kk], ar, 0, 0, 0); ai = __builtin_amdgcn_mfma_f32_32x32x16_bf16(av, Bi[kk], ai, 0, 0, 0); }
        { const bf16x8 a0 = afrL[(s * 4 + 2 * ct) * 64 + lane], a1 = afrL[(s * 4 + 2 * ct + 1) * 64 + lane];
            ax = __builtin_amdgcn_mfma_f32_32x32x16_bf16(a0, idf[0], ax, 0, 0, 0); ax = __builtin_amdgcn_mfma_f32_32x32x16_bf16(a1, idf[1], ax, 0, 0, 0); }
        const bf16_t* zs = ZAp + (size_t)(16 * s) * DM; bf16_t* ys = YAp + (size_t)(16 * s) * DM;
#pragma unroll
        for (int ei = 0; ei < 16; ++ei) { const int e = DIR ? 15 - ei : ei;
            const float r = sigm(ar[e] + br), ig = sigm(ai[e] + bi);
            const float av = __builtin_amdgcn_exp2f(cl * r);
            const float om = fmaxf(fmaf(-av, av, 1.f), 0.f);
            const float u = __builtin_amdgcn_sqrtf(om) * (ig * ax[e]);
            H = fmaf(av, H, u);
            if (FINAL) {
                if (DIR == 0) ys[(size_t)e * DM] = (bf16_t)(pk2(H, 0.f) & 0xffffu);
                else ys[(size_t)e * DM] = (bf16_t)(pk2((H + bf2f(ys[(size_t)e * DM])) * bf2f(zs[(size_t)e * DM]), 0.f) & 0xffffu); }
            else Ap *= av; }
    }
    Aout = Ap; Uout = H;
}

template <bool FINAL>
__device__ __forceinline__ void scan_phase(const Args& a, LAS unsigned char* lds, int gw, int NGW, int wave, int lane) {
    unsigned char* ws = a.ws;
    const bf16_t* XA = (const bf16_t*)(ws + WS_XA); const bf16_t* ZA = (const bf16_t*)(ws + WS_ZA);
    const bf16_t* WG = (const bf16_t*)(ws + WS_WG);
    const float* conv_w = a.in[6]; const float* conv_b = a.in[7];
    typedef float f32x2 __attribute__((ext_vector_type(2)));
    f32x2* AGG = (f32x2*)(ws + WS_AGG);
    bf16_t* YA = (bf16_t*)(ws + WS_H);
    LAS bf16x8* afrL = (LAS bf16x8*)(lds + wave * 16384);
    const int n = lane & 31, hf = lane >> 5;
    bf16x8 idf[2];
#pragma unroll
    for (int k2 = 0; k2 < 2; ++k2)
#pragma unroll
        for (int jj = 0; jj < 8; ++jj) idf[k2][jj] = (16 * k2 + 8 * hf + jj == n) ? (short)0x3F80 : (short)0;
    for (int wt = gw; wt < 2048; wt += NGW) {
        const int cp = wt & 31, jb = (wt >> 5) & 15, b = wt >> 9, ch0 = jb * 64;
        { const int a_half = (n >> 2) & 1, a_idx = (n & 3) + 4 * (n >> 3), a_chunk = 2 * cp + a_half;
#pragma unroll 1
          for (int kk = 0; kk < 4; ++kk) { const int ch = ch0 + 16 * kk + 8 * hf;
              float cw[4][8], cb[8];
#pragma unroll
              for (int w = 0; w < 4; ++w) { const f32x4 c0 = *(const f32x4*)(conv_w + w * DM + ch), c1 = *(const f32x4*)(conv_w + w * DM + ch + 4);
#pragma unroll
                  for (int jj = 0; jj < 4; ++jj) { cw[w][jj] = c0[jj]; cw[w][4 + jj] = c1[jj]; } }
              { const f32x4 c0 = *(const f32x4*)(conv_b + ch), c1 = *(const f32x4*)(conv_b + ch + 4);
#pragma unroll
                  for (int jj = 0; jj < 4; ++jj) { cb[jj] = c0[jj]; cb[4 + jj] = c1[jj]; } }
#pragma unroll
              for (int s = 0; s < 4; ++s) { const int p = a_chunk * 64 + 16 * s + a_idx;
                  float acc[8];
#pragma unroll
                  for (int jj = 0; jj < 8; ++jj) acc[jj] = cb[jj];
#pragma unroll
                  for (int w = 0; w < 4; ++w) { const int pp = p + w - 2; const bool ok = (pp >= 0) && (pp < SEQ); const int pc = min(max(pp, 0), SEQ - 1);
                      const bf16x8 xv = *(const bf16x8*)(XA + ((size_t)b * SEQ + pc) * DM + ch);
#pragma unroll
                      for (int jj = 0; jj < 8; ++jj) acc[jj] = fmaf(cw[w][jj], ok ? bf2f((unsigned short)xv[jj]) : 0.f, acc[jj]); }
                  u32x4 pw; pw.x = pk2(acc[0], acc[1]); pw.y = pk2(acc[2], acc[3]); pw.z = pk2(acc[4], acc[5]); pw.w = pk2(acc[6], acc[7]);
                  afrL[(s * 4 + kk) * 64 + lane] = __builtin_bit_cast(bf16x8, pw); } } }
        LDS_WAIT(); asm volatile("" ::: "memory");
        const int chunk = 2 * cp + hf;
        if (FINAL) {
            const int tid = threadIdx.x, pdir = tid >> 8, pseg = (tid >> 6) & 3, pch = tid & 63, q = cp >> 3;
            LAS f32x2* segL = (LAS f32x2*)(lds + LDS_SEG);
            LAS float* cinL = (LAS float*)(lds + LDS_CIN);
            f32x2 g[16];
#pragma unroll
            for (int i = 0; i < 16; ++i) g[i] = AGG[((size_t)(b * 2 + pdir) * 64 + 16 * pseg + i) * DM + ch0 + pch];
            float As = 1.f, Us = 0.f;
#pragma unroll
            for (int ii = 0; ii < 16; ++ii) { const int i = pdir ? 15 - ii : ii; Us = fmaf(g[i][0], Us, g[i][1]); As *= g[i][0]; }
            __syncthreads();
            segL[(pdir * 4 + pseg) * 64 + pch] = (f32x2){As, Us};
            __syncthreads();
            if (pseg == q) { float Hc = 0.f;
                if (pdir == 0) { for (int s2 = 0; s2 < pseg; ++s2) { const f32x2 sg = segL[(0 * 4 + s2) * 64 + pch]; Hc = fmaf(sg[0], Hc, sg[1]); } }
                else { for (int s2 = 3; s2 > pseg; --s2) { const f32x2 sg = segL[(1 * 4 + s2) * 64 + pch]; Hc = fmaf(sg[0], Hc, sg[1]); } }
#pragma unroll
                for (int ii = 0; ii < 16; ++ii) { const int i = pdir ? 15 - ii : ii; cinL[(pdir * 16 + i) * 64 + pch] = Hc; Hc = fmaf(g[i][0], Hc, g[i][1]); } }
            __syncthreads();
        }
#pragma unroll 1
        for (int ct = 0; ct < 2; ++ct) { const int ch = ch0 + 32 * ct + n;
            float Af, Uf, Ab, Ub;
            {
                const float br = a.in[9][ch], bi = a.in[11][ch]; const float lam = a.in[12][ch];
                const float cl = -8.f * 1.44269504089f * log1pf(expf(-lam));
                float Hin = 0.f;
                if (FINAL) Hin = ((const LAS float*)(lds + LDS_CIN))[(0 * 16 + (chunk & 15)) * 64 + 32 * ct + n];
                scan_dir<FINAL, 0>(afrL, lane, ct, WG + (size_t)(0 * 16 + jb) * 4096, WG + (size_t)(1 * 16 + jb) * 4096, br, bi, cl, Hin, idf, Af, Uf, ZA + ((size_t)b * SEQ + chunk * 64) * DM + ch, YA + ((size_t)b * SEQ + chunk * 64) * DM + ch);
            }
            {
                const float br = a.in[14][ch], bi = a.in[16][ch]; const float lam = a.in[17][ch];
                const float cl = -8.f * 1.44269504089f * log1pf(expf(-lam));
                float Hin = 0.f;
                if (FINAL) Hin = ((const LAS float*)(lds + LDS_CIN))[(1 * 16 + (chunk & 15)) * 64 + 32 * ct + n];
                scan_dir<FINAL, 1>(afrL, lane, ct, WG + (size_t)(2 * 16 + jb) * 4096, WG + (size_t)(3 * 16 + jb) * 4096, br, bi, cl, Hin, idf, Ab, Ub, ZA + ((size_t)b * SEQ + chunk * 64) * DM + ch, YA + ((size_t)b * SEQ + chunk * 64) * DM + ch);
            }
            if (!FINAL) {
                AGG[((size_t)(b * 2 + 0) * 64 + chunk) * DM + ch] = (f32x2){Af, Uf};
                AGG[((size_t)(b * 2 + 1) * 64 + chunk) * DM + ch] = (f32x2){Ab, Ub};
            }
        }
        LDS_WAIT(); asm volatile("" ::: "memory");
    }
}

__device__ __forceinline__ void final_norm(const Args& a, int gw, int NGW, int lane) {
    const float* x = a.in[0]; const float* g_final = a.in[22]; float* out = a.out;
    f32x4 g[4];
#pragma unroll
    for (int j = 0; j < 4; ++j) g[j] = *((const f32x4*)g_final + lane + 64 * j);
    for (int row = gw; row < MTOK; row += NGW) {
        f32x4* orow = (f32x4*)(out + (size_t)row * DM) + lane; const f32x4* xrow = (const f32x4*)(x + (size_t)row * DM) + lane;
        f32x4 v[4]; float ss = 0.f;
#pragma unroll
        for (int j = 0; j < 4; ++j) { v[j] = orow[64 * j] + xrow[64 * j]; ss += (v[j][0] * v[j][0] + v[j][1] * v[j][1]) + (v[j][2] * v[j][2] + v[j][3] * v[j][3]); }
        const float rstd = __builtin_amdgcn_rsqf(wave_sum(ss) * (1.f / 1024.f) + 1e-6f);
#pragma unroll
        for (int j = 0; j < 4; ++j) orow[64 * j] = v[j] * rstd * g[j];
    }
}

#define XB_TMO      128
#define XB_XCNT(j)  (256  + 64 * (j))
#define XB_XSUB(j)  (1280 + 64 * (j))
#define XB_XGEN(j)  (2304 + 64 * (j))
#define XB_TOP      3328
#define XB_TOPGEN   3392
#define XCD_BAR_WORDS 3456
#define XB_SPIN_CAP (1u << 18)
__device__ __forceinline__ unsigned xb_ld(unsigned* p)              { return __hip_atomic_load(p, __ATOMIC_RELAXED, __HIP_MEMORY_SCOPE_AGENT); }
__device__ __forceinline__ unsigned xb_add(unsigned* p, unsigned v) { return __hip_atomic_fetch_add(p, v, __ATOMIC_RELAXED, __HIP_MEMORY_SCOPE_AGENT); }
__device__ __forceinline__ unsigned xb_xcc_id() { return (unsigned)__builtin_amdgcn_s_getreg((3 << 11) | 20) & 0xFu; }
#define XB_SPIN(cond, bar) do { unsigned _sp = 0; while (cond) { __builtin_amdgcn_s_sleep(1); \
    if ((++_sp & 255u) == 0u) { if (xb_ld(&(bar)[XB_TMO])) break; if (_sp > XB_SPIN_CAP) { atomicAdd(&(bar)[XB_TMO], 1u); break; } } } } while (0)
struct XcdBarrier { unsigned* bar; unsigned x; volatile LAS unsigned* st; };
__device__ __forceinline__ XcdBarrier xcd_barrier_post(unsigned* bar, volatile LAS unsigned* st) {
    XcdBarrier b; b.bar = bar; b.x = xb_xcc_id(); b.st = st;
    if (threadIdx.x == 0) (void)xb_add(&bar[XB_XCNT(b.x)], 1u);
    return b;
}
__device__ __forceinline__ void xcd_barrier_complete(unsigned* bar, unsigned x, unsigned& nloc, unsigned& nx) {
    const unsigned G = gridDim.x * gridDim.y * gridDim.z;
    unsigned sum, cnt, mine, sp = 0u;
    for (;;) {
        sum = 0u; cnt = 0u; mine = 0u;
#pragma unroll
        for (unsigned j = 0; j < 16; ++j) { const unsigned c = xb_ld(&bar[XB_XCNT(j)]); sum += c; cnt += (c > 0u) ? 1u : 0u; mine = (j == x) ? c : mine; }
        if (sum == G) break;
        __builtin_amdgcn_s_sleep(1);
        if ((++sp & 255u) == 0u) { if (xb_ld(&bar[XB_TMO])) break; if (sp > XB_SPIN_CAP) { atomicAdd(&bar[XB_TMO], 1u); break; } }
    }
    nloc = mine > 0u ? mine : 1u; nx = cnt > 0u ? cnt : 1u;
}
__device__ __forceinline__ void xcd_barrier(const XcdBarrier& b) {
    asm volatile("s_waitcnt vmcnt(0)" ::: "memory");
    __syncthreads();
    if (threadIdx.x == 0) {
        unsigned* bar = b.bar;
        __builtin_amdgcn_s_waitcnt(0);
        unsigned nloc = b.st[0], nx = b.st[1];
        if (nloc == 0u) { xcd_barrier_complete(bar, b.x, nloc, nx); b.st[0] = nloc; b.st[1] = nx; }
        const unsigned old = xb_add(&bar[XB_XSUB(b.x)], 1u);
        const unsigned gen = old / nloc;
        if (old + 1u == (gen + 1u) * nloc) {
            __builtin_amdgcn_fence(__ATOMIC_RELEASE, "agent");
            asm volatile("s_waitcnt vmcnt(0)" ::: "memory");
            const unsigned og = xb_add(&bar[XB_TOP], 1u);
            const unsigned tg = og / nx;
            if (og + 1u == (tg + 1u) * nx) xb_add(&bar[XB_TOPGEN], 1u);
            else XB_SPIN(xb_ld(&bar[XB_TOPGEN]) == tg, bar);
            __builtin_amdgcn_fence(__ATOMIC_ACQUIRE, "agent");
            xb_add(&bar[XB_XGEN(b.x)], 1u);
            asm volatile("s_waitcnt vmcnt(0)" ::: "memory");
        } else {
            XB_SPIN(xb_ld(&bar[XB_XGEN(b.x)]) == gen, bar);
            __builtin_amdgcn_fence(__ATOMIC_ACQUIRE, "agent");
            asm volatile("s_waitcnt vmcnt(0)" ::: "memory");
        }
    }
    __syncthreads();
}

__global__ void __launch_bounds__(512, 2) fwd_kernel(Args a) {
    extern __shared__ __attribute__((aligned(16))) unsigned char lds_raw[];
    LAS unsigned char* lds = (LAS unsigned char*)lds_raw;
    cg::grid_group grid = cg::this_grid();
    const int tid = threadIdx.x, lane = tid & 63, wave = __builtin_amdgcn_readfirstlane(tid >> 6);
    const int G = gridDim.x, bx = blockIdx.x;
    const int vcu = (G % 8 == 0) ? (bx % 8) * (G / 8) + bx / 8 : bx;
    const int gw = bx * 8 + wave, NGW = G * 8;
    unsigned char* ws = a.ws;
#ifdef PROBE_A0
    unsigned long long tA0 = 0, tA1 = 0, tB0 = 0, tB1 = 0;
#define STAMP(k) do { const unsigned long long _t = __builtin_amdgcn_s_memrealtime(); if ((k) == PROBE_A0) tA0 = _t; if ((k) == PROBE_A1) tA1 = _t; if ((k) == PROBE_B0) tB0 = _t; if ((k) == PROBE_B1) tB1 = _t; } while (0)
#else
#define STAMP(k) do {} while (0)
#endif
    STAMP(0);
    unsigned* barw = (unsigned*)(ws + WS_BAR);
    if (bx == 0) for (int i = tid; i < XCD_BAR_WORDS; i += 512) barw[i] = 0u;
    if (tid < 4) ((volatile LAS unsigned*)(lds + LDS_MISC))[tid] = 0u;

#define PH(k) (!defined(ONLY) || ONLY == (k))
#if !defined(ONLY) || ONLY == 0
    p0_prologue(a, lds, gw, NGW, wave, lane);
#endif
    STAMP(1);
    grid.sync();
    XcdBarrier xb = xcd_barrier_post(barw, (volatile LAS unsigned*)(lds + LDS_MISC));
    STAMP(2);
#if !defined(ONLY) || ONLY == 1
    p1_hpass(a, lds, G, tid, wave, lane);
#endif
    STAMP(3);
    xcd_barrier(xb);
    STAMP(4);
#if !defined(ONLY) || ONLY == 2
    {
        pg8::Gemm g{(const bf16_t*)(ws + WS_H), (const bf16_t*)(ws + WS_WIN), MTOK, 7168, 1024}; pg8::StaticOrder S; S.init(MTOK, 7168, G, bx);
        EpiProj E{(bf16_t*)(ws + WS_XA), (bf16_t*)a.out};
        pg8::gemm_phase<EpiProj, pg8::StaticOrder, PG8_ALIGN, PG8_SP2>(lds, g, S, E);
    }
    STAMP(5);
    {
        pg8::Gemm g{(const bf16_t*)(ws + WS_WV), (const bf16_t*)(ws + WS_H), 1024, MTOK, 1024}; pg8::StaticOrder S; S.init(1024, MTOK, G, bx);
        EpiPlain E{(bf16_t*)(ws + WS_VT), MTOK};
        pg8::gemm_phase<EpiPlain, pg8::StaticOrder, PG8_ALIGN, PG8_SP2>(lds, g, S, E);
    }
    STAMP(6);
#endif
    xcd_barrier(xb);
    STAMP(7);
#if !defined(ONLY) || ONLY == 3
    attn_phase((const bf16_t*)(ws + WS_Q), (const bf16_t*)(ws + WS_K), (const bf16_t*)(ws + WS_VT), (const bf16_t*)(ws + WS_ZB), a.in[18], (bf16_t*)(ws + WS_Q), vcu, G, wave, lane);
#endif
    STAMP(8);
#if !defined(ONLY) || ONLY == 4
    scan_phase<false>(a, lds, gw, NGW, wave, lane);
#endif
    STAMP(9);
    xcd_barrier(xb);
    STAMP(10);
#if !defined(ONLY) || ONLY == 5
    scan_phase<true>(a, lds, gw, NGW, wave, lane);
#endif
    STAMP(11);
    xcd_barrier(xb);
    STAMP(12);
#if !defined(ONLY) || ONLY == 6
    {
        pg8::Gemm g{(const bf16_t*)(ws + WS_H), (const bf16_t*)(ws + WS_WPA), MTOK, 1024, 1024, (const bf16_t*)(ws + WS_Q), (const bf16_t*)(ws + WS_WPB)}; pg8::PairOrder S; S.init(MTOK, 1024, G, bx);
        EpiGate2 E{(const bf16_t*)a.out, (const bf16_t*)a.out + ARR, (bf16_t*)(ws + WS_K), (bf16_t*)(ws + WS_XA)};
        pg8::gemm_phase<EpiGate2, pg8::PairOrder, PG8_ALIGN, PG8_SP2>(lds, g, S, E);
    }
    STAMP(14);
#endif
    xcd_barrier(xb);
    STAMP(15);
#if !defined(ONLY) || ONLY == 7
    {
        pg8::Gemm g{(const bf16_t*)(ws + WS_XA), (const bf16_t*)(ws + WS_WO), MTOK, 1024, 1024}; pg8::StaticOrder S; S.init(MTOK, 1024, G, bx);
        EpiOut E{(const float*)(ws + WS_GATE), a.out};
        pg8::gemm_phase<EpiOut, pg8::StaticOrder, PG8_ALIGN, PG8_SP2>(lds, g, S, E);
    }
    STAMP(16);
#endif
    xcd_barrier(xb);
    STAMP(17);
#if !defined(ONLY) || ONLY == 8
    final_norm(a, gw, NGW, lane);
#endif
#ifdef PROBE_A0
    STAMP(18);
    if (bx == 0) {
        const float dA = (float)(tA1 - tA0) * 0.01f, dB = (float)(tB1 - tB0) * 0.01f;
        __syncthreads();
        float* orow = a.out + (size_t)wave * DM;
        for (int i = lane; i < DM; i += 64) orow[i] += dB;
        __syncthreads();
        if (tid == 0) a.out[0] += dA;
    }
#endif
}

extern "C" void kernel_launch(void* const* d_in, const int* in_sizes, int n_in, void* d_out, int out_size, void* d_ws, size_t ws_size, hipStream_t stream) {
    static int grid = 0;
    if (grid == 0) {
        if (n_in != 23 || out_size != MTOK * DM || ws_size < 256 * MiB) { fprintf(stderr, "kernel_launch: unexpected problem shape (n_in %d, out %d, ws %zu)\n", n_in, out_size, ws_size); grid = -1; return; }
        int dev = 0, cus = 0, per_cu = 0;
        (void)hipGetDevice(&dev);
        (void)hipDeviceGetAttribute(&cus, hipDeviceAttributeMultiprocessorCount, dev);
        if (hipFuncSetAttribute((const void*)fwd_kernel, hipFuncAttributeMaxDynamicSharedMemorySize, LDS_BYTES) != hipSuccess) { fprintf(stderr, "kernel_launch: hipFuncSetAttribute failed\n"); grid = -1; return; }
        if (hipOccupancyMaxActiveBlocksPerMultiprocessor(&per_cu, (const void*)fwd_kernel, 512, LDS_BYTES) != hipSuccess || per_cu < 1) { fprintf(stderr, "kernel_launch: occupancy query failed (%d)\n", per_cu); per_cu = 1; (void)hipGetLastError(); }
        grid = cus * per_cu;
        if (grid <= 0) { grid = -1; return; }
    }
    if (grid < 0) return;
    Args a{};
    for (int i = 0; i < 23; ++i) a.in[i] = (const float*)d_in[i];
    a.out = (float*)d_out; a.ws = (unsigned char*)d_ws;
    void* args[] = {&a};
    hipError_t e = hipLaunchCooperativeKernel((const void*)fwd_kernel, dim3(grid), dim3(512), args, LDS_BYTES, stream);
    if (e != hipSuccess) fprintf(stderr, "kernel_launch: cooperative launch failed: %s (grid %d)\n", hipGetErrorString(e), grid);
}
```

```cpp
#include <hip/hip_runtime.h>
#include <hip/hip_cooperative_groups.h>
#include <cstdio>
#include <cstdint>
namespace cg = cooperative_groups;
namespace pg8 {
#define PG8_LAS __attribute__((address_space(3)))
typedef unsigned short bf16_t;
typedef short bf16x8 __attribute__((ext_vector_type(8)));
typedef float f32x4 __attribute__((ext_vector_type(4)));
typedef unsigned u32x4 __attribute__((ext_vector_type(4)));
constexpr int BM = 256, BK = 64, HALF = 128, HTB = HALF * BK * 2  , STAGE_BYTES = 8 * HTB, NXCD = 8, WGM = 8;

__host__ __device__ __forceinline__ int lds_byte(int r, int c) { const int st = (r >> 4) * 2 + (c >> 5), rr = r & 15, cc = c & 31, ob = rr * 64 + cc * 2; return st * 1024 + (ob ^ (((ob >> 9) & 1) << 5)); }
__host__ __device__ __forceinline__ void stage_rc(int b, int& R, int& C) { const int st = b / 1024, sb = b % 1024, swz = sb ^ (((sb >> 9) & 1) << 5); R = (st >> 1) * 16 + swz / 64; C = (st & 1) * 32 + (swz % 64) / 2; }
__host__ __device__ __forceinline__ int perm32(int rho) { const int n = rho >> 4, i = rho & 15; return 8 * (i >> 2) + 4 * n + (i & 3); }

struct Unit { int pm, pn, w; };
struct Gemm { const bf16_t* A; const bf16_t* Bt; int M, N, K; const bf16_t* A2; const bf16_t* Bt2; };

struct StaticOrder {
    int nM, nN, nwg, G, c;
    __host__ __device__ void init(int M, int N, int G_, int c_) { nM = M / BM; nN = N / BM; nwg = nM * nN; G = G_; c = c_; }
    __host__ __device__ bool next(int i, Unit& u) const {
        const long L = (long)i * G + c; if (L >= nwg) return false;
        int wgid = (int)L; { const int q = nwg / NXCD, r = nwg % NXCD, xcd = wgid % NXCD, off = wgid / NXCD; wgid = (xcd < r ? xcd * (q + 1) : r * (q + 1) + (xcd - r) * q) + off; }
        const int nig = WGM * nN, gid = wgid / nig, fm = gid * WGM, gsz = (nM - fm) < WGM ? (nM - fm) : WGM;
        u.pm = fm + ((wgid % nig) % gsz); u.pn = (wgid % nig) / gsz; u.w = 0; return true;
    }
    __device__ __forceinline__ void a_ready(const Unit&) const {}
    __device__ __forceinline__ void done(const Unit&) const {}
};
struct PairOrder : StaticOrder {
    __host__ __device__ bool next(int i, Unit& u) const { if (!StaticOrder::next(i >> 1, u)) return false; u.w = i & 1; return true; }
};
__device__ __forceinline__ unsigned cvt_pk_bf16(float lo, float hi) { unsigned r; asm volatile("v_cvt_pk_bf16_f32 %0, %1, %2" : "=v"(r) : "v"(lo), "v"(hi)); return r; }
typedef float f32x2 __attribute__((ext_vector_type(2)));
template <class Epi, class Sched, bool ALIGN_EPI = false, bool SP2 = false>
__device__ __forceinline__ void gemm_phase(PG8_LAS unsigned char* lds, const Gemm g, const Sched& S, const Epi& E) {
    const int tid = threadIdx.x, wid = __builtin_amdgcn_readfirstlane(tid >> 6), lane = tid & 63, wr = wid >> 2, wc = wid & 3, fr = lane & 15, fq = lane >> 4;
    const int K = g.K, nt = K / BK;
    unsigned voffA[2], voffB[2];
#pragma unroll
    for (int i = 0; i < 2; ++i) { int R, C; stage_rc(tid * 16 + i * 8192, R, C); const int Rb = Epi::PERM ? ((R & ~31) + perm32(R & 31)) : R;
        voffA[i] = (unsigned)(R * K + C) * 2u; voffB[i] = (unsigned)(Rb * K + C) * 2u; }
    const size_t kstep = (size_t)(BK * 2);
    const size_t hstep = (size_t)HALF * K * 2;
    const size_t tstep = 2 * hstep;
    const unsigned ldsw = (unsigned)wid * 1024u;
    const int aoff = lds_byte(wr * 64 + fr, fq * 8), boff = lds_byte(wc * 32 + fr, fq * 8);
#define PG8_SA(b, h) (((b) * 2 + (h)) * HTB)
#define PG8_SB(b, h) ((4 + (b) * 2 + (h)) * HTB)
#define PG8_STAGE(bufoff, gbase, voff) do { _Pragma("unroll") for (int _i = 0; _i < 2; ++_i) \
        __builtin_amdgcn_global_load_lds((const unsigned*)((const char*)(gbase) + (voff)[_i]), (PG8_LAS unsigned*)(lds + (bufoff) + ldsw + _i * 8192), 16, 0, 0); } while (0)
#define PG8_LDA(dst, b, h) do { _Pragma("unroll") for (int m = 0; m < 4; ++m) _Pragma("unroll") for (int k = 0; k < 2; ++k) dst[m][k] = *(const PG8_LAS bf16x8*)(lds + PG8_SA(b, h) + aoff + m * 2048 + k * 1024); } while (0)
#define PG8_LDB(dst, b, h) do { _Pragma("unroll") for (int n = 0; n < 2; ++n) _Pragma("unroll") for (int k = 0; k < 2; ++k) dst[n][k] = *(const PG8_LAS bf16x8*)(lds + PG8_SB(b, h) + boff + n * 2048 + k * 1024); } while (0)
#define PG8_MMA(ai, bj, At, Bt) do { __builtin_amdgcn_s_setprio(1); _Pragma("unroll") for (int m = 0; m < 4; ++m) _Pragma("unroll") for (int n = 0; n < 2; ++n) _Pragma("unroll") for (int k = 0; k < 2; ++k) \
        acc[ai][bj][m][n] = __builtin_amdgcn_mfma_f32_16x16x32_bf16(Bt[n][k], At[m][k], acc[ai][bj][m][n], 0, 0, 0); __builtin_amdgcn_s_setprio(0); } while (0)
#define PG8_WAIT_V(n) asm volatile("s_waitcnt vmcnt(" #n ")" ::: "memory")
#define PG8_WAIT_L(n) asm volatile("s_waitcnt lgkmcnt(" #n ")" ::: "memory")
#define PG8_BAR __builtin_amdgcn_s_barrier()
#define PG8_SCHED __builtin_amdgcn_sched_barrier(0)
    Unit cur, nxt; int ui = 0;
    if (!S.next(0, cur)) return;
    f32x4 acc[2][2][4][2];
#pragma unroll
    for (int a = 0; a < 2; ++a)
#pragma unroll
        for (int b = 0; b < 2; ++b)
#pragma unroll
            for (int m = 0; m < 4; ++m)
#pragma unroll
                for (int n = 0; n < 2; ++n) acc[a][b][m][n] = (f32x4){0.f, 0.f, 0.f, 0.f};
    bf16x8 At[4][2], B0[2][2], B1[2][2];
    const char* cA = (const char*)(cur.w ? g.A2 : g.A) + (size_t)cur.pm * tstep; const char* cB = (const char*)(cur.w ? g.Bt2 : g.Bt) + (size_t)cur.pn * tstep;
    S.a_ready(cur);
    if constexpr (SP2) {
        PG8_STAGE(PG8_SB(0, 0), cB, voffB); PG8_STAGE(PG8_SB(0, 1), cB + hstep, voffB); PG8_STAGE(PG8_SA(0, 0), cA, voffA); PG8_STAGE(PG8_SA(0, 1), cA + hstep, voffA);
        if (wr == 1) PG8_BAR;
        PG8_WAIT_V(2); PG8_BAR;
        PG8_STAGE(PG8_SB(1, 0), cB + kstep, voffB); PG8_STAGE(PG8_SA(1, 0), cA + kstep, voffA); PG8_STAGE(PG8_SB(1, 1), cB + hstep + kstep, voffB);
        PG8_WAIT_V(6); PG8_BAR;
    } else {
        PG8_STAGE(PG8_SB(0, 0), cB, voffB); PG8_STAGE(PG8_SA(0, 0), cA, voffA); PG8_STAGE(PG8_SB(0, 1), cB + hstep, voffB); PG8_STAGE(PG8_SA(0, 1), cA + hstep, voffA);
        if (wr == 1) PG8_BAR;
        PG8_WAIT_V(4); PG8_BAR;
        PG8_STAGE(PG8_SB(1, 0), cB + kstep, voffB); PG8_STAGE(PG8_SA(1, 0), cA + kstep, voffA); PG8_STAGE(PG8_SB(1, 1), cB + hstep + kstep, voffB);
        PG8_WAIT_V(6); PG8_BAR;
    }
    for (;;) {
        const bool has_next = S.next(ui + 1, nxt);
        const char* nA = has_next ? (const char*)(nxt.w ? g.A2 : g.A) + (size_t)nxt.pm * tstep : cA; const char* nB = has_next ? (const char*)(nxt.w ? g.Bt2 : g.Bt) + (size_t)nxt.pn * tstep : cB;
        for (int t = 0; t < nt; t += 2) {
            const bool last = (t == nt - 2);
            const char* a1 = cA + (size_t)(t + 1) * kstep;
            const char* a2 = last ? nA : cA + (size_t)(t + 2) * kstep; const char* b2 = last ? nB : cB + (size_t)(t + 2) * kstep;
            const char* a3 = a2 + kstep; const char* b3 = b2 + kstep;
            if (last && has_next) S.a_ready(nxt);
            if constexpr (SP2) {
            PG8_LDB(B0, 0, 0); PG8_LDB(B1, 0, 1); PG8_SCHED; PG8_LDA(At, 0, 0); PG8_STAGE(PG8_SA(1, 1), a1 + hstep, voffA);
            PG8_WAIT_V(8); PG8_WAIT_L(0); PG8_BAR; PG8_MMA(0, 0, At, B0); PG8_MMA(0, 1, At, B1); PG8_BAR; PG8_SCHED;
            PG8_LDA(At, 0, 1); PG8_STAGE(PG8_SB(0, 0), b2, voffB); PG8_STAGE(PG8_SB(0, 1), b2 + hstep, voffB); PG8_STAGE(PG8_SA(0, 0), a2, voffA);
            PG8_WAIT_V(8); PG8_WAIT_L(0); PG8_BAR; PG8_MMA(1, 0, At, B0); PG8_MMA(1, 1, At, B1); PG8_BAR; PG8_SCHED;
            PG8_LDB(B0, 1, 0); PG8_LDB(B1, 1, 1); PG8_SCHED; PG8_LDA(At, 1, 0); PG8_STAGE(PG8_SA(0, 1), a2 + hstep, voffA);
            PG8_WAIT_V(8); PG8_WAIT_L(0); PG8_BAR; PG8_MMA(0, 0, At, B0); PG8_MMA(0, 1, At, B1); PG8_BAR; PG8_SCHED;
            PG8_LDA(At, 1, 1); PG8_STAGE(PG8_SB(1, 0), b3, voffB); PG8_STAGE(PG8_SB(1, 1), b3 + hstep, voffB); PG8_STAGE(PG8_SA(1, 0), a3, voffA);
            PG8_WAIT_V(8); PG8_WAIT_L(0); PG8_BAR; PG8_MMA(1, 0, At, B0); PG8_MMA(1, 1, At, B1); PG8_BAR; PG8_SCHED;
            } else {
            PG8_LDB(B0, 0, 0); PG8_SCHED; PG8_LDA(At, 0, 0); PG8_STAGE(PG8_SA(1, 1), a1 + hstep, voffA);
            PG8_WAIT_L(8); PG8_BAR; PG8_WAIT_L(0); PG8_MMA(0, 0, At, B0); PG8_BAR; PG8_SCHED;
            PG8_LDB(B1, 0, 1); PG8_STAGE(PG8_SB(0, 0), b2, voffB);
            PG8_BAR; PG8_WAIT_L(0); PG8_MMA(0, 1, At, B1); PG8_BAR;
            PG8_LDA(At, 0, 1); PG8_STAGE(PG8_SA(0, 0), a2, voffA);
            PG8_BAR; PG8_WAIT_L(0); PG8_MMA(1, 0, At, B0); PG8_BAR; PG8_SCHED;
            PG8_STAGE(PG8_SB(0, 1), b2 + hstep, voffB);
            PG8_WAIT_V(6); PG8_BAR; PG8_MMA(1, 1, At, B1); PG8_BAR;
            PG8_LDB(B0, 1, 0); PG8_SCHED; PG8_LDA(At, 1, 0); PG8_STAGE(PG8_SA(0, 1), a2 + hstep, voffA);
            PG8_WAIT_L(8); PG8_BAR; PG8_WAIT_L(0); PG8_MMA(0, 0, At, B0); PG8_BAR; PG8_SCHED;
            PG8_LDB(B1, 1, 1); PG8_STAGE(PG8_SB(1, 0), b3, voffB);
            PG8_BAR; PG8_WAIT_L(0); PG8_MMA(0, 1, At, B1); PG8_BAR;
            PG8_LDA(At, 1, 1); PG8_STAGE(PG8_SA(1, 0), a3, voffA);
            PG8_BAR; PG8_WAIT_L(0); PG8_MMA(1, 0, At, B0); PG8_BAR; PG8_SCHED;
            PG8_STAGE(PG8_SB(1, 1), b3 + hstep, voffB);
            PG8_WAIT_V(6); PG8_BAR; PG8_MMA(1, 1, At, B1); PG8_BAR;
            }
        }
        if constexpr (ALIGN_EPI) { if (wr == 0) PG8_BAR; }
        if constexpr (!Epi::AFTER_DRAIN) { E(acc, cur, wr, wc, fr, fq); S.done(cur); }
        if (!has_next) break;
#pragma unroll
        for (int a = 0; a < 2; ++a)
#pragma unroll
            for (int b = 0; b < 2; ++b)
#pragma unroll
                for (int m = 0; m < 4; ++m)
#pragma unroll
                    for (int n = 0; n < 2; ++n) acc[a][b][m][n] = (f32x4){0.f, 0.f, 0.f, 0.f};
        cur = nxt; cA = nA; cB = nB; ++ui;
        if constexpr (ALIGN_EPI) { if (wr == 1) PG8_BAR; }
    }
    PG8_WAIT_V(0);
    if constexpr (!ALIGN_EPI) { if (wr == 0) PG8_BAR; }
    PG8_BAR;
    if constexpr (Epi::AFTER_DRAIN) { E.fused(acc, cur, wr, wc, fr, fq, lds, wid, lane); S.done(cur); }
#undef PG8_SA
#undef PG8_SB
#undef PG8_STAGE
#undef PG8_LDA
#undef PG8_LDB
#undef PG8_MMA
#undef PG8_WAIT_V
#undef PG8_WAIT_L
#undef PG8_BAR
#undef PG8_SCHED
}
}
#ifndef PG8_SP2
#define PG8_SP2 true
#endif
#ifndef PG8_ALIGN
#define PG8_ALIGN true
#endif

#define LAS __attribute__((address_space(3)))
typedef unsigned short bf16_t;
typedef short bf16x8 __attribute__((ext_vector_type(8)));
typedef short bf16x4 __attribute__((ext_vector_type(4)));
typedef float f32x4 __attribute__((ext_vector_type(4)));
typedef float f32x16 __attribute__((ext_vector_type(16)));
typedef unsigned u32x4 __attribute__((ext_vector_type(4)));
typedef unsigned u32x2 __attribute__((ext_vector_type(2)));

constexpr int MTOK = 16384, DM = 1024, SEQ = 4096, NB = 4;
constexpr size_t MiB = 1u << 20;
constexpr size_t ARR = (size_t)MTOK * DM;
constexpr size_t WS_MODP = 0;
constexpr size_t WS_GATE = 786432;
constexpr size_t WS_AGG = 1 * MiB;
constexpr size_t WS_RSS = 5 * MiB;
constexpr size_t WS_WG = 6 * MiB;
constexpr size_t WS_WPA = 8 * MiB, WS_WPB = 10 * MiB, WS_WO = 12 * MiB, WS_WV = 14 * MiB;
constexpr size_t WS_WIN = 16 * MiB;
constexpr size_t WS_H = 32 * MiB;
constexpr size_t WS_XA = 64 * MiB, WS_ZA = 96 * MiB, WS_Q = 128 * MiB, WS_K = 160 * MiB, WS_ZB = 192 * MiB;
constexpr size_t WS_VT = 224 * MiB;
constexpr size_t WS_BAR = 802816;
constexpr int LDS_CIN = 131072, LDS_SEG = 131072 + 8192, LDS_MISC = 131072 + 12288;
constexpr int LDS_BYTES = 131072 + 12288 + 256;

__device__ __forceinline__ float bf2f(unsigned short b) { return __uint_as_float(((unsigned)b) << 16); }
__device__ __forceinline__ unsigned pk2(float lo, float hi) { return pg8::cvt_pk_bf16(lo, hi); }
__device__ __forceinline__ float sigm(float v) { return __builtin_amdgcn_rcpf(1.f + __builtin_amdgcn_exp2f(-1.44269504089f * v)); }
__device__ __forceinline__ float wave_sum(float v) {
#pragma unroll
    for (int o = 1; o < 64; o <<= 1) v += __shfl_xor(v, o);
    return v;
}
#define LDS_WAIT() asm volatile("s_waitcnt lgkmcnt(0)" ::: "memory")

struct EpiProj {
    static constexpr bool PERM = true, AFTER_DRAIN = false;
    bf16_t* O5; bf16_t* OG;
    __device__ __forceinline__ void operator()(const f32x4 (&acc)[2][2][4][2], const pg8::Unit& u, int wr, int wc, int fr, int fq) const {
        const int arr = u.pn >> 2, colt = (u.pn & 3) * 256;
        bf16_t* base = arr < 5 ? O5 + (size_t)arr * ARR : OG + (size_t)(arr - 5) * ARR;
        const int mode = (arr == 1 || arr == 4) ? 1 : (arr >= 5 ? 2 : (arr == 2 ? 3 : 0));
        const int row0 = u.pm * 256 + wr * 64 + fr, col0 = colt + wc * 32 + 8 * fq;
#pragma unroll
        for (int ai = 0; ai < 2; ++ai)
#pragma unroll
            for (int m = 0; m < 4; ++m) { bf16_t* rowp = base + (size_t)(row0 + ai * 128 + m * 16) * DM + col0;
#pragma unroll
                for (int bj = 0; bj < 2; ++bj) { f32x4 v0 = acc[ai][bj][m][0], v1 = acc[ai][bj][m][1];
                    if (mode == 1) {
#pragma unroll
                        for (int j = 0; j < 4; ++j) { v0[j] = v0[j] * sigm(v0[j]); v1[j] = v1[j] * sigm(v1[j]); } }
                    else if (mode == 2) {
#pragma unroll
                        for (int j = 0; j < 4; ++j) { v0[j] = sigm(v0[j]); v1[j] = sigm(v1[j]); } }
                    else if (mode == 3) { v0 = v0 * 0.125f; v1 = v1 * 0.125f; }
                    u32x4 w; w.x = pk2(v0[0], v0[1]); w.y = pk2(v0[2], v0[3]); w.z = pk2(v1[0], v1[1]); w.w = pk2(v1[2], v1[3]);
                    *(u32x4*)(rowp + bj * 128) = w; } }
    }
};
struct EpiPlain {
    static constexpr bool PERM = true, AFTER_DRAIN = false;
    bf16_t* O; int ldc;
    __device__ __forceinline__ void operator()(const f32x4 (&acc)[2][2][4][2], const pg8::Unit& u, int wr, int wc, int fr, int fq) const {
        const int row0 = u.pm * 256 + wr * 64 + fr, col0 = u.pn * 256 + wc * 32 + 8 * fq;
#pragma unroll
        for (int ai = 0; ai < 2; ++ai)
#pragma unroll
            for (int m = 0; m < 4; ++m) { bf16_t* rowp = O + (size_t)(row0 + ai * 128 + m * 16) * ldc + col0;
#pragma unroll
                for (int bj = 0; bj < 2; ++bj) { const f32x4 v0 = acc[ai][bj][m][0], v1 = acc[ai][bj][m][1];
                    u32x4 w; w.x = pk2(v0[0], v0[1]); w.y = pk2(v0[2], v0[3]); w.z = pk2(v1[0], v1[1]); w.w = pk2(v1[2], v1[3]);
                    *(u32x4*)(rowp + bj * 128) = w; } }
    }
};
struct EpiGate2 {
    static constexpr bool PERM = true, AFTER_DRAIN = false;
    const bf16_t* Ga; const bf16_t* Gb; bf16_t* Tb; bf16_t* O;
    __device__ __forceinline__ void operator()(const f32x4 (&acc)[2][2][4][2], const pg8::Unit& u, int wr, int wc, int fr, int fq) const {
        const int row0 = u.pm * 256 + wr * 64 + fr, col0 = u.pn * 256 + wc * 32 + 8 * fq;
        const bf16_t* G = u.w ? Gb : Ga; bf16_t* dst = u.w ? O : Tb;
#pragma unroll
        for (int ai = 0; ai < 2; ++ai) {
            bf16x8 g[4][2], t[4][2];
#pragma unroll
            for (int m = 0; m < 4; ++m)
#pragma unroll
                for (int bj = 0; bj < 2; ++bj) { const size_t off = (size_t)(row0 + ai * 128 + m * 16) * DM + col0 + bj * 128;
                    g[m][bj] = *(const bf16x8*)(G + off);
                    if (u.w) t[m][bj] = *(const bf16x8*)(Tb + off); else t[m][bj] = (bf16x8){0, 0, 0, 0, 0, 0, 0, 0}; }
            asm volatile("" ::: "memory");
#pragma unroll
            for (int m = 0; m < 4; ++m)
#pragma unroll
                for (int bj = 0; bj < 2; ++bj) { const size_t off = (size_t)(row0 + ai * 128 + m * 16) * DM + col0 + bj * 128;
                    const f32x4 v0 = acc[ai][bj][m][0], v1 = acc[ai][bj][m][1];
                    float o[8];
#pragma unroll
                    for (int j = 0; j < 4; ++j) { o[j] = fmaf(bf2f((unsigned short)g[m][bj][j]), v0[j], bf2f((unsigned short)t[m][bj][j])); o[4 + j] = fmaf(bf2f((unsigned short)g[m][bj][4 + j]), v1[j], bf2f((unsigned short)t[m][bj][4 + j])); }
                    u32x4 w; w.x = pk2(o[0], o[1]); w.y = pk2(o[2], o[3]); w.z = pk2(o[4], o[5]); w.w = pk2(o[6], o[7]);
                    *(u32x4*)(dst + off) = w; }
            asm volatile("" ::: "memory");
        }
    }
};
struct EpiOut {
    static constexpr bool PERM = false, AFTER_DRAIN = false;
    const float* gate; float* out;
    __device__ __forceinline__ void operator()(const f32x4 (&acc)[2][2][4][2], const pg8::Unit& u, int wr, int wc, int fr, int fq) const {
        const int row0 = u.pm * 256 + wr * 64 + fr, col0 = u.pn * 256 + wc * 32 + 4 * fq;
        const float* gp = gate + (size_t)(u.pm >> 4) * DM + col0;
        f32x4 gv[2][2];
#pragma unroll
        for (int bj = 0; bj < 2; ++bj)
#pragma unroll
            for (int n = 0; n < 2; ++n) gv[bj][n] = *(const f32x4*)(gp + bj * 128 + n * 16);
#pragma unroll
        for (int ai = 0; ai < 2; ++ai)
#pragma unroll
            for (int m = 0; m < 4; ++m) { const size_t off = (size_t)(row0 + ai * 128 + m * 16) * DM + col0;
#pragma unroll
                for (int bj = 0; bj < 2; ++bj)
#pragma unroll
                    for (int n = 0; n < 2; ++n) *(f32x4*)(out + off + bj * 128 + n * 16) = gv[bj][n] * acc[ai][bj][m][n]; }
    }
};

__device__ __forceinline__ void p0_transpose_item(const float* W, int K, int N, bf16_t* WT, int dst_row0, int k0, int n0, LAS float* scr, int lane) {
#pragma unroll 8
    for (int i = 0; i < 32; ++i) { const int kk = 2 * i + (lane >> 5); scr[kk * 33 + (lane & 31)] = W[(size_t)(k0 + kk) * N + n0 + (lane & 31)]; }
    LDS_WAIT(); asm volatile("" ::: "memory");
    const int c = lane & 7;
#pragma unroll
    for (int j = 0; j < 4; ++j) { const int n = (lane >> 3) + 8 * j; const LAS float* s = scr + (8 * c) * 33 + n;
        u32x4 o; o.x = pk2(s[0 * 33], s[1 * 33]); o.y = pk2(s[2 * 33], s[3 * 33]); o.z = pk2(s[4 * 33], s[5 * 33]); o.w = pk2(s[6 * 33], s[7 * 33]);
        *(u32x4*)(WT + (size_t)(dst_row0 + n) * K + k0 + 8 * c) = o; }
    LDS_WAIT(); asm volatile("" ::: "memory");
}

struct Args { const float* in[23]; float* out; unsigned char* ws; };

__device__ __forceinline__ void p0_prologue(const Args& a, LAS unsigned char* lds, int gw, int NGW, int wave, int lane) {
    LAS float* scr = (LAS float*)(lds + wave * 16384);
    unsigned char* ws = a.ws;
    const float* c = a.in[1]; const float* w_c = a.in[3]; const float* w_in = a.in[5];
    float* modp = (float*)(ws + WS_MODP);
    constexpr int I_MOD = 768, I_IN = 16 * 256, I_SQ = 16 * 32, I_G = 4 * 16 * 2;
    constexpr int NITEMS = I_MOD + I_IN + 3 * I_SQ + I_G;
    for (int it = gw; it < NITEMS; it += NGW) {
        int r = it;
        if (r < I_MOD) {
            const int cgi = r % 48, kc = r / 48, col = cgi * 64 + lane, k0 = kc * 64;
            float sv[4];
#pragma unroll
            for (int b = 0; b < 4; ++b) { const float cv = c[b * DM + k0 + lane]; sv[b] = cv * sigm(cv); }
            float acc[4] = {0.f, 0.f, 0.f, 0.f};
#pragma unroll 8
            for (int kk = 0; kk < 64; ++kk) { const float w = w_c[(size_t)(k0 + kk) * 3072 + col];
#pragma unroll
                for (int b = 0; b < 4; ++b) acc[b] += __shfl(sv[b], kk) * w; }
#pragma unroll
            for (int b = 0; b < 4; ++b) modp[(size_t)(kc * 4 + b) * 3072 + col] = acc[b];
            continue;
        }
        r -= I_MOD;
        if (r < I_IN) { const int kb = r / 256, nb = r % 256, n0 = nb * 32, cb = n0 >> 10;
            if (cb == 4) p0_transpose_item(w_in, 1024, 8192, (bf16_t*)(ws + WS_WV), n0 - 4096, kb * 64, n0, scr, lane);
            else p0_transpose_item(w_in, 1024, 8192, (bf16_t*)(ws + WS_WIN), (cb < 4 ? cb : cb - 1) * 1024 + (n0 & 1023), kb * 64, n0, scr, lane);
            continue; }
        r -= I_IN;
        if (r < 3 * I_SQ) { const int which = r / I_SQ, rr = r % I_SQ, kb = rr / 32, nb = rr % 32;
            const float* W = which == 0 ? a.in[19] : (which == 1 ? a.in[20] : a.in[21]);
            bf16_t* WT = (bf16_t*)(ws + (which == 0 ? WS_WPA : (which == 1 ? WS_WPB : WS_WO)));
            p0_transpose_item(W, 1024, 1024, WT, nb * 32, kb * 64, nb * 32, scr, lane);
            continue; }
        r -= 3 * I_SQ;
        { const int g = r / 32, rr = r % 32, hb = rr / 2, nb = rr % 2;
            const float* W = (g == 0 ? a.in[8] : (g == 1 ? a.in[10] : (g == 2 ? a.in[13] : a.in[15]))) + (size_t)hb * 4096;
            bf16_t* WT = (bf16_t*)(ws + WS_WG) + (size_t)(g * 16 + hb) * 4096;
            p0_transpose_item(W, 64, 64, WT, nb * 32, 0, nb * 32, scr, lane); }
    }
}

__device__ __forceinline__ void p1_hpass(const Args& a, LAS unsigned char* lds, int G, int tid, int wave, int lane) {
    unsigned char* ws = a.ws;
    const float* x = a.in[0]; const float* g_pre = a.in[2]; const float* b_c = a.in[4];
    const float* modp = (const float*)(ws + WS_MODP);
    bf16_t* H = (bf16_t*)(ws + WS_H);
    LAS float* sh = (LAS float*)lds;
    for (int rb = blockIdx.x; rb < MTOK / 64; rb += G) {
        const int b = rb >> 6;
        __syncthreads();
        for (int idx = tid; idx < 2048; idx += 512) { float s = b_c[idx];
#pragma unroll
            for (int kc = 0; kc < 16; ++kc) s += modp[(size_t)(kc * 4 + b) * 3072 + idx];
            sh[idx] = idx < 1024 ? s : 1.f + s; }
        __syncthreads();
        for (int rr = wave; rr < 64; rr += 8) { const int row = rb * 64 + rr;
            const f32x4* xr = (const f32x4*)(x + (size_t)row * DM) + lane;
            f32x4 v[4]; float s = 0.f;
#pragma unroll
            for (int j = 0; j < 4; ++j) { v[j] = xr[64 * j]; s += (v[j][0] * v[j][0] + v[j][1] * v[j][1]) + (v[j][2] * v[j][2] + v[j][3] * v[j][3]); }
            const float rstd = __builtin_amdgcn_rsqf(wave_sum(s) * (1.f / 1024.f) + 1e-6f);
#pragma unroll
            for (int j = 0; j < 4; ++j) { const int col = 4 * lane + 256 * j;
                const f32x4 g = *(const f32x4*)(g_pre + col); const f32x4 sc = *(const LAS f32x4*)(sh + 1024 + col); const f32x4 sf = *(const LAS f32x4*)(sh + col);
                const f32x4 o = (v[j] * rstd) * g * sc + sf;
                u32x2 w; w.x = pk2(o[0], o[1]); w.y = pk2(o[2], o[3]);
                *(u32x2*)(H + (size_t)row * DM + col) = w; }
        }
    }
    float* gate = (float*)(ws + WS_GATE);
    for (int idx = blockIdx.x * 512 + tid; idx < 4096; idx += G * 512) { const int b = idx >> 10, col = idx & 1023; float s = b_c[2048 + col];
#pragma unroll
        for (int kc = 0; kc < 16; ++kc) s += modp[(size_t)(kc * 4 + b) * 3072 + 2048 + col];
        gate[idx] = s; }
}

__device__ __forceinline__ void attn_phase(const bf16_t* Q, const bf16_t* Kb, const bf16_t* VT, const bf16_t* ZB, const float* rpb, bf16_t* YB, int vcu, int G, int wave, int lane) {
    const int fr = lane & 15, fq = lane >> 4;
    constexpr int NQ = 4 * 64 * 16 * 4;
    constexpr float L2E = 1.44269504089f;
    for (int qi = vcu * 8 + wave; qi < NQ; qi += G * 8) {
        const int j = qi & 3, item = qi >> 2, r = item & 63, hb = item >> 6, h = hb & 15, b = hb >> 4;
        const int r0 = min(max(r - 4, 0), 56);
        const int cs = min(max(16 * j - 8, 0), 32);
        const int qc = 16 * j + fr, c0 = min(max(qc - 8, 0), 48);
        const size_t tokq = (size_t)b * SEQ + r * 64 + qc;
        bf16x8 qf[2];
#pragma unroll
        for (int ks = 0; ks < 2; ++ks) qf[ks] = *(const bf16x8*)(Q + tokq * DM + h * 64 + ks * 32 + fq * 8);
        f32x4 s[8][2];
#pragma unroll
        for (int w = 0; w < 8; ++w) { const size_t tokrow = (size_t)b * SEQ + (size_t)(r0 + w) * 64;
#pragma unroll
            for (int t = 0; t < 2; ++t) { const int kc = cs + 8 * (fr >> 2) + (fr & 3) + 4 * t;
                f32x4 acc = {0.f, 0.f, 0.f, 0.f};
#pragma unroll
                for (int ks = 0; ks < 2; ++ks) { const bf16x8 kf = *(const bf16x8*)(Kb + (tokrow + kc) * DM + h * 64 + ks * 32 + fq * 8);
                    acc = __builtin_amdgcn_mfma_f32_16x16x32_bf16(kf, qf[ks], acc, 0, 0, 0); }
                s[w][t] = acc; } }
        float mx = -1e30f;
#pragma unroll
        for (int w = 0; w < 8; ++w) { const float* rp = rpb + (size_t)(h * 15 + (r0 + w - r + 7)) * 31;
#pragma unroll
            for (int t = 0; t < 2; ++t)
#pragma unroll
                for (int i = 0; i < 4; ++i) { const int kcol = cs + 8 * fq + 4 * t + i; const bool ok = (kcol >= c0) && (kcol < c0 + 16);
                    const int dcol = min(max(kcol - qc + 15, 0), 30);
                    const float v = ok ? (s[w][t][i] + rp[dcol]) * L2E : -1e30f; s[w][t][i] = v; mx = fmaxf(mx, v); } }
        mx = fmaxf(mx, __shfl_xor(mx, 16)); mx = fmaxf(mx, __shfl_xor(mx, 32));
        float sum = 0.f; bf16x8 pf[8];
#pragma unroll
        for (int w = 0; w < 8; ++w) { float p[8];
#pragma unroll
            for (int t = 0; t < 2; ++t)
#pragma unroll
                for (int i = 0; i < 4; ++i) { const float e = __builtin_amdgcn_exp2f(s[w][t][i] - mx); p[4 * t + i] = e; sum += e; }
            u32x4 pw; pw.x = pk2(p[0], p[1]); pw.y = pk2(p[2], p[3]); pw.z = pk2(p[4], p[5]); pw.w = pk2(p[6], p[7]);
            pf[w] = __builtin_bit_cast(bf16x8, pw); }
        sum += __shfl_xor(sum, 16); sum += __shfl_xor(sum, 32);
        const float inv = 1.f / sum;
        f32x4 o[4];
#pragma unroll
        for (int dt = 0; dt < 4; ++dt) o[dt] = (f32x4){0.f, 0.f, 0.f, 0.f};
#pragma unroll
        for (int w = 0; w < 8; ++w) { const size_t tokrow = (size_t)b * SEQ + (size_t)(r0 + w) * 64;
#pragma unroll
            for (int dt = 0; dt < 4; ++dt) { const bf16x8 vf = *(const bf16x8*)(VT + (size_t)(h * 64 + dt * 16 + fr) * MTOK + tokrow + cs + 8 * fq);
                o[dt] = __builtin_amdgcn_mfma_f32_16x16x32_bf16(vf, pf[w], o[dt], 0, 0, 0); } }
#pragma unroll
        for (int dt = 0; dt < 4; ++dt) { const size_t off = tokq * DM + h * 64 + dt * 16 + 4 * fq;
            const bf16x4 z = *(const bf16x4*)(ZB + off);
            u32x2 w; w.x = pk2(o[dt][0] * inv * bf2f((unsigned short)z[0]), o[dt][1] * inv * bf2f((unsigned short)z[1]));
            w.y = pk2(o[dt][2] * inv * bf2f((unsigned short)z[2]), o[dt][3] * inv * bf2f((unsigned short)z[3]));
            *(u32x2*)(YB + off) = w; }
    }
}

template <bool FINAL, int DIR>
__device__ __forceinline__ void scan_dir(const LAS bf16x8* afrL, int lane, int ct, const bf16_t* WGr, const bf16_t* WGi, float br, float bi, float cl, float Hin,
                                         const bf16x8 (&idf)[2], float& Aout, float& Uout, const bf16_t* ZAp, bf16_t* YAp) {
    const int n = lane & 31, hf = lane >> 5;
    bf16x8 Br[4], Bi[4];
#pragma unroll
    for (int kk = 0; kk < 4; ++kk) { Br[kk] = *(const bf16x8*)(WGr + (size_t)(32 * ct + n) * 64 + 16 * kk + 8 * hf); Bi[kk] = *(const bf16x8*)(WGi + (size_t)(32 * ct + n) * 64 + 16 * kk + 8 * hf); }
    float H = Hin, Ap = 1.f;
#pragma unroll 1
    for (int si = 0; si < 4; ++si) { const int s = DIR ? 3 - si : si;
        f32x16 ar, ai, ax;
#pragma unroll
        for (int e = 0; e < 16; ++e) { ar[e] = 0.f; ai[e] = 0.f; ax[e] = 0.f; }
#pragma unroll
        for (int kk = 0; kk < 4; ++kk) { const bf16x8 av = afrL[(s * 4 + kk) * 64 + lane];
            ar = __builtin_amdgcn_mfma_f32_32x32x16_bf16(av, Br[kk], ar, 0, 0, 0); ai = __builtin_amdgcn_mfma_f32_32x32x16_bf16(av, Bi[kk], ai, 0, 0, 0); }
        { const bf16x8 a0 = afrL[(s * 4 + 2 * ct) * 64 + lane], a1 = afrL[(s * 4 + 2 * ct + 1) * 64 + lane];
            ax = __builtin_amdgcn_mfma_f32_32x32x16_bf16(a0, idf[0], ax, 0, 0, 0); ax = __builtin_amdgcn_mfma_f32_32x32x16_bf16(a1, idf[1], ax, 0, 0, 0); }
        const bf16_t* zs = ZAp + (size_t)(16 * s) * DM; bf16_t* ys = YAp + (size_t)(16 * s) * DM;
#pragma unroll
        for (int ei = 0; ei < 16; ++ei) { const int e = DIR ? 15 - ei : ei;
            const float r = sigm(ar[e] + br), ig = sigm(ai[e] + bi);
            const float av = __builtin_amdgcn_exp2f(cl * r);
            const float om = fmaxf(fmaf(-av, av, 1.f), 0.f);
            const float u = __builtin_amdgcn_sqrtf(om) * (ig * ax[e]);
            H = fmaf(av, H, u);
            if (FINAL) {
                if (DIR == 0) ys[(size_t)e * DM] = (bf16_t)(pk2(H, 0.f) & 0xffffu);
                else ys[(size_t)e * DM] = (bf16_t)(pk2((H + bf2f(ys[(size_t)e * DM])) * bf2f(zs[(size_t)e * DM]), 0.f) & 0xffffu); }
            else Ap *= av; }
    }
    Aout = Ap; Uout = H;
}

template <bool FINAL>
__device__ __forceinline__ void scan_phase(const Args& a, LAS unsigned char* lds, int gw, int NGW, int wave, int lane) {
    unsigned char* ws = a.ws;
    const bf16_t* XA = (const bf16_t*)(ws + WS_XA); const bf16_t* ZA = (const bf16_t*)(ws + WS_ZA);
    const bf16_t* WG = (const bf16_t*)(ws + WS_WG);
    const float* conv_w = a.in[6]; const float* conv_b = a.in[7];
    typedef float f32x2 __attribute__((ext_vector_type(2)));
    f32x2* AGG = (f32x2*)(ws + WS_AGG);
    bf16_t* YA = (bf16_t*)(ws + WS_H);
    LAS bf16x8* afrL = (LAS bf16x8*)(lds + wave * 16384);
    const int n = lane & 31, hf = lane >> 5;
    bf16x8 idf[2];
#pragma unroll
    for (int k2 = 0; k2 < 2; ++k2)
#pragma unroll
        for (int jj = 0; jj < 8; ++jj) idf[k2][jj] = (16 * k2 + 8 * hf + jj == n) ? (short)0x3F80 : (short)0;
    for (int wt = gw; wt < 2048; wt += NGW) {
        const int cp = wt & 31, jb = (wt >> 5) & 15, b = wt >> 9, ch0 = jb * 64;
        { const int a_half = (n >> 2) & 1, a_idx = (n & 3) + 4 * (n >> 3), a_chunk = 2 * cp + a_half;
#pragma unroll 1
          for (int kk = 0; kk < 4; ++kk) { const int ch = ch0 + 16 * kk + 8 * hf;
              float cw[4][8], cb[8];
#pragma unroll
              for (int w = 0; w < 4; ++w) { const f32x4 c0 = *(const f32x4*)(conv_w + w * DM + ch), c1 = *(const f32x4*)(conv_w + w * DM + ch + 4);
#pragma unroll
                  for (int jj = 0; jj < 4; ++jj) { cw[w][jj] = c0[jj]; cw[w][4 + jj] = c1[jj]; } }
              { const f32x4 c0 = *(const f32x4*)(conv_b + ch), c1 = *(const f32x4*)(conv_b + ch + 4);
#pragma unroll
                  for (int jj = 0; jj < 4; ++jj) { cb[jj] = c0[jj]; cb[4 + jj] = c1[jj]; } }
#pragma unroll
              for (int s = 0; s < 4; ++s) { const int p = a_chunk * 64 + 16 * s + a_idx;
                  float acc[8];
#pragma unroll
                  for (int jj = 0; jj < 8; ++jj) acc[jj] = cb[jj];
#pragma unroll
                  for (int w = 0; w < 4; ++w) { const int pp = p + w - 2; const bool ok = (pp >= 0) && (pp < SEQ); const int pc = min(max(pp, 0), SEQ - 1);
                      const bf16x8 xv = *(const bf16x8*)(XA + ((size_t)b * SEQ + pc) * DM + ch);
#pragma unroll
                      for (int jj = 0; jj < 8; ++jj) acc[jj] = fmaf(cw[w][jj], ok ? bf2f((unsigned short)xv[jj]) : 0.f, acc[jj]); }
                  u32x4 pw; pw.x = pk2(acc[0], acc[1]); pw.y = pk2(acc[2], acc[3]); pw.z = pk2(acc[4], acc[5]); pw.w = pk2(acc[6], acc[7]);
                  afrL[(s * 4 + kk) * 64 + lane] = __builtin_bit_cast(bf16x8, pw); } } }
        LDS_WAIT(); asm volatile("" ::: "memory");
        const int chunk = 2 * cp + hf;
        if (FINAL) {
            const int tid = threadIdx.x, pdir = tid >> 8, pseg = (tid >> 6) & 3, pch = tid & 63, q = cp >> 3;
            LAS f32x2* segL = (LAS f32x2*)(lds + LDS_SEG);
            LAS float* cinL = (LAS float*)(lds + LDS_CIN);
            f32x2 g[16];
#pragma unroll
            for (int i = 0; i < 16; ++i) g[i] = AGG[((size_t)(b * 2 + pdir) * 64 + 16 * pseg + i) * DM + ch0 + pch];
            float As = 1.f, Us = 0.f;
#pragma unroll
            for (int ii = 0; ii < 16; ++ii) { const int i = pdir ? 15 - ii : ii; Us = fmaf(g[i][0], Us, g[i][1]); As *= g[i][0]; }
            __syncthreads();
            segL[(pdir * 4 + pseg) * 64 + pch] = (f32x2){As, Us};
            __syncthreads();
            if (pseg == q) { float Hc = 0.f;
                if (pdir == 0) { for (int s2 = 0; s2 < pseg; ++s2) { const f32x2 sg = segL[(0 * 4 + s2) * 64 + pch]; Hc = fmaf(sg[0], Hc, sg[1]); } }
                else { for (int s2 = 3; s2 > pseg; --s2) { const f32x2 sg = segL[(1 * 4 + s2) * 64 + pch]; Hc = fmaf(sg[0], Hc, sg[1]); } }
#pragma unroll
                for (int ii = 0; ii < 16; ++ii) { const int i = pdir ? 15 - ii : ii; cinL[(pdir * 16 + i) * 64 + pch] = Hc; Hc = fmaf(g[i][0], Hc, g[i][1]); } }
            __syncthreads();
        }
#pragma unroll 1
        for (int ct = 0; ct < 2; ++ct) { const int ch = ch0 + 32 * ct + n;
            float Af, Uf, Ab, Ub;
            {
                const float br = a.in[9][ch], bi = a.in[11][ch]; const float lam = a.in[12][ch];
                const float cl = -8.f * 1.44269504089f * log1pf(expf(-lam));
                float Hin = 0.f;
                if (FINAL) Hin = ((const LAS float*)(lds + LDS_CIN))[(0 * 16 + (chunk & 15)) * 64 + 32 * ct + n];
                scan_dir<FINAL, 0>(afrL, lane, ct, WG + (size_t)(0 * 16 + jb) * 4096, WG + (size_t)(1 * 16 + jb) * 4096, br, bi, cl, Hin, idf, Af, Uf, ZA + ((size_t)b * SEQ + chunk * 64) * DM + ch, YA + ((size_t)b * SEQ + chunk * 64) * DM + ch);
            }
            {
                const float br = a.in[14][ch], bi = a.in[16][ch]; const float lam = a.in[17][ch];
                const float cl = -8.f * 1.44269504089f * log1pf(expf(-lam));
                float Hin = 0.f;
                if (FINAL) Hin = ((const LAS float*)(lds + LDS_CIN))[(1 * 16 + (chunk & 15)) * 64 + 32 * ct + n];
                scan_dir<FINAL, 1>(afrL, lane, ct, WG + (size_t)(2 * 16 + jb) * 4096, WG + (size_t)(3 * 16 + jb) * 4096, br, bi, cl, Hin, idf, Ab, Ub, ZA + ((size_t)b * SEQ + chunk * 64) * DM + ch, YA + ((size_t)b * SEQ + chunk * 64) * DM + ch);
            }
            if (!FINAL) {
                AGG[((size_t)(b * 2 + 0) * 64 + chunk) * DM + ch] = (f32x2){Af, Uf};
                AGG[((size_t)(b * 2 + 1) * 64 + chunk) * DM + ch] = (f32x2){Ab, Ub};
            }
        }
        LDS_WAIT(); asm volatile("" ::: "memory");
    }
}

__device__ __forceinline__ void final_norm(const Args& a, int gw, int NGW, int lane) {
    const float* x = a.in[0]; const float* g_final = a.in[22]; float* out = a.out;
    f32x4 g[4];
#pragma unroll
    for (int j = 0; j < 4; ++j) g[j] = *((const f32x4*)g_final + lane + 64 * j);
    for (int row = gw; row < MTOK; row += NGW) {
        f32x4* orow = (f32x4*)(out + (size_t)row * DM) + lane; const f32x4* xrow = (const f32x4*)(x + (size_t)row * DM) + lane;
        f32x4 v[4]; float ss = 0.f;
#pragma unroll
        for (int j = 0; j < 4; ++j) { v[j] = orow[64 * j] + xrow[64 * j]; ss += (v[j][0] * v[j][0] + v[j][1] * v[j][1]) + (v[j][2] * v[j][2] + v[j][3] * v[j][3]); }
        const float rstd = __builtin_amdgcn_rsqf(wave_sum(ss) * (1.f / 1024.f) + 1e-6f);
#pragma unroll
        for (int j = 0; j < 4; ++j) orow[64 * j] = v[j] * rstd * g[j];
    }
}

#define XB_TMO      128
#define XB_XCNT(j)  (256  + 64 * (j))
#define XB_XSUB(j)  (1280 + 64 * (j))
#define XB_XGEN(j)  (2304 + 64 * (j))
#define XB_TOP      3328
#define XB_TOPGEN   3392
#define XCD_BAR_WORDS 3456
#define XB_SPIN_CAP (1u << 18)
__device__ __forceinline__ unsigned xb_ld(unsigned* p)              { return __hip_atomic_load(p, __ATOMIC_RELAXED, __HIP_MEMORY_SCOPE_AGENT); }
__device__ __forceinline__ unsigned xb_add(unsigned* p, unsigned v) { return __hip_atomic_fetch_add(p, v, __ATOMIC_RELAXED, __HIP_MEMORY_SCOPE_AGENT); }
__device__ __forceinline__ unsigned xb_xcc_id() { return (unsigned)__builtin_amdgcn_s_getreg((3 << 11) | 20) & 0xFu; }
#define XB_SPIN(cond, bar) do { unsigned _sp = 0; while (cond) { __builtin_amdgcn_s_sleep(1); \
    if ((++_sp & 255u) == 0u) { if (xb_ld(&(bar)[XB_TMO])) break; if (_sp > XB_SPIN_CAP) { atomicAdd(&(bar)[XB_TMO], 1u); break; } } } } while (0)
struct XcdBarrier { unsigned* bar; unsigned x; volatile LAS unsigned* st; };
__device__ __forceinline__ XcdBarrier xcd_barrier_post(unsigned* bar, volatile LAS unsigned* st) {
    XcdBarrier b; b.bar = bar; b.x = xb_xcc_id(); b.st = st;
    if (threadIdx.x == 0) (void)xb_add(&bar[XB_XCNT(b.x)], 1u);
    return b;
}
__device__ __forceinline__ void xcd_barrier_complete(unsigned* bar, unsigned x, unsigned& nloc, unsigned& nx) {
    const unsigned G = gridDim.x * gridDim.y * gridDim.z;
    unsigned sum, cnt, mine, sp = 0u;
    for (;;) {
        sum = 0u; cnt = 0u; mine = 0u;
#pragma unroll
        for (unsigned j = 0; j < 16; ++j) { const unsigned c = xb_ld(&bar[XB_XCNT(j)]); sum += c; cnt += (c > 0u) ? 1u : 0u; mine = (j == x) ? c : mine; }
        if (sum == G) break;
        __builtin_amdgcn_s_sleep(1);
        if ((++sp & 255u) == 0u) { if (xb_ld(&bar[XB_TMO])) break; if (sp > XB_SPIN_CAP) { atomicAdd(&bar[XB_TMO], 1u); break; } }
    }
    nloc = mine > 0u ? mine : 1u; nx = cnt > 0u ? cnt : 1u;
}
__device__ __forceinline__ void xcd_barrier(const XcdBarrier& b) {
    asm volatile("s_waitcnt vmcnt(0)" ::: "memory");
    __syncthreads();
    if (threadIdx.x == 0) {
        unsigned* bar = b.bar;
        __builtin_amdgcn_s_waitcnt(0);
        unsigned nloc = b.st[0], nx = b.st[1];
        if (nloc == 0u) { xcd_barrier_complete(bar, b.x, nloc, nx); b.st[0] = nloc; b.st[1] = nx; }
        const unsigned old = xb_add(&bar[XB_XSUB(b.x)], 1u);
        const unsigned gen = old / nloc;
        if (old + 1u == (gen + 1u) * nloc) {
            __builtin_amdgcn_fence(__ATOMIC_RELEASE, "agent");
            asm volatile("s_waitcnt vmcnt(0)" ::: "memory");
            const unsigned og = xb_add(&bar[XB_TOP], 1u);
            const unsigned tg = og / nx;
            if (og + 1u == (tg + 1u) * nx) xb_add(&bar[XB_TOPGEN], 1u);
            else XB_SPIN(xb_ld(&bar[XB_TOPGEN]) == tg, bar);
            __builtin_amdgcn_fence(__ATOMIC_ACQUIRE, "agent");
            xb_add(&bar[XB_XGEN(b.x)], 1u);
            asm volatile("s_waitcnt vmcnt(0)" ::: "memory");
        } else {
            XB_SPIN(xb_ld(&bar[XB_XGEN(b.x)]) == gen, bar);
            __builtin_amdgcn_fence(__ATOMIC_ACQUIRE, "agent");
            asm volatile("s_waitcnt vmcnt(0)" ::: "memory");
        }
    }
    __syncthreads();
}

__global__ void __launch_bounds__(512, 2) fwd_kernel(Args a) {
    extern __shared__ __attribute__((aligned(16))) unsigned char lds_raw[];
    LAS unsigned char* lds = (LAS unsigned char*)lds_raw;
    cg::grid_group grid = cg::this_grid();
    const int tid = threadIdx.x, lane = tid & 63, wave = __builtin_amdgcn_readfirstlane(tid >> 6);
    const int G = gridDim.x, bx = blockIdx.x;
    const int vcu = (G % 8 == 0) ? (bx % 8) * (G / 8) + bx / 8 : bx;
    const int gw = bx * 8 + wave, NGW = G * 8;
    unsigned char* ws = a.ws;
#ifdef PROBE_A0
    unsigned long long tA0 = 0, tA1 = 0, tB0 = 0, tB1 = 0;
#define STAMP(k) do { const unsigned long long _t = __builtin_amdgcn_s_memrealtime(); if ((k) == PROBE_A0) tA0 = _t; if ((k) == PROBE_A1) tA1 = _t; if ((k) == PROBE_B0) tB0 = _t; if ((k) == PROBE_B1) tB1 = _t; } while (0)
#else
#define STAMP(k) do {} while (0)
#endif
    STAMP(0);
    unsigned* barw = (unsigned*)(ws + WS_BAR);
    if (tid < 4) ((volatile LAS unsigned*)(lds + LDS_MISC))[tid] = 0u;
    __syncthreads();
    XcdBarrier xb = xcd_barrier_post(barw, (volatile LAS unsigned*)(lds + LDS_MISC));
    if (a.ws == nullptr) grid.sync();

#define PH(k) (!defined(ONLY) || ONLY == (k))
#if !defined(ONLY) || ONLY == 0
    p0_prologue(a, lds, gw, NGW, wave, lane);
#endif
    STAMP(1);
    xcd_barrier(xb);
    STAMP(2);
#if !defined(ONLY) || ONLY == 1
    p1_hpass(a, lds, G, tid, wave, lane);
#endif
    STAMP(3);
    xcd_barrier(xb);
    STAMP(4);
#if !defined(ONLY) || ONLY == 2
    {
        pg8::Gemm g{(const bf16_t*)(ws + WS_H), (const bf16_t*)(ws + WS_WIN), MTOK, 7168, 1024}; pg8::StaticOrder S; S.init(MTOK, 7168, G, bx);
        EpiProj E{(bf16_t*)(ws + WS_XA), (bf16_t*)a.out};
        pg8::gemm_phase<EpiProj, pg8::StaticOrder, PG8_ALIGN, PG8_SP2>(lds, g, S, E);
    }
    STAMP(5);
    {
        pg8::Gemm g{(const bf16_t*)(ws + WS_WV), (const bf16_t*)(ws + WS_H), 1024, MTOK, 1024}; pg8::StaticOrder S; S.init(1024, MTOK, G, bx);
        EpiPlain E{(bf16_t*)(ws + WS_VT), MTOK};
        pg8::gemm_phase<EpiPlain, pg8::StaticOrder, PG8_ALIGN, PG8_SP2>(lds, g, S, E);
    }
    STAMP(6);
#endif
    xcd_barrier(xb);
    STAMP(7);
#if !defined(ONLY) || ONLY == 3
    attn_phase((const bf16_t*)(ws + WS_Q), (const bf16_t*)(ws + WS_K), (const bf16_t*)(ws + WS_VT), (const bf16_t*)(ws + WS_ZB), a.in[18], (bf16_t*)(ws + WS_Q), vcu, G, wave, lane);
#endif
    STAMP(8);
#if !defined(ONLY) || ONLY == 4
    scan_phase<false>(a, lds, gw, NGW, wave, lane);
#endif
    STAMP(9);
    xcd_barrier(xb);
    STAMP(10);
#if !defined(ONLY) || ONLY == 5
    scan_phase<true>(a, lds, gw, NGW, wave, lane);
#endif
    STAMP(11);
    xcd_barrier(xb);
    STAMP(12);
#if !defined(ONLY) || ONLY == 6
    {
        pg8::Gemm g{(const bf16_t*)(ws + WS_H), (const bf16_t*)(ws + WS_WPA), MTOK, 1024, 1024, (const bf16_t*)(ws + WS_Q), (const bf16_t*)(ws + WS_WPB)}; pg8::PairOrder S; S.init(MTOK, 1024, G, bx);
        EpiGate2 E{(const bf16_t*)a.out, (const bf16_t*)a.out + ARR, (bf16_t*)(ws + WS_K), (bf16_t*)(ws + WS_XA)};
        pg8::gemm_phase<EpiGate2, pg8::PairOrder, PG8_ALIGN, PG8_SP2>(lds, g, S, E);
    }
    STAMP(14);
#endif
    xcd_barrier(xb);
    STAMP(15);
#if !defined(ONLY) || ONLY == 7
    {
        pg8::Gemm g{(const bf16_t*)(ws + WS_XA), (const bf16_t*)(ws + WS_WO), MTOK, 1024, 1024}; pg8::StaticOrder S; S.init(MTOK, 1024, G, bx);
        EpiOut E{(const float*)(ws + WS_GATE), a.out};
        pg8::gemm_phase<EpiOut, pg8::StaticOrder, PG8_ALIGN, PG8_SP2>(lds, g, S, E);
    }
    STAMP(16);
#endif
    xcd_barrier(xb);
    STAMP(17);
#if !defined(ONLY) || ONLY == 8
    final_norm(a, gw, NGW, lane);
#endif
#ifdef PROBE_A0
    STAMP(18);
    if (bx == 0) {
        const float dA = (float)(tA1 - tA0) * 0.01f, dB = (float)(tB1 - tB0) * 0.01f;
        __syncthreads();
        float* orow = a.out + (size_t)wave * DM;
        for (int i = lane; i < DM; i += 64) orow[i] += dB;
        __syncthreads();
        if (tid == 0) a.out[0] += dA;
    }
#endif
}

extern "C" void kernel_launch(void* const* d_in, const int* in_sizes, int n_in, void* d_out, int out_size, void* d_ws, size_t ws_size, hipStream_t stream) {
    static int grid = 0;
    if (grid == 0) {
        if (n_in != 23 || out_size != MTOK * DM || ws_size < 256 * MiB) { fprintf(stderr, "kernel_launch: unexpected problem shape (n_in %d, out %d, ws %zu)\n", n_in, out_size, ws_size); grid = -1; return; }
        int dev = 0, cus = 0, per_cu = 0;
        (void)hipGetDevice(&dev);
        (void)hipDeviceGetAttribute(&cus, hipDeviceAttributeMultiprocessorCount, dev);
        if (hipFuncSetAttribute((const void*)fwd_kernel, hipFuncAttributeMaxDynamicSharedMemorySize, LDS_BYTES) != hipSuccess) { fprintf(stderr, "kernel_launch: hipFuncSetAttribute failed\n"); grid = -1; return; }
        if (hipOccupancyMaxActiveBlocksPerMultiprocessor(&per_cu, (const void*)fwd_kernel, 512, LDS_BYTES) != hipSuccess || per_cu < 1) { fprintf(stderr, "kernel_launch: occupancy query failed (%d)\n", per_cu); per_cu = 1; (void)hipGetLastError(); }
        grid = cus * per_cu;
        if (grid <= 0) { grid = -1; return; }
    }
    if (grid < 0) return;
    Args a{};
    for (int i = 0; i < 23; ++i) a.in[i] = (const float*)d_in[i];
    a.out = (float*)d_out; a.ws = (unsigned char*)d_ws;
    void* args[] = {&a};
    if (hipMemsetAsync((unsigned char*)d_ws + WS_BAR, 0, XCD_BAR_WORDS * 4, stream) != hipSuccess) { fprintf(stderr, "kernel_launch: memset of the barrier words failed\n"); return; }
    hipError_t e = hipLaunchCooperativeKernel((const void*)fwd_kernel, dim3(grid), dim3(512), args, LDS_BYTES, stream);
    if (e != hipSuccess) fprintf(stderr, "kernel_launch: cooperative launch failed: %s (grid %d)\n", hipGetErrorString(e), grid);
}
```

```cpp
#include <hip/hip_runtime.h>
#include <hip/hip_cooperative_groups.h>
#include <cstdio>
#include <cstdint>
namespace cg = cooperative_groups;
namespace pg8 {
#define PG8_LAS __attribute__((address_space(3)))
typedef unsigned short bf16_t;
typedef short bf16x8 __attribute__((ext_vector_type(8)));
typedef float f32x4 __attribute__((ext_vector_type(4)));
typedef unsigned u32x4 __attribute__((ext_vector_type(4)));
constexpr int BM = 256, BK = 64, HALF = 128, HTB = HALF * BK * 2  , STAGE_BYTES = 8 * HTB, NXCD = 8, WGM = 8;

__host__ __device__ __forceinline__ int lds_byte(int r, int c) { const int st = (r >> 4) * 2 + (c >> 5), rr = r & 15, cc = c & 31, ob = rr * 64 + cc * 2; return st * 1024 + (ob ^ (((ob >> 9) & 1) << 5)); }
__host__ __device__ __forceinline__ void stage_rc(int b, int& R, int& C) { const int st = b / 1024, sb = b % 1024, swz = sb ^ (((sb >> 9) & 1) << 5); R = (st >> 1) * 16 + swz / 64; C = (st & 1) * 32 + (swz % 64) / 2; }
__host__ __device__ __forceinline__ int perm32(int rho) { const int n = rho >> 4, i = rho & 15; return 8 * (i >> 2) + 4 * n + (i & 3); }

struct Unit { int pm, pn, w; };
struct Gemm { const bf16_t* A; const bf16_t* Bt; int M, N, K; const bf16_t* A2; const bf16_t* Bt2; };

struct StaticOrder {
    int nM, nN, nwg, G, c;
    __host__ __device__ void init(int M, int N, int G_, int c_) { nM = M / BM; nN = N / BM; nwg = nM * nN; G = G_; c = c_; }
    __host__ __device__ bool next(int i, Unit& u) const {
        const long L = (long)i * G + c; if (L >= nwg) return false;
        int wgid = (int)L; { const int q = nwg / NXCD, r = nwg % NXCD, xcd = wgid % NXCD, off = wgid / NXCD; wgid = (xcd < r ? xcd * (q + 1) : r * (q + 1) + (xcd - r) * q) + off; }
        const int nig = WGM * nN, gid = wgid / nig, fm = gid * WGM, gsz = (nM - fm) < WGM ? (nM - fm) : WGM;
        u.pm = fm + ((wgid % nig) % gsz); u.pn = (wgid % nig) / gsz; u.w = 0; return true;
    }
    __device__ __forceinline__ void a_ready(const Unit&) const {}
    __device__ __forceinline__ void done(const Unit&) const {}
};
struct PairOrder : StaticOrder {
    __host__ __device__ bool next(int i, Unit& u) const { if (!StaticOrder::next(i >> 1, u)) return false; u.w = i & 1; return true; }
};
__device__ __forceinline__ unsigned cvt_pk_bf16(float lo, float hi) { unsigned r; asm volatile("v_cvt_pk_bf16_f32 %0, %1, %2" : "=v"(r) : "v"(lo), "v"(hi)); return r; }
typedef float f32x2 __attribute__((ext_vector_type(2)));
template <class Epi, class Sched, bool ALIGN_EPI = false, bool SP2 = false>
__device__ __forceinline__ void gemm_phase(PG8_LAS unsigned char* lds, const Gemm g, const Sched& S, const Epi& E) {
    const int tid = threadIdx.x, wid = __builtin_amdgcn_readfirstlane(tid >> 6), lane = tid & 63, wr = wid >> 2, wc = wid & 3, fr = lane & 15, fq = lane >> 4;
    const int K = g.K, nt = K / BK;
    unsigned voffA[2], voffB[2];
#pragma unroll
    for (int i = 0; i < 2; ++i) { int R, C; stage_rc(tid * 16 + i * 8192, R, C); const int Rb = Epi::PERM ? ((R & ~31) + perm32(R & 31)) : R;
        voffA[i] = (unsigned)(R * K + C) * 2u; voffB[i] = (unsigned)(Rb * K + C) * 2u; }
    const size_t kstep = (size_t)(BK * 2);
    const size_t hstep = (size_t)HALF * K * 2;
    const size_t tstep = 2 * hstep;
    const unsigned ldsw = (unsigned)wid * 1024u;
    const int aoff = lds_byte(wr * 64 + fr, fq * 8), boff = lds_byte(wc * 32 + fr, fq * 8);
#define PG8_SA(b, h) (((b) * 2 + (h)) * HTB)
#define PG8_SB(b, h) ((4 + (b) * 2 + (h)) * HTB)
#define PG8_STAGE(bufoff, gbase, voff) do { _Pragma("unroll") for (int _i = 0; _i < 2; ++_i) \
        __builtin_amdgcn_global_load_lds((const unsigned*)((const char*)(gbase) + (voff)[_i]), (PG8_LAS unsigned*)(lds + (bufoff) + ldsw + _i * 8192), 16, 0, 0); } while (0)
#define PG8_LDA(dst, b, h) do { _Pragma("unroll") for (int m = 0; m < 4; ++m) _Pragma("unroll") for (int k = 0; k < 2; ++k) dst[m][k] = *(const PG8_LAS bf16x8*)(lds + PG8_SA(b, h) + aoff + m * 2048 + k * 1024); } while (0)
#define PG8_LDB(dst, b, h) do { _Pragma("unroll") for (int n = 0; n < 2; ++n) _Pragma("unroll") for (int k = 0; k < 2; ++k) dst[n][k] = *(const PG8_LAS bf16x8*)(lds + PG8_SB(b, h) + boff + n * 2048 + k * 1024); } while (0)
#define PG8_MMA(ai, bj, At, Bt) do { __builtin_amdgcn_s_setprio(1); _Pragma("unroll") for (int m = 0; m < 4; ++m) _Pragma("unroll") for (int n = 0; n < 2; ++n) _Pragma("unroll") for (int k = 0; k < 2; ++k) \
        acc[ai][bj][m][n] = __builtin_amdgcn_mfma_f32_16x16x32_bf16(Bt[n][k], At[m][k], acc[ai][bj][m][n], 0, 0, 0); __builtin_amdgcn_s_setprio(0); } while (0)
#define PG8_WAIT_V(n) asm volatile("s_waitcnt vmcnt(" #n ")" ::: "memory")
#define PG8_WAIT_L(n) asm volatile("s_waitcnt lgkmcnt(" #n ")" ::: "memory")
#define PG8_BAR __builtin_amdgcn_s_barrier()
#define PG8_SCHED __builtin_amdgcn_sched_barrier(0)
    Unit cur, nxt; int ui = 0;
    if (!S.next(0, cur)) return;
    f32x4 acc[2][2][4][2];
#pragma unroll
    for (int a = 0; a < 2; ++a)
#pragma unroll
        for (int b = 0; b < 2; ++b)
#pragma unroll
            for (int m = 0; m < 4; ++m)
#pragma unroll
                for (int n = 0; n < 2; ++n) acc[a][b][m][n] = (f32x4){0.f, 0.f, 0.f, 0.f};
    bf16x8 At[4][2], B0[2][2], B1[2][2];
    const char* cA = (const char*)(cur.w ? g.A2 : g.A) + (size_t)cur.pm * tstep; const char* cB = (const char*)(cur.w ? g.Bt2 : g.Bt) + (size_t)cur.pn * tstep;
    S.a_ready(cur);
    if constexpr (SP2) {
        PG8_STAGE(PG8_SB(0, 0), cB, voffB); PG8_STAGE(PG8_SB(0, 1), cB + hstep, voffB); PG8_STAGE(PG8_SA(0, 0), cA, voffA); PG8_STAGE(PG8_SA(0, 1), cA + hstep, voffA);
        if (wr == 1) PG8_BAR;
        PG8_WAIT_V(2); PG8_BAR;
        PG8_STAGE(PG8_SB(1, 0), cB + kstep, voffB); PG8_STAGE(PG8_SA(1, 0), cA + kstep, voffA); PG8_STAGE(PG8_SB(1, 1), cB + hstep + kstep, voffB);
        PG8_WAIT_V(6); PG8_BAR;
    } else {
        PG8_STAGE(PG8_SB(0, 0), cB, voffB); PG8_STAGE(PG8_SA(0, 0), cA, voffA); PG8_STAGE(PG8_SB(0, 1), cB + hstep, voffB); PG8_STAGE(PG8_SA(0, 1), cA + hstep, voffA);
        if (wr == 1) PG8_BAR;
        PG8_WAIT_V(4); PG8_BAR;
        PG8_STAGE(PG8_SB(1, 0), cB + kstep, voffB); PG8_STAGE(PG8_SA(1, 0), cA + kstep, voffA); PG8_STAGE(PG8_SB(1, 1), cB + hstep + kstep, voffB);
        PG8_WAIT_V(6); PG8_BAR;
    }
    for (;;) {
        const bool has_next = S.next(ui + 1, nxt);
        const char* nA = has_next ? (const char*)(nxt.w ? g.A2 : g.A) + (size_t)nxt.pm * tstep : cA; const char* nB = has_next ? (const char*)(nxt.w ? g.Bt2 : g.Bt) + (size_t)nxt.pn * tstep : cB;
        for (int t = 0; t < nt; t += 2) {
            const bool last = (t == nt - 2);
            const char* a1 = cA + (size_t)(t + 1) * kstep;
            const char* a2 = last ? nA : cA + (size_t)(t + 2) * kstep; const char* b2 = last ? nB : cB + (size_t)(t + 2) * kstep;
            const char* a3 = a2 + kstep; const char* b3 = b2 + kstep;
            if (last && has_next) S.a_ready(nxt);
            if constexpr (SP2) {
            PG8_LDB(B0, 0, 0); PG8_LDB(B1, 0, 1); PG8_SCHED; PG8_LDA(At, 0, 0); PG8_STAGE(PG8_SA(1, 1), a1 + hstep, voffA);
            PG8_WAIT_V(8); PG8_WAIT_L(0); PG8_BAR; PG8_MMA(0, 0, At, B0); PG8_MMA(0, 1, At, B1); PG8_BAR; PG8_SCHED;
            PG8_LDA(At, 0, 1); PG8_STAGE(PG8_SB(0, 0), b2, voffB); PG8_STAGE(PG8_SB(0, 1), b2 + hstep, voffB); PG8_STAGE(PG8_SA(0, 0), a2, voffA);
            PG8_WAIT_V(8); PG8_WAIT_L(0); PG8_BAR; PG8_MMA(1, 0, At, B0); PG8_MMA(1, 1, At, B1); PG8_BAR; PG8_SCHED;
            PG8_LDB(B0, 1, 0); PG8_LDB(B1, 1, 1); PG8_SCHED; PG8_LDA(At, 1, 0); PG8_STAGE(PG8_SA(0, 1), a2 + hstep, voffA);
            PG8_WAIT_V(8); PG8_WAIT_L(0); PG8_BAR; PG8_MMA(0, 0, At, B0); PG8_MMA(0, 1, At, B1); PG8_BAR; PG8_SCHED;
            PG8_LDA(At, 1, 1); PG8_STAGE(PG8_SB(1, 0), b3, voffB); PG8_STAGE(PG8_SB(1, 1), b3 + hstep, voffB); PG8_STAGE(PG8_SA(1, 0), a3, voffA);
            PG8_WAIT_V(8); PG8_WAIT_L(0); PG8_BAR; PG8_MMA(1, 0, At, B0); PG8_MMA(1, 1, At, B1); PG8_BAR; PG8_SCHED;
            } else {
            PG8_LDB(B0, 0, 0); PG8_SCHED; PG8_LDA(At, 0, 0); PG8_STAGE(PG8_SA(1, 1), a1 + hstep, voffA);
            PG8_WAIT_L(8); PG8_BAR; PG8_WAIT_L(0); PG8_MMA(0, 0, At, B0); PG8_BAR; PG8_SCHED;
            PG8_LDB(B1, 0, 1); PG8_STAGE(PG8_SB(0, 0), b2, voffB);
            PG8_BAR; PG8_WAIT_L(0); PG8_MMA(0, 1, At, B1); PG8_BAR;
            PG8_LDA(At, 0, 1); PG8_STAGE(PG8_SA(0, 0), a2, voffA);
            PG8_BAR; PG8_WAIT_L(0); PG8_MMA(1, 0, At, B0); PG8_BAR; PG8_SCHED;
            PG8_STAGE(PG8_SB(0, 1), b2 + hstep, voffB);
            PG8_WAIT_V(6); PG8_BAR; PG8_MMA(1, 1, At, B1); PG8_BAR;
            PG8_LDB(B0, 1, 0); PG8_SCHED; PG8_LDA(At, 1, 0); PG8_STAGE(PG8_SA(0, 1), a2 + hstep, voffA);
            PG8_WAIT_L(8); PG8_BAR; PG8_WAIT_L(0); PG8_MMA(0, 0, At, B0); PG8_BAR; PG8_SCHED;
            PG8_LDB(B1, 1, 1); PG8_STAGE(PG8_SB(1, 0), b3, voffB);
            PG8_BAR; PG8_WAIT_L(0); PG8_MMA(0, 1, At, B1); PG8_BAR;
            PG8_LDA(At, 1, 1); PG8_STAGE(PG8_SA(1, 0), a3, voffA);
            PG8_BAR; PG8_WAIT_L(0); PG8_MMA(1, 0, At, B0); PG8_BAR; PG8_SCHED;
            PG8_STAGE(PG8_SB(1, 1), b3 + hstep, voffB);
            PG8_WAIT_V(6); PG8_BAR; PG8_MMA(1, 1, At, B1); PG8_BAR;
            }
        }
        if constexpr (ALIGN_EPI) { if (wr == 0) PG8_BAR; }
        if constexpr (!Epi::AFTER_DRAIN) { E(acc, cur, wr, wc, fr, fq); S.done(cur); }
        if (!has_next) break;
#pragma unroll
        for (int a = 0; a < 2; ++a)
#pragma unroll
            for (int b = 0; b < 2; ++b)
#pragma unroll
                for (int m = 0; m < 4; ++m)
#pragma unroll
                    for (int n = 0; n < 2; ++n) acc[a][b][m][n] = (f32x4){0.f, 0.f, 0.f, 0.f};
        cur = nxt; cA = nA; cB = nB; ++ui;
        if constexpr (ALIGN_EPI) { if (wr == 1) PG8_BAR; }
    }
    PG8_WAIT_V(0);
    if constexpr (!ALIGN_EPI) { if (wr == 0) PG8_BAR; }
    PG8_BAR;
    if constexpr (Epi::AFTER_DRAIN) { E.fused(acc, cur, wr, wc, fr, fq, lds, wid, lane); S.done(cur); }
#undef PG8_SA
#undef PG8_SB
#undef PG8_STAGE
#undef PG8_LDA
#undef PG8_LDB
#undef PG8_MMA
#undef PG8_WAIT_V
#undef PG8_WAIT_L
#undef PG8_BAR
#undef PG8_SCHED
}
}
#ifndef PG8_SP2
#define PG8_SP2 true
#endif
#ifndef PG8_ALIGN
#define PG8_ALIGN true
#endif

#define LAS __attribute__((address_space(3)))
typedef unsigned short bf16_t;
typedef short bf16x8 __attribute__((ext_vector_type(8)));
typedef short bf16x4 __attribute__((ext_vector_type(4)));
typedef float f32x4 __attribute__((ext_vector_type(4)));
typedef float f32x16 __attribute__((ext_vector_type(16)));
typedef unsigned u32x4 __attribute__((ext_vector_type(4)));
typedef unsigned u32x2 __attribute__((ext_vector_type(2)));

constexpr int MTOK = 16384, DM = 1024, SEQ = 4096, NB = 4;
constexpr size_t MiB = 1u << 20;
constexpr size_t ARR = (size_t)MTOK * DM;
constexpr size_t WS_MODP = 0;
constexpr size_t WS_GATE = 786432;
constexpr size_t WS_AGG = 1 * MiB;
constexpr size_t WS_RSS = 5 * MiB;
constexpr size_t WS_WG = 6 * MiB;
constexpr size_t WS_WPA = 8 * MiB, WS_WPB = 10 * MiB, WS_WO = 12 * MiB, WS_WV = 14 * MiB;
constexpr size_t WS_WIN = 16 * MiB;
constexpr size_t WS_H = 32 * MiB;
constexpr size_t WS_XA = 64 * MiB, WS_ZA = 96 * MiB, WS_Q = 128 * MiB, WS_K = 160 * MiB, WS_ZB = 192 * MiB;
constexpr size_t WS_VT = 224 * MiB;
constexpr size_t WS_BAR = 802816;
constexpr int LDS_CIN = 131072, LDS_SEG = 131072 + 8192;
constexpr int LDS_MISC = 147456, LDS_RPB = 147456 + 256;
constexpr int LDS_BYTES = 147456 + 256 + 3840;

__device__ __forceinline__ float bf2f(unsigned short b) { return __uint_as_float(((unsigned)b) << 16); }
__device__ __forceinline__ unsigned pk2(float lo, float hi) { return pg8::cvt_pk_bf16(lo, hi); }
__device__ __forceinline__ float sigm(float v) { return __builtin_amdgcn_rcpf(1.f + __builtin_amdgcn_exp2f(-1.44269504089f * v)); }
__device__ __forceinline__ float wave_sum(float v) {
#pragma unroll
    for (int o = 1; o < 64; o <<= 1) v += __shfl_xor(v, o);
    return v;
}
#define LDS_WAIT() asm volatile("s_waitcnt lgkmcnt(0)" ::: "memory")

struct EpiProj {
    static constexpr bool PERM = true, AFTER_DRAIN = false;
    bf16_t* O5; bf16_t* OG;
    __device__ __forceinline__ void operator()(const f32x4 (&acc)[2][2][4][2], const pg8::Unit& u, int wr, int wc, int fr, int fq) const {
        const int arr = u.pn >> 2, colt = (u.pn & 3) * 256;
        bf16_t* base = arr < 5 ? O5 + (size_t)arr * ARR : OG + (size_t)(arr - 5) * ARR;
        const int mode = (arr == 1 || arr == 4) ? 1 : (arr >= 5 ? 2 : (arr == 2 ? 3 : 0));
        const int row0 = u.pm * 256 + wr * 64 + fr, col0 = colt + wc * 32 + 8 * fq;
#pragma unroll
        for (int ai = 0; ai < 2; ++ai)
#pragma unroll
            for (int m = 0; m < 4; ++m) { bf16_t* rowp = base + (size_t)(row0 + ai * 128 + m * 16) * DM + col0;
#pragma unroll
                for (int bj = 0; bj < 2; ++bj) { f32x4 v0 = acc[ai][bj][m][0], v1 = acc[ai][bj][m][1];
                    if (mode == 1) {
#pragma unroll
                        for (int j = 0; j < 4; ++j) { v0[j] = v0[j] * sigm(v0[j]); v1[j] = v1[j] * sigm(v1[j]); } }
                    else if (mode == 2) {
#pragma unroll
                        for (int j = 0; j < 4; ++j) { v0[j] = sigm(v0[j]); v1[j] = sigm(v1[j]); } }
                    else if (mode == 3) { v0 = v0 * 0.125f; v1 = v1 * 0.125f; }
                    u32x4 w; w.x = pk2(v0[0], v0[1]); w.y = pk2(v0[2], v0[3]); w.z = pk2(v1[0], v1[1]); w.w = pk2(v1[2], v1[3]);
                    *(u32x4*)(rowp + bj * 128) = w; } }
    }
};
struct EpiPlain {
    static constexpr bool PERM = true, AFTER_DRAIN = false;
    bf16_t* O; int ldc;
    __device__ __forceinline__ void operator()(const f32x4 (&acc)[2][2][4][2], const pg8::Unit& u, int wr, int wc, int fr, int fq) const {
        const int row0 = u.pm * 256 + wr * 64 + fr, col0 = u.pn * 256 + wc * 32 + 8 * fq;
#pragma unroll
        for (int ai = 0; ai < 2; ++ai)
#pragma unroll
            for (int m = 0; m < 4; ++m) { bf16_t* rowp = O + (size_t)(row0 + ai * 128 + m * 16) * ldc + col0;
#pragma unroll
                for (int bj = 0; bj < 2; ++bj) { const f32x4 v0 = acc[ai][bj][m][0], v1 = acc[ai][bj][m][1];
                    u32x4 w; w.x = pk2(v0[0], v0[1]); w.y = pk2(v0[2], v0[3]); w.z = pk2(v1[0], v1[1]); w.w = pk2(v1[2], v1[3]);
                    *(u32x4*)(rowp + bj * 128) = w; } }
    }
};
struct EpiGate2 {
    static constexpr bool PERM = true, AFTER_DRAIN = false;
    const bf16_t* Ga; const bf16_t* Gb; bf16_t* Tb; bf16_t* O;
    __device__ __forceinline__ void operator()(const f32x4 (&acc)[2][2][4][2], const pg8::Unit& u, int wr, int wc, int fr, int fq) const {
        const int row0 = u.pm * 256 + wr * 64 + fr, col0 = u.pn * 256 + wc * 32 + 8 * fq;
        const bf16_t* G = u.w ? Gb : Ga; bf16_t* dst = u.w ? O : Tb;
#pragma unroll
        for (int ai = 0; ai < 2; ++ai) {
            bf16x8 g[4][2], t[4][2];
#pragma unroll
            for (int m = 0; m < 4; ++m)
#pragma unroll
                for (int bj = 0; bj < 2; ++bj) { const size_t off = (size_t)(row0 + ai * 128 + m * 16) * DM + col0 + bj * 128;
                    g[m][bj] = *(const bf16x8*)(G + off);
                    if (u.w) t[m][bj] = *(const bf16x8*)(Tb + off); else t[m][bj] = (bf16x8){0, 0, 0, 0, 0, 0, 0, 0}; }
            asm volatile("" ::: "memory");
#pragma unroll
            for (int m = 0; m < 4; ++m)
#pragma unroll
                for (int bj = 0; bj < 2; ++bj) { const size_t off = (size_t)(row0 + ai * 128 + m * 16) * DM + col0 + bj * 128;
                    const f32x4 v0 = acc[ai][bj][m][0], v1 = acc[ai][bj][m][1];
                    float o[8];
#pragma unroll
                    for (int j = 0; j < 4; ++j) { o[j] = fmaf(bf2f((unsigned short)g[m][bj][j]), v0[j], bf2f((unsigned short)t[m][bj][j])); o[4 + j] = fmaf(bf2f((unsigned short)g[m][bj][4 + j]), v1[j], bf2f((unsigned short)t[m][bj][4 + j])); }
                    u32x4 w; w.x = pk2(o[0], o[1]); w.y = pk2(o[2], o[3]); w.z = pk2(o[4], o[5]); w.w = pk2(o[6], o[7]);
                    *(u32x4*)(dst + off) = w; }
            asm volatile("" ::: "memory");
        }
    }
};
struct EpiOut {
    static constexpr bool PERM = false, AFTER_DRAIN = false;
    const float* gate; float* out;
    __device__ __forceinline__ void operator()(const f32x4 (&acc)[2][2][4][2], const pg8::Unit& u, int wr, int wc, int fr, int fq) const {
        const int row0 = u.pm * 256 + wr * 64 + fr, col0 = u.pn * 256 + wc * 32 + 4 * fq;
        const float* gp = gate + (size_t)(u.pm >> 4) * DM + col0;
        f32x4 gv[2][2];
#pragma unroll
        for (int bj = 0; bj < 2; ++bj)
#pragma unroll
            for (int n = 0; n < 2; ++n) gv[bj][n] = *(const f32x4*)(gp + bj * 128 + n * 16);
#pragma unroll
        for (int ai = 0; ai < 2; ++ai)
#pragma unroll
            for (int m = 0; m < 4; ++m) { const size_t off = (size_t)(row0 + ai * 128 + m * 16) * DM + col0;
#pragma unroll
                for (int bj = 0; bj < 2; ++bj)
#pragma unroll
                    for (int n = 0; n < 2; ++n) *(f32x4*)(out + off + bj * 128 + n * 16) = gv[bj][n] * acc[ai][bj][m][n]; }
    }
};

__device__ __forceinline__ void p0_transpose_item(const float* W, int K, int N, bf16_t* WT, int dst_row0, int k0, int n0, LAS float* scr, int lane) {
#pragma unroll 8
    for (int i = 0; i < 32; ++i) { const int kk = 2 * i + (lane >> 5); scr[kk * 33 + (lane & 31)] = W[(size_t)(k0 + kk) * N + n0 + (lane & 31)]; }
    LDS_WAIT(); asm volatile("" ::: "memory");
    const int c = lane & 7;
#pragma unroll
    for (int j = 0; j < 4; ++j) { const int n = (lane >> 3) + 8 * j; const LAS float* s = scr + (8 * c) * 33 + n;
        u32x4 o; o.x = pk2(s[0 * 33], s[1 * 33]); o.y = pk2(s[2 * 33], s[3 * 33]); o.z = pk2(s[4 * 33], s[5 * 33]); o.w = pk2(s[6 * 33], s[7 * 33]);
        *(u32x4*)(WT + (size_t)(dst_row0 + n) * K + k0 + 8 * c) = o; }
    LDS_WAIT(); asm volatile("" ::: "memory");
}

struct Args { const float* in[23]; float* out; unsigned char* ws; };

__device__ __forceinline__ void p0_prologue(const Args& a, LAS unsigned char* lds, int gw, int NGW, int wave, int lane) {
    LAS float* scr = (LAS float*)(lds + wave * 16384);
    unsigned char* ws = a.ws;
    const float* c = a.in[1]; const float* w_c = a.in[3]; const float* w_in = a.in[5];
    float* modp = (float*)(ws + WS_MODP);
    constexpr int I_MOD = 768, I_IN = 16 * 256, I_SQ = 16 * 32, I_G = 4 * 16 * 2;
    constexpr int NITEMS = I_MOD + I_IN + 3 * I_SQ + I_G;
    for (int it = gw; it < NITEMS; it += NGW) {
        int r = it;
        if (r < I_MOD) {
            const int cgi = r % 48, kc = r / 48, col = cgi * 64 + lane, k0 = kc * 64;
            float sv[4];
#pragma unroll
            for (int b = 0; b < 4; ++b) { const float cv = c[b * DM + k0 + lane]; sv[b] = cv * sigm(cv); }
            float acc[4] = {0.f, 0.f, 0.f, 0.f};
#pragma unroll 8
            for (int kk = 0; kk < 64; ++kk) { const float w = w_c[(size_t)(k0 + kk) * 3072 + col];
#pragma unroll
                for (int b = 0; b < 4; ++b) acc[b] += __shfl(sv[b], kk) * w; }
#pragma unroll
            for (int b = 0; b < 4; ++b) modp[(size_t)(kc * 4 + b) * 3072 + col] = acc[b];
            continue;
        }
        r -= I_MOD;
        if (r < I_IN) { const int kb = r / 256, nb = r % 256, n0 = nb * 32, cb = n0 >> 10;
            if (cb == 4) p0_transpose_item(w_in, 1024, 8192, (bf16_t*)(ws + WS_WV), n0 - 4096, kb * 64, n0, scr, lane);
            else p0_transpose_item(w_in, 1024, 8192, (bf16_t*)(ws + WS_WIN), (cb < 4 ? cb : cb - 1) * 1024 + (n0 & 1023), kb * 64, n0, scr, lane);
            continue; }
        r -= I_IN;
        if (r < 3 * I_SQ) { const int which = r / I_SQ, rr = r % I_SQ, kb = rr / 32, nb = rr % 32;
            const float* W = which == 0 ? a.in[19] : (which == 1 ? a.in[20] : a.in[21]);
            bf16_t* WT = (bf16_t*)(ws + (which == 0 ? WS_WPA : (which == 1 ? WS_WPB : WS_WO)));
            p0_transpose_item(W, 1024, 1024, WT, nb * 32, kb * 64, nb * 32, scr, lane);
            continue; }
        r -= 3 * I_SQ;
        { const int g = r / 32, rr = r % 32, hb = rr / 2, nb = rr % 2;
            const float* W = (g == 0 ? a.in[8] : (g == 1 ? a.in[10] : (g == 2 ? a.in[13] : a.in[15]))) + (size_t)hb * 4096;
            bf16_t* WT = (bf16_t*)(ws + WS_WG) + (size_t)(g * 16 + hb) * 4096;
            p0_transpose_item(W, 64, 64, WT, nb * 32, 0, nb * 32, scr, lane); }
    }
}

__device__ __forceinline__ void p1_hpass(const Args& a, LAS unsigned char* lds, int G, int tid, int wave, int lane) {
    unsigned char* ws = a.ws;
    const float* x = a.in[0]; const float* g_pre = a.in[2]; const float* b_c = a.in[4];
    const float* modp = (const float*)(ws + WS_MODP);
    bf16_t* H = (bf16_t*)(ws + WS_H);
    LAS float* sh = (LAS float*)lds;
    for (int rb = blockIdx.x; rb < MTOK / 64; rb += G) {
        const int b = rb >> 6;
        __syncthreads();
        for (int idx = tid; idx < 2048; idx += 512) { float s = b_c[idx];
#pragma unroll
            for (int kc = 0; kc < 16; ++kc) s += modp[(size_t)(kc * 4 + b) * 3072 + idx];
            sh[idx] = idx < 1024 ? s : 1.f + s; }
        __syncthreads();
        for (int rr = wave; rr < 64; rr += 8) { const int row = rb * 64 + rr;
            const f32x4* xr = (const f32x4*)(x + (size_t)row * DM) + lane;
            f32x4 v[4]; float s = 0.f;
#pragma unroll
            for (int j = 0; j < 4; ++j) { v[j] = xr[64 * j]; s += (v[j][0] * v[j][0] + v[j][1] * v[j][1]) + (v[j][2] * v[j][2] + v[j][3] * v[j][3]); }
            const float rstd = __builtin_amdgcn_rsqf(wave_sum(s) * (1.f / 1024.f) + 1e-6f);
#pragma unroll
            for (int j = 0; j < 4; ++j) { const int col = 4 * lane + 256 * j;
                const f32x4 g = *(const f32x4*)(g_pre + col); const f32x4 sc = *(const LAS f32x4*)(sh + 1024 + col); const f32x4 sf = *(const LAS f32x4*)(sh + col);
                const f32x4 o = (v[j] * rstd) * g * sc + sf;
                u32x2 w; w.x = pk2(o[0], o[1]); w.y = pk2(o[2], o[3]);
                *(u32x2*)(H + (size_t)row * DM + col) = w; }
        }
    }
    float* gate = (float*)(ws + WS_GATE);
    for (int idx = blockIdx.x * 512 + tid; idx < 4096; idx += G * 512) { const int b = idx >> 10, col = idx & 1023; float s = b_c[2048 + col];
#pragma unroll
        for (int kc = 0; kc < 16; ++kc) s += modp[(size_t)(kc * 4 + b) * 3072 + 2048 + col];
        gate[idx] = s; }
}

__device__ __forceinline__ int attn_fk(int col) { return ((col >> 1) & 1) | (((col >> 3) & 3) << 1); }
__device__ __forceinline__ void attn_phase(const bf16_t* Q, const bf16_t* Kb, const bf16_t* VT, const bf16_t* ZB, const float* rpb, bf16_t* YB, LAS unsigned char* lds, int vcu, int G, int tid, int wave, int lane) {
    const int fr = lane & 15, fq = lane >> 4;
    constexpr float L2E = 1.44269504089f;
    LAS float* rpbL = (LAS float*)(lds + LDS_RPB);
    const int rsel = wave >> 2, j = wave & 3;
    const int cs = min(max(16 * j - 8, 0), 32);
    const int qc = 16 * j + fr, c0 = min(max(qc - 8, 0), 48);
    const int lcol = tid >> 3, lch = tid & 7;
    for (int u = vcu; u < 256; u += G) {
        const int band = u & 3, h = (u >> 2) & 15, b = u >> 6, R0 = band * 16;
        __syncthreads();
        for (int i = tid; i < 15 * 64; i += 512) { const int dr = i >> 6, dc = (i & 63) - 16; rpbL[i] = (dc >= 0 && dc < 31) ? rpb[(size_t)(h * 15 + dr) * 31 + dc] : 0.f; }
        int loaded_hi = -1;
#pragma unroll 1
        for (int ss = 0; ss < 8; ++ss) {
            const int r = R0 + 2 * ss;
            const int lo = min(max(r - 4, 0), 56), hi = min(max(r - 3, 0), 56) + 7;
            const int first = loaded_hi < 0 ? lo : loaded_hi + 1;
            if (ss > 0) __syncthreads();
            {
                u32x4 kv[9], vv[9];
#pragma unroll
                for (int k = 0; k < 9; ++k) { const int row = first + k;
                    if (row <= hi) { const size_t tokrow = (size_t)b * SEQ + (size_t)row * 64;
                        kv[k] = *(const u32x4*)(Kb + (tokrow + lcol) * DM + h * 64 + lch * 8);
                        vv[k] = *(const u32x4*)(VT + (size_t)(h * 64 + lcol) * MTOK + tokrow + lch * 8); } }
#pragma unroll
                for (int k = 0; k < 9; ++k) { const int row = first + k;
                    if (row <= hi) { const int slot = row % 9;
                        *(LAS u32x4*)(lds + slot * 16384 + lcol * 128 + ((lch ^ attn_fk(lcol)) << 4)) = kv[k];
                        *(LAS u32x4*)(lds + slot * 16384 + 8192 + lcol * 128 + ((lch ^ ((lcol >> 1) & 7)) << 4)) = vv[k]; } }
            }
            loaded_hi = hi;
            __syncthreads();
            const int ro = r + rsel, r0 = min(max(ro - 4, 0), 56);
            const size_t tokq = (size_t)b * SEQ + ro * 64 + qc;
            bf16x8 qf[2];
#pragma unroll
            for (int ks = 0; ks < 2; ++ks) qf[ks] = *(const bf16x8*)(Q + tokq * DM + h * 64 + ks * 32 + fq * 8);
            f32x4 s[8][2];
#pragma unroll
            for (int w = 0; w < 8; ++w) { const int slot = (r0 + w) % 9;
#pragma unroll
                for (int t = 0; t < 2; ++t) { const int kc = cs + 8 * (fr >> 2) + (fr & 3) + 4 * t; const int fk = attn_fk(kc);
                    f32x4 acc = {0.f, 0.f, 0.f, 0.f};
#pragma unroll
                    for (int ks = 0; ks < 2; ++ks) { const bf16x8 kf = *(const LAS bf16x8*)(lds + slot * 16384 + kc * 128 + (((ks * 4 + fq) ^ fk) << 4));
                        acc = __builtin_amdgcn_mfma_f32_16x16x32_bf16(kf, qf[ks], acc, 0, 0, 0); }
                    s[w][t] = acc; } }
            float mx = -1e30f;
#pragma unroll
            for (int w = 0; w < 8; ++w) { const LAS float* rp = rpbL + (r0 + w - ro + 7) * 64 + 16;
#pragma unroll
                for (int t = 0; t < 2; ++t)
#pragma unroll
                    for (int i = 0; i < 4; ++i) { const int kcol = cs + 8 * fq + 4 * t + i; const bool ok = (kcol >= c0) && (kcol < c0 + 16);
                        const float v = ok ? (s[w][t][i] + rp[kcol - qc + 15]) * L2E : -1e30f; s[w][t][i] = v; mx = fmaxf(mx, v); } }
            mx = fmaxf(mx, __shfl_xor(mx, 16)); mx = fmaxf(mx, __shfl_xor(mx, 32));
            float sum = 0.f; bf16x8 pf[8];
#pragma unroll
            for (int w = 0; w < 8; ++w) { float p[8];
#pragma unroll
                for (int t = 0; t < 2; ++t)
#pragma unroll
                    for (int i = 0; i < 4; ++i) { const float e = __builtin_amdgcn_exp2f(s[w][t][i] - mx); p[4 * t + i] = e; sum += e; }
                u32x4 pw; pw.x = pk2(p[0], p[1]); pw.y = pk2(p[2], p[3]); pw.z = pk2(p[4], p[5]); pw.w = pk2(p[6], p[7]);
                pf[w] = __builtin_bit_cast(bf16x8, pw); }
            sum += __shfl_xor(sum, 16); sum += __shfl_xor(sum, 32);
            const float inv = 1.f / sum;
            f32x4 o[4];
#pragma unroll
            for (int dt = 0; dt < 4; ++dt) o[dt] = (f32x4){0.f, 0.f, 0.f, 0.f};
#pragma unroll
            for (int w = 0; w < 8; ++w) { const int slot = (r0 + w) % 9;
#pragma unroll
                for (int dt = 0; dt < 4; ++dt) { const int d = dt * 16 + fr;
                    const bf16x8 vf = *(const LAS bf16x8*)(lds + slot * 16384 + 8192 + d * 128 + ((((cs >> 3) + fq) ^ ((d >> 1) & 7)) << 4));
                    o[dt] = __builtin_amdgcn_mfma_f32_16x16x32_bf16(vf, pf[w], o[dt], 0, 0, 0); } }
#pragma unroll
            for (int dt = 0; dt < 4; ++dt) { const size_t off = tokq * DM + h * 64 + dt * 16 + 4 * fq;
                const bf16x4 z = *(const bf16x4*)(ZB + off);
                u32x2 w; w.x = pk2(o[dt][0] * inv * bf2f((unsigned short)z[0]), o[dt][1] * inv * bf2f((unsigned short)z[1]));
                w.y = pk2(o[dt][2] * inv * bf2f((unsigned short)z[2]), o[dt][3] * inv * bf2f((unsigned short)z[3]));
                *(u32x2*)(YB + off) = w; }
        }
    }
    __syncthreads();
}

template <bool FINAL, int DIR>
__device__ __forceinline__ void scan_dir(const LAS bf16x8* afrL, int lane, int ct, const bf16_t* WGr, const bf16_t* WGi, float br, float bi, float cl, float Hin,
                                         const bf16x8 (&idf)[2], float& Aout, float& Uout, const bf16_t* ZAp, bf16_t* YAp) {
    const int n = lane & 31, hf = lane >> 5;
    bf16x8 Br[4], Bi[4];
#pragma unroll
    for (int kk = 0; kk < 4; ++kk) { Br[kk] = *(const bf16x8*)(WGr + (size_t)(32 * ct + n) * 64 + 16 * kk + 8 * hf); Bi[kk] = *(const bf16x8*)(WGi + (size_t)(32 * ct + n) * 64 + 16 * kk + 8 * hf); }
    float H = Hin, Ap = 1.f;
#pragma unroll 1
    for (int si = 0; si < 4; ++si) { const int s = DIR ? 3 - si : si;
        f32x16 ar, ai, ax;
#pragma unroll
        for (int e = 0; e < 16; ++e) { ar[e] = 0.f; ai[e] = 0.f; ax[e] = 0.f; }
#pragma unroll
        for (int kk = 0; kk < 4; ++kk) { const bf16x8 av = afrL[(s * 4 + kk) * 64 + lane];
            ar = __builtin_amdgcn_mfma_f32_32x32x16_bf16(av, Br[kk], ar, 0, 0, 0); ai = __builtin_amdgcn_mfma_f32_32x32x16_bf16(av, Bi[kk], ai, 0, 0, 0); }
        { const bf16x8 a0 = afrL[(s * 4 + 2 * ct) * 64 + lane], a1 = afrL[(s * 4 + 2 * ct + 1) * 64 + lane];
            ax = __builtin_amdgcn_mfma_f32_32x32x16_bf16(a0, idf[0], ax, 0, 0, 0); ax = __builtin_amdgcn_mfma_f32_32x32x16_bf16(a1, idf[1], ax, 0, 0, 0); }
        const bf16_t* zs = ZAp + (size_t)(16 * s) * DM; bf16_t* ys = YAp + (size_t)(16 * s) * DM;
#pragma unroll
        for (int ei = 0; ei < 16; ++ei) { const int e = DIR ? 15 - ei : ei;
            const float r = sigm(ar[e] + br), ig = sigm(ai[e] + bi);
            const float av = __builtin_amdgcn_exp2f(cl * r);
            const float om = fmaxf(fmaf(-av, av, 1.f), 0.f);
            const float u = __builtin_amdgcn_sqrtf(om) * (ig * ax[e]);
            H = fmaf(av, H, u);
            if (FINAL) {
                if (DIR == 0) ys[(size_t)e * DM] = (bf16_t)(pk2(H, 0.f) & 0xffffu);
                else ys[(size_t)e * DM] = (bf16_t)(pk2((H + bf2f(ys[(size_t)e * DM])) * bf2f(zs[(size_t)e * DM]), 0.f) & 0xffffu); }
            else Ap *= av; }
    }
    Aout = Ap; Uout = H;
}

template <bool FINAL>
__device__ __forceinline__ void scan_phase(const Args& a, LAS unsigned char* lds, int gw, int NGW, int wave, int lane) {
    unsigned char* ws = a.ws;
    const bf16_t* XA = (const bf16_t*)(ws + WS_XA); const bf16_t* ZA = (const bf16_t*)(ws + WS_ZA);
    const bf16_t* WG = (const bf16_t*)(ws + WS_WG);
    const float* conv_w = a.in[6]; const float* conv_b = a.in[7];
    typedef float f32x2 __attribute__((ext_vector_type(2)));
    f32x2* AGG = (f32x2*)(ws + WS_AGG);
    bf16_t* YA = (bf16_t*)(ws + WS_H);
    LAS bf16x8* afrL = (LAS bf16x8*)(lds + wave * 16384);
    const int n = lane & 31, hf = lane >> 5;
    bf16x8 idf[2];
#pragma unroll
    for (int k2 = 0; k2 < 2; ++k2)
#pragma unroll
        for (int jj = 0; jj < 8; ++jj) idf[k2][jj] = (16 * k2 + 8 * hf + jj == n) ? (short)0x3F80 : (short)0;
    for (int wt = gw; wt < 2048; wt += NGW) {
        const int cp = wt & 31, jb = (wt >> 5) & 15, b = wt >> 9, ch0 = jb * 64;
        { const int a_half = (n >> 2) & 1, a_idx = (n & 3) + 4 * (n >> 3), a_chunk = 2 * cp + a_half;
#pragma unroll 1
          for (int kk = 0; kk < 4; ++kk) { const int ch = ch0 + 16 * kk + 8 * hf;
              float cw[4][8], cb[8];
#pragma unroll
              for (int w = 0; w < 4; ++w) { const f32x4 c0 = *(const f32x4*)(conv_w + w * DM + ch), c1 = *(const f32x4*)(conv_w + w * DM + ch + 4);
#pragma unroll
                  for (int jj = 0; jj < 4; ++jj) { cw[w][jj] = c0[jj]; cw[w][4 + jj] = c1[jj]; } }
              { const f32x4 c0 = *(const f32x4*)(conv_b + ch), c1 = *(const f32x4*)(conv_b + ch + 4);
#pragma unroll
                  for (int jj = 0; jj < 4; ++jj) { cb[jj] = c0[jj]; cb[4 + jj] = c1[jj]; } }
#pragma unroll
              for (int s = 0; s < 4; ++s) { const int p = a_chunk * 64 + 16 * s + a_idx;
                  float acc[8];
#pragma unroll
                  for (int jj = 0; jj < 8; ++jj) acc[jj] = cb[jj];
#pragma unroll
                  for (int w = 0; w < 4; ++w) { const int pp = p + w - 2; const bool ok = (pp >= 0) && (pp < SEQ); const int pc = min(max(pp, 0), SEQ - 1);
                      const bf16x8 xv = *(const bf16x8*)(XA + ((size_t)b * SEQ + pc) * DM + ch);
#pragma unroll
                      for (int jj = 0; jj < 8; ++jj) acc[jj] = fmaf(cw[w][jj], ok ? bf2f((unsigned short)xv[jj]) : 0.f, acc[jj]); }
                  u32x4 pw; pw.x = pk2(acc[0], acc[1]); pw.y = pk2(acc[2], acc[3]); pw.z = pk2(acc[4], acc[5]); pw.w = pk2(acc[6], acc[7]);
                  afrL[(s * 4 + kk) * 64 + lane] = __builtin_bit_cast(bf16x8, pw); } } }
        LDS_WAIT(); asm volatile("" ::: "memory");
        const int chunk = 2 * cp + hf;
        if (FINAL) {
            const int tid = threadIdx.x, pdir = tid >> 8, pseg = (tid >> 6) & 3, pch = tid & 63, q = cp >> 3;
            LAS f32x2* segL = (LAS f32x2*)(lds + LDS_SEG);
            LAS float* cinL = (LAS float*)(lds + LDS_CIN);
            f32x2 g[16];
#pragma unroll
            for (int i = 0; i < 16; ++i) g[i] = AGG[((size_t)(b * 2 + pdir) * 64 + 16 * pseg + i) * DM + ch0 + pch];
            float As = 1.f, Us = 0.f;
#pragma unroll
            for (int ii = 0; ii < 16; ++ii) { const int i = pdir ? 15 - ii : ii; Us = fmaf(g[i][0], Us, g[i][1]); As *= g[i][0]; }
            __syncthreads();
            segL[(pdir * 4 + pseg) * 64 + pch] = (f32x2){As, Us};
            __syncthreads();
            if (pseg == q) { float Hc = 0.f;
                if (pdir == 0) { for (int s2 = 0; s2 < pseg; ++s2) { const f32x2 sg = segL[(0 * 4 + s2) * 64 + pch]; Hc = fmaf(sg[0], Hc, sg[1]); } }
                else { for (int s2 = 3; s2 > pseg; --s2) { const f32x2 sg = segL[(1 * 4 + s2) * 64 + pch]; Hc = fmaf(sg[0], Hc, sg[1]); } }
#pragma unroll
                for (int ii = 0; ii < 16; ++ii) { const int i = pdir ? 15 - ii : ii; cinL[(pdir * 16 + i) * 64 + pch] = Hc; Hc = fmaf(g[i][0], Hc, g[i][1]); } }
            __syncthreads();
        }
#pragma unroll 1
        for (int ct = 0; ct < 2; ++ct) { const int ch = ch0 + 32 * ct + n;
            float Af, Uf, Ab, Ub;
            {
                const float br = a.in[9][ch], bi = a.in[11][ch]; const float lam = a.in[12][ch];
                const float cl = -8.f * 1.44269504089f * log1pf(expf(-lam));
                float Hin = 0.f;
                if (FINAL) Hin = ((const LAS float*)(lds + LDS_CIN))[(0 * 16 + (chunk & 15)) * 64 + 32 * ct + n];
                scan_dir<FINAL, 0>(afrL, lane, ct, WG + (size_t)(0 * 16 + jb) * 4096, WG + (size_t)(1 * 16 + jb) * 4096, br, bi, cl, Hin, idf, Af, Uf, ZA + ((size_t)b * SEQ + chunk * 64) * DM + ch, YA + ((size_t)b * SEQ + chunk * 64) * DM + ch);
            }
            {
                const float br = a.in[14][ch], bi = a.in[16][ch]; const float lam = a.in[17][ch];
                const float cl = -8.f * 1.44269504089f * log1pf(expf(-lam));
                float Hin = 0.f;
                if (FINAL) Hin = ((const LAS float*)(lds + LDS_CIN))[(1 * 16 + (chunk & 15)) * 64 + 32 * ct + n];
                scan_dir<FINAL, 1>(afrL, lane, ct, WG + (size_t)(2 * 16 + jb) * 4096, WG + (size_t)(3 * 16 + jb) * 4096, br, bi, cl, Hin, idf, Ab, Ub, ZA + ((size_t)b * SEQ + chunk * 64) * DM + ch, YA + ((size_t)b * SEQ + chunk * 64) * DM + ch);
            }
            if (!FINAL) {
                AGG[((size_t)(b * 2 + 0) * 64 + chunk) * DM + ch] = (f32x2){Af, Uf};
                AGG[((size_t)(b * 2 + 1) * 64 + chunk) * DM + ch] = (f32x2){Ab, Ub};
            }
        }
        LDS_WAIT(); asm volatile("" ::: "memory");
    }
}

__device__ __forceinline__ void final_norm(const Args& a, int gw, int NGW, int lane) {
    const float* x = a.in[0]; const float* g_final = a.in[22]; float* out = a.out;
    f32x4 g[4];
#pragma unroll
    for (int j = 0; j < 4; ++j) g[j] = *((const f32x4*)g_final + lane + 64 * j);
    for (int row = gw; row < MTOK; row += NGW) {
        f32x4* orow = (f32x4*)(out + (size_t)row * DM) + lane; const f32x4* xrow = (const f32x4*)(x + (size_t)row * DM) + lane;
        f32x4 v[4]; float ss = 0.f;
#pragma unroll
        for (int j = 0; j < 4; ++j) { v[j] = orow[64 * j] + xrow[64 * j]; ss += (v[j][0] * v[j][0] + v[j][1] * v[j][1]) + (v[j][2] * v[j][2] + v[j][3] * v[j][3]); }
        const float rstd = __builtin_amdgcn_rsqf(wave_sum(ss) * (1.f / 1024.f) + 1e-6f);
#pragma unroll
        for (int j = 0; j < 4; ++j) orow[64 * j] = v[j] * rstd * g[j];
    }
}

#define XB_TMO      128
#define XB_XCNT(j)  (256  + 64 * (j))
#define XB_XSUB(j)  (1280 + 64 * (j))
#define XB_XGEN(j)  (2304 + 64 * (j))
#define XB_TOP      3328
#define XB_TOPGEN   3392
#define XCD_BAR_WORDS 3456
#define XB_SPIN_CAP (1u << 18)
__device__ __forceinline__ unsigned xb_ld(unsigned* p)              { return __hip_atomic_load(p, __ATOMIC_RELAXED, __HIP_MEMORY_SCOPE_AGENT); }
__device__ __forceinline__ unsigned xb_add(unsigned* p, unsigned v) { return __hip_atomic_fetch_add(p, v, __ATOMIC_RELAXED, __HIP_MEMORY_SCOPE_AGENT); }
__device__ __forceinline__ unsigned xb_xcc_id() { return (unsigned)__builtin_amdgcn_s_getreg((3 << 11) | 20) & 0xFu; }
#define XB_SPIN(cond, bar) do { unsigned _sp = 0; while (cond) { __builtin_amdgcn_s_sleep(1); \
    if ((++_sp & 255u) == 0u) { if (xb_ld(&(bar)[XB_TMO])) break; if (_sp > XB_SPIN_CAP) { atomicAdd(&(bar)[XB_TMO], 1u); break; } } } } while (0)
struct XcdBarrier { unsigned* bar; unsigned x; volatile LAS unsigned* st; };
__device__ __forceinline__ XcdBarrier xcd_barrier_post(unsigned* bar, volatile LAS unsigned* st) {
    XcdBarrier b; b.bar = bar; b.x = xb_xcc_id(); b.st = st;
    if (threadIdx.x == 0) (void)xb_add(&bar[XB_XCNT(b.x)], 1u);
    return b;
}
__device__ __forceinline__ void xcd_barrier_complete(unsigned* bar, unsigned x, unsigned& nloc, unsigned& nx) {
    const unsigned G = gridDim.x * gridDim.y * gridDim.z;
    unsigned sum, cnt, mine, sp = 0u;
    for (;;) {
        sum = 0u; cnt = 0u; mine = 0u;
#pragma unroll
        for (unsigned j = 0; j < 16; ++j) { const unsigned c = xb_ld(&bar[XB_XCNT(j)]); sum += c; cnt += (c > 0u) ? 1u : 0u; mine = (j == x) ? c : mine; }
        if (sum == G) break;
        __builtin_amdgcn_s_sleep(1);
        if ((++sp & 255u) == 0u) { if (xb_ld(&bar[XB_TMO])) break; if (sp > XB_SPIN_CAP) { atomicAdd(&bar[XB_TMO], 1u); break; } }
    }
    nloc = mine > 0u ? mine : 1u; nx = cnt > 0u ? cnt : 1u;
}
__device__ __forceinline__ void xcd_barrier(const XcdBarrier& b) {
    asm volatile("s_waitcnt vmcnt(0)" ::: "memory");
    __syncthreads();
    if (threadIdx.x == 0) {
        unsigned* bar = b.bar;
        __builtin_amdgcn_s_waitcnt(0);
        unsigned nloc = b.st[0], nx = b.st[1];
        if (nloc == 0u) { xcd_barrier_complete(bar, b.x, nloc, nx); b.st[0] = nloc; b.st[1] = nx; }
        const unsigned old = xb_add(&bar[XB_XSUB(b.x)], 1u);
        const unsigned gen = old / nloc;
        if (old + 1u == (gen + 1u) * nloc) {
            __builtin_amdgcn_fence(__ATOMIC_RELEASE, "agent");
            asm volatile("s_waitcnt vmcnt(0)" ::: "memory");
            const unsigned og = xb_add(&bar[XB_TOP], 1u);
            const unsigned tg = og / nx;
            if (og + 1u == (tg + 1u) * nx) xb_add(&bar[XB_TOPGEN], 1u);
            else XB_SPIN(xb_ld(&bar[XB_TOPGEN]) == tg, bar);
            __builtin_amdgcn_fence(__ATOMIC_ACQUIRE, "agent");
            xb_add(&bar[XB_XGEN(b.x)], 1u);
            asm volatile("s_waitcnt vmcnt(0)" ::: "memory");
        } else {
            XB_SPIN(xb_ld(&bar[XB_XGEN(b.x)]) == gen, bar);
            __builtin_amdgcn_fence(__ATOMIC_ACQUIRE, "agent");
            asm volatile("s_waitcnt vmcnt(0)" ::: "memory");
        }
    }
    __syncthreads();
}

__global__ void __launch_bounds__(512, 2) fwd_kernel(Args a) {
    extern __shared__ __attribute__((aligned(16))) unsigned char lds_raw[];
    LAS unsigned char* lds = (LAS unsigned char*)lds_raw;
    cg::grid_group grid = cg::this_grid();
    const int tid = threadIdx.x, lane = tid & 63, wave = __builtin_amdgcn_readfirstlane(tid >> 6);
    const int G = gridDim.x, bx = blockIdx.x;
    const int vcu = (G % 8 == 0) ? (bx % 8) * (G / 8) + bx / 8 : bx;
    const int gw = bx * 8 + wave, NGW = G * 8;
    unsigned char* ws = a.ws;
#ifdef PROBE_A0
    unsigned long long tA0 = 0, tA1 = 0, tB0 = 0, tB1 = 0;
#define STAMP(k) do { const unsigned long long _t = __builtin_amdgcn_s_memrealtime(); if ((k) == PROBE_A0) tA0 = _t; if ((k) == PROBE_A1) tA1 = _t; if ((k) == PROBE_B0) tB0 = _t; if ((k) == PROBE_B1) tB1 = _t; } while (0)
#else
#define STAMP(k) do {} while (0)
#endif
    STAMP(0);
    unsigned* barw = (unsigned*)(ws + WS_BAR);
    if (tid < 4) ((volatile LAS unsigned*)(lds + LDS_MISC))[tid] = 0u;
    __syncthreads();
    XcdBarrier xb = xcd_barrier_post(barw, (volatile LAS unsigned*)(lds + LDS_MISC));
    if (a.ws == nullptr) grid.sync();

#define PH(k) (!defined(ONLY) || ONLY == (k))
#if !defined(ONLY) || ONLY == 0
    p0_prologue(a, lds, gw, NGW, wave, lane);
#endif
    STAMP(1);
    xcd_barrier(xb);
    STAMP(2);
#if !defined(ONLY) || ONLY == 1
    p1_hpass(a, lds, G, tid, wave, lane);
#endif
    STAMP(3);
    xcd_barrier(xb);
    STAMP(4);
#if !defined(ONLY) || ONLY == 2
    {
        pg8::Gemm g{(const bf16_t*)(ws + WS_H), (const bf16_t*)(ws + WS_WIN), MTOK, 7168, 1024}; pg8::StaticOrder S; S.init(MTOK, 7168, G, bx);
        EpiProj E{(bf16_t*)(ws + WS_XA), (bf16_t*)a.out};
        pg8::gemm_phase<EpiProj, pg8::StaticOrder, PG8_ALIGN, PG8_SP2>(lds, g, S, E);
    }
    STAMP(5);
    {
        pg8::Gemm g{(const bf16_t*)(ws + WS_WV), (const bf16_t*)(ws + WS_H), 1024, MTOK, 1024}; pg8::StaticOrder S; S.init(1024, MTOK, G, bx);
        EpiPlain E{(bf16_t*)(ws + WS_VT), MTOK};
        pg8::gemm_phase<EpiPlain, pg8::StaticOrder, PG8_ALIGN, PG8_SP2>(lds, g, S, E);
    }
    STAMP(6);
#endif
    xcd_barrier(xb);
    STAMP(7);
#if !defined(ONLY) || ONLY == 3
    attn_phase((const bf16_t*)(ws + WS_Q), (const bf16_t*)(ws + WS_K), (const bf16_t*)(ws + WS_VT), (const bf16_t*)(ws + WS_ZB), a.in[18], (bf16_t*)(ws + WS_Q), lds, vcu, G, tid, wave, lane);
#endif
    STAMP(8);
#if !defined(ONLY) || ONLY == 4
    scan_phase<false>(a, lds, gw, NGW, wave, lane);
#endif
    STAMP(9);
    xcd_barrier(xb);
    STAMP(10);
#if !defined(ONLY) || ONLY == 5
    scan_phase<true>(a, lds, gw, NGW, wave, lane);
#endif
    STAMP(11);
    xcd_barrier(xb);
    STAMP(12);
#if !defined(ONLY) || ONLY == 6
    {
        pg8::Gemm g{(const bf16_t*)(ws + WS_H), (const bf16_t*)(ws + WS_WPA), MTOK, 1024, 1024, (const bf16_t*)(ws + WS_Q), (const bf16_t*)(ws + WS_WPB)}; pg8::PairOrder S; S.init(MTOK, 1024, G, bx);
        EpiGate2 E{(const bf16_t*)a.out, (const bf16_t*)a.out + ARR, (bf16_t*)(ws + WS_K), (bf16_t*)(ws + WS_XA)};
        pg8::gemm_phase<EpiGate2, pg8::PairOrder, PG8_ALIGN, PG8_SP2>(lds, g, S, E);
    }
    STAMP(14);
#endif
    xcd_barrier(xb);
    STAMP(15);
#if !defined(ONLY) || ONLY == 7
    {
        pg8::Gemm g{(const bf16_t*)(ws + WS_XA), (const bf16_t*)(ws + WS_WO), MTOK, 1024, 1024}; pg8::StaticOrder S; S.init(MTOK, 1024, G, bx);
        EpiOut E{(const float*)(ws + WS_GATE), a.out};
        pg8::gemm_phase<EpiOut, pg8::StaticOrder, PG8_ALIGN, PG8_SP2>(lds, g, S, E);
    }
    STAMP(16);
#endif
    xcd_barrier(xb);
    STAMP(17);
#if !defined(ONLY) || ONLY == 8
    final_norm(a, gw, NGW, lane);
#endif
#ifdef PROBE_A0
    STAMP(18);
    if (bx == 0) {
        const float dA = (float)(tA1 - tA0) * 0.01f, dB = (float)(tB1 - tB0) * 0.01f;
        __syncthreads();
        float* orow = a.out + (size_t)wave * DM;
        for (int i = lane; i < DM; i += 64) orow[i] += dB;
        __syncthreads();
        if (tid == 0) a.out[0] += dA;
    }
#endif
}

extern "C" void kernel_launch(void* const* d_in, const int* in_sizes, int n_in, void* d_out, int out_size, void* d_ws, size_t ws_size, hipStream_t stream) {
    static int grid = 0;
    if (grid == 0) {
        if (n_in != 23 || out_size != MTOK * DM || ws_size < 256 * MiB) { fprintf(stderr, "kernel_launch: unexpected problem shape (n_in %d, out %d, ws %zu)\n", n_in, out_size, ws_size); grid = -1; return; }
        int dev = 0, cus = 0, per_cu = 0;
        (void)hipGetDevice(&dev);
        (void)hipDeviceGetAttribute(&cus, hipDeviceAttributeMultiprocessorCount, dev);
        if (hipFuncSetAttribute((const void*)fwd_kernel, hipFuncAttributeMaxDynamicSharedMemorySize, LDS_BYTES) != hipSuccess) { fprintf(stderr, "kernel_launch: hipFuncSetAttribute failed\n"); grid = -1; return; }
        if (hipOccupancyMaxActiveBlocksPerMultiprocessor(&per_cu, (const void*)fwd_kernel, 512, LDS_BYTES) != hipSuccess || per_cu < 1) { fprintf(stderr, "kernel_launch: occupancy query failed (%d)\n", per_cu); per_cu = 1; (void)hipGetLastError(); }
        grid = cus * per_cu;
        if (grid <= 0) { grid = -1; return; }
    }
    if (grid < 0) return;
    Args a{};
    for (int i = 0; i < 23; ++i) a.in[i] = (const float*)d_in[i];
    a.out = (float*)d_out; a.ws = (unsigned char*)d_ws;
    void* args[] = {&a};
    if (hipMemsetAsync((unsigned char*)d_ws + WS_BAR, 0, XCD_BAR_WORDS * 4, stream) != hipSuccess) { fprintf(stderr, "kernel_launch: memset of the barrier words failed\n"); return; }
    hipError_t e = hipLaunchCooperativeKernel((const void*)fwd_kernel, dim3(grid), dim3(512), args, LDS_BYTES, stream);
    if (e != hipSuccess) fprintf(stderr, "kernel_launch: cooperative launch failed: %s (grid %d)\n", hipGetErrorString(e), grid);
}
```

```cpp
#include <hip/hip_runtime.h>
#include <hip/hip_cooperative_groups.h>
#include <cstdio>
#include <cstdint>
namespace cg = cooperative_groups;
namespace pg8 {
#define PG8_LAS __attribute__((address_space(3)))
typedef unsigned short bf16_t;
typedef short bf16x8 __attribute__((ext_vector_type(8)));
typedef float f32x4 __attribute__((ext_vector_type(4)));
typedef unsigned u32x4 __attribute__((ext_vector_type(4)));
constexpr int BM = 256, BK = 64, HALF = 128, HTB = HALF * BK * 2  , STAGE_BYTES = 8 * HTB, NXCD = 8, WGM = 8;

__host__ __device__ __forceinline__ int lds_byte(int r, int c) { const int st = (r >> 4) * 2 + (c >> 5), rr = r & 15, cc = c & 31, ob = rr * 64 + cc * 2; return st * 1024 + (ob ^ (((ob >> 9) & 1) << 5)); }
__host__ __device__ __forceinline__ void stage_rc(int b, int& R, int& C) { const int st = b / 1024, sb = b % 1024, swz = sb ^ (((sb >> 9) & 1) << 5); R = (st >> 1) * 16 + swz / 64; C = (st & 1) * 32 + (swz % 64) / 2; }
__host__ __device__ __forceinline__ int perm32(int rho) { const int n = rho >> 4, i = rho & 15; return 8 * (i >> 2) + 4 * n + (i & 3); }

struct Unit { int pm, pn, w; };
struct Gemm { const bf16_t* A; const bf16_t* Bt; int M, N, K; const bf16_t* A2; const bf16_t* Bt2; };

struct StaticOrder {
    int nM, nN, nwg, G, c;
    __host__ __device__ void init(int M, int N, int G_, int c_) { nM = M / BM; nN = N / BM; nwg = nM * nN; G = G_; c = c_; }
    __host__ __device__ bool next(int i, Unit& u) const {
        const long L = (long)i * G + c; if (L >= nwg) return false;
        int wgid = (int)L; { const int q = nwg / NXCD, r = nwg % NXCD, xcd = wgid % NXCD, off = wgid / NXCD; wgid = (xcd < r ? xcd * (q + 1) : r * (q + 1) + (xcd - r) * q) + off; }
        const int nig = WGM * nN, gid = wgid / nig, fm = gid * WGM, gsz = (nM - fm) < WGM ? (nM - fm) : WGM;
        u.pm = fm + ((wgid % nig) % gsz); u.pn = (wgid % nig) / gsz; u.w = 0; return true;
    }
    __device__ __forceinline__ void a_ready(const Unit&) const {}
    __device__ __forceinline__ void done(const Unit&) const {}
};
struct PairOrder : StaticOrder {
    __host__ __device__ bool next(int i, Unit& u) const { if (!StaticOrder::next(i >> 1, u)) return false; u.w = i & 1; return true; }
};
__device__ __forceinline__ unsigned cvt_pk_bf16(float lo, float hi) { unsigned r; asm volatile("v_cvt_pk_bf16_f32 %0, %1, %2" : "=v"(r) : "v"(lo), "v"(hi)); return r; }
typedef float f32x2 __attribute__((ext_vector_type(2)));
template <class Epi, class Sched, bool ALIGN_EPI = false, bool SP2 = false>
__device__ __forceinline__ void gemm_phase(PG8_LAS unsigned char* lds, const Gemm g, const Sched& S, const Epi& E) {
    const int tid = threadIdx.x, wid = __builtin_amdgcn_readfirstlane(tid >> 6), lane = tid & 63, wr = wid >> 2, wc = wid & 3, fr = lane & 15, fq = lane >> 4;
    const int K = g.K, nt = K / BK;
    unsigned voffA[2], voffB[2];
#pragma unroll
    for (int i = 0; i < 2; ++i) { int R, C; stage_rc(tid * 16 + i * 8192, R, C); const int Rb = Epi::PERM ? ((R & ~31) + perm32(R & 31)) : R;
        voffA[i] = (unsigned)(R * K + C) * 2u; voffB[i] = (unsigned)(Rb * K + C) * 2u; }
    const size_t kstep = (size_t)(BK * 2);
    const size_t hstep = (size_t)HALF * K * 2;
    const size_t tstep = 2 * hstep;
    const unsigned ldsw = (unsigned)wid * 1024u;
    const int aoff = lds_byte(wr * 64 + fr, fq * 8), boff = lds_byte(wc * 32 + fr, fq * 8);
#define PG8_SA(b, h) (((b) * 2 + (h)) * HTB)
#define PG8_SB(b, h) ((4 + (b) * 2 + (h)) * HTB)
#define PG8_STAGE(bufoff, gbase, voff) do { _Pragma("unroll") for (int _i = 0; _i < 2; ++_i) \
        __builtin_amdgcn_global_load_lds((const unsigned*)((const char*)(gbase) + (voff)[_i]), (PG8_LAS unsigned*)(lds + (bufoff) + ldsw + _i * 8192), 16, 0, 0); } while (0)
#define PG8_LDA(dst, b, h) do { _Pragma("unroll") for (int m = 0; m < 4; ++m) _Pragma("unroll") for (int k = 0; k < 2; ++k) dst[m][k] = *(const PG8_LAS bf16x8*)(lds + PG8_SA(b, h) + aoff + m * 2048 + k * 1024); } while (0)
#define PG8_LDB(dst, b, h) do { _Pragma("unroll") for (int n = 0; n < 2; ++n) _Pragma("unroll") for (int k = 0; k < 2; ++k) dst[n][k] = *(const PG8_LAS bf16x8*)(lds + PG8_SB(b, h) + boff + n * 2048 + k * 1024); } while (0)
#define PG8_MMA(ai, bj, At, Bt) do { __builtin_amdgcn_s_setprio(1); _Pragma("unroll") for (int m = 0; m < 4; ++m) _Pragma("unroll") for (int n = 0; n < 2; ++n) _Pragma("unroll") for (int k = 0; k < 2; ++k) \
        acc[ai][bj][m][n] = __builtin_amdgcn_mfma_f32_16x16x32_bf16(Bt[n][k], At[m][k], acc[ai][bj][m][n], 0, 0, 0); __builtin_amdgcn_s_setprio(0); } while (0)
#define PG8_WAIT_V(n) asm volatile("s_waitcnt vmcnt(" #n ")" ::: "memory")
#define PG8_WAIT_L(n) asm volatile("s_waitcnt lgkmcnt(" #n ")" ::: "memory")
#define PG8_BAR __builtin_amdgcn_s_barrier()
#define PG8_SCHED __builtin_amdgcn_sched_barrier(0)
    Unit cur, nxt; int ui = 0;
    if (!S.next(0, cur)) return;
    f32x4 acc[2][2][4][2];
#pragma unroll
    for (int a = 0; a < 2; ++a)
#pragma unroll
        for (int b = 0; b < 2; ++b)
#pragma unroll
            for (int m = 0; m < 4; ++m)
#pragma unroll
                for (int n = 0; n < 2; ++n) acc[a][b][m][n] = (f32x4){0.f, 0.f, 0.f, 0.f};
    bf16x8 At[4][2], B0[2][2], B1[2][2];
    const char* cA = (const char*)(cur.w ? g.A2 : g.A) + (size_t)cur.pm * tstep; const char* cB = (const char*)(cur.w ? g.Bt2 : g.Bt) + (size_t)cur.pn * tstep;
    S.a_ready(cur);
    if constexpr (SP2) {
        PG8_STAGE(PG8_SB(0, 0), cB, voffB); PG8_STAGE(PG8_SB(0, 1), cB + hstep, voffB); PG8_STAGE(PG8_SA(0, 0), cA, voffA); PG8_STAGE(PG8_SA(0, 1), cA + hstep, voffA);
        if (wr == 1) PG8_BAR;
        PG8_WAIT_V(2); PG8_BAR;
        PG8_STAGE(PG8_SB(1, 0), cB + kstep, voffB); PG8_STAGE(PG8_SA(1, 0), cA + kstep, voffA); PG8_STAGE(PG8_SB(1, 1), cB + hstep + kstep, voffB);
        PG8_WAIT_V(6); PG8_BAR;
    } else {
        PG8_STAGE(PG8_SB(0, 0), cB, voffB); PG8_STAGE(PG8_SA(0, 0), cA, voffA); PG8_STAGE(PG8_SB(0, 1), cB + hstep, voffB); PG8_STAGE(PG8_SA(0, 1), cA + hstep, voffA);
        if (wr == 1) PG8_BAR;
        PG8_WAIT_V(4); PG8_BAR;
        PG8_STAGE(PG8_SB(1, 0), cB + kstep, voffB); PG8_STAGE(PG8_SA(1, 0), cA + kstep, voffA); PG8_STAGE(PG8_SB(1, 1), cB + hstep + kstep, voffB);
        PG8_WAIT_V(6); PG8_BAR;
    }
    for (;;) {
        const bool has_next = S.next(ui + 1, nxt);
        const char* nA = has_next ? (const char*)(nxt.w ? g.A2 : g.A) + (size_t)nxt.pm * tstep : cA; const char* nB = has_next ? (const char*)(nxt.w ? g.Bt2 : g.Bt) + (size_t)nxt.pn * tstep : cB;
        for (int t = 0; t < nt; t += 2) {
            const bool last = (t == nt - 2);
            const char* a1 = cA + (size_t)(t + 1) * kstep;
            const char* a2 = last ? nA : cA + (size_t)(t + 2) * kstep; const char* b2 = last ? nB : cB + (size_t)(t + 2) * kstep;
            const char* a3 = a2 + kstep; const char* b3 = b2 + kstep;
            if (last && has_next) S.a_ready(nxt);
            if constexpr (SP2) {
            PG8_LDB(B0, 0, 0); PG8_LDB(B1, 0, 1); PG8_SCHED; PG8_LDA(At, 0, 0); PG8_STAGE(PG8_SA(1, 1), a1 + hstep, voffA);
            PG8_WAIT_V(8); PG8_WAIT_L(0); PG8_BAR; PG8_MMA(0, 0, At, B0); PG8_MMA(0, 1, At, B1); PG8_BAR; PG8_SCHED;
            PG8_LDA(At, 0, 1); PG8_STAGE(PG8_SB(0, 0), b2, voffB); PG8_STAGE(PG8_SB(0, 1), b2 + hstep, voffB); PG8_STAGE(PG8_SA(0, 0), a2, voffA);
            PG8_WAIT_V(8); PG8_WAIT_L(0); PG8_BAR; PG8_MMA(1, 0, At, B0); PG8_MMA(1, 1, At, B1); PG8_BAR; PG8_SCHED;
            PG8_LDB(B0, 1, 0); PG8_LDB(B1, 1, 1); PG8_SCHED; PG8_LDA(At, 1, 0); PG8_STAGE(PG8_SA(0, 1), a2 + hstep, voffA);
            PG8_WAIT_V(8); PG8_WAIT_L(0); PG8_BAR; PG8_MMA(0, 0, At, B0); PG8_MMA(0, 1, At, B1); PG8_BAR; PG8_SCHED;
            PG8_LDA(At, 1, 1); PG8_STAGE(PG8_SB(1, 0), b3, voffB); PG8_STAGE(PG8_SB(1, 1), b3 + hstep, voffB); PG8_STAGE(PG8_SA(1, 0), a3, voffA);
            PG8_WAIT_V(8); PG8_WAIT_L(0); PG8_BAR; PG8_MMA(1, 0, At, B0); PG8_MMA(1, 1, At, B1); PG8_BAR; PG8_SCHED;
            } else {
            PG8_LDB(B0, 0, 0); PG8_SCHED; PG8_LDA(At, 0, 0); PG8_STAGE(PG8_SA(1, 1), a1 + hstep, voffA);
            PG8_WAIT_L(8); PG8_BAR; PG8_WAIT_L(0); PG8_MMA(0, 0, At, B0); PG8_BAR; PG8_SCHED;
            PG8_LDB(B1, 0, 1); PG8_STAGE(PG8_SB(0, 0), b2, voffB);
            PG8_BAR; PG8_WAIT_L(0); PG8_MMA(0, 1, At, B1); PG8_BAR;
            PG8_LDA(At, 0, 1); PG8_STAGE(PG8_SA(0, 0), a2, voffA);
            PG8_BAR; PG8_WAIT_L(0); PG8_MMA(1, 0, At, B0); PG8_BAR; PG8_SCHED;
            PG8_STAGE(PG8_SB(0, 1), b2 + hstep, voffB);
            PG8_WAIT_V(6); PG8_BAR; PG8_MMA(1, 1, At, B1); PG8_BAR;
            PG8_LDB(B0, 1, 0); PG8_SCHED; PG8_LDA(At, 1, 0); PG8_STAGE(PG8_SA(0, 1), a2 + hstep, voffA);
            PG8_WAIT_L(8); PG8_BAR; PG8_WAIT_L(0); PG8_MMA(0, 0, At, B0); PG8_BAR; PG8_SCHED;
            PG8_LDB(B1, 1, 1); PG8_STAGE(PG8_SB(1, 0), b3, voffB);
            PG8_BAR; PG8_WAIT_L(0); PG8_MMA(0, 1, At, B1); PG8_BAR;
            PG8_LDA(At, 1, 1); PG8_STAGE(PG8_SA(1, 0), a3, voffA);
            PG8_BAR; PG8_WAIT_L(0); PG8_MMA(1, 0, At, B0); PG8_BAR; PG8_SCHED;
            PG8_STAGE(PG8_SB(1, 1), b3 + hstep, voffB);
            PG8_WAIT_V(6); PG8_BAR; PG8_MMA(1, 1, At, B1); PG8_BAR;
            }
        }
        if constexpr (ALIGN_EPI) { if (wr == 0) PG8_BAR; }
        if constexpr (!Epi::AFTER_DRAIN) { E(acc, cur, wr, wc, fr, fq); S.done(cur); }
        if (!has_next) break;
#pragma unroll
        for (int a = 0; a < 2; ++a)
#pragma unroll
            for (int b = 0; b < 2; ++b)
#pragma unroll
                for (int m = 0; m < 4; ++m)
#pragma unroll
                    for (int n = 0; n < 2; ++n) acc[a][b][m][n] = (f32x4){0.f, 0.f, 0.f, 0.f};
        cur = nxt; cA = nA; cB = nB; ++ui;
        if constexpr (ALIGN_EPI) { if (wr == 1) PG8_BAR; }
    }
    PG8_WAIT_V(0);
    if constexpr (!ALIGN_EPI) { if (wr == 0) PG8_BAR; }
    PG8_BAR;
    if constexpr (Epi::AFTER_DRAIN) { E.fused(acc, cur, wr, wc, fr, fq, lds, wid, lane); S.done(cur); }
#undef PG8_SA
#undef PG8_SB
#undef PG8_STAGE
#undef PG8_LDA
#undef PG8_LDB
#undef PG8_MMA
#undef PG8_WAIT_V
#undef PG8_WAIT_L
#undef PG8_BAR
#undef PG8_SCHED
}
}
#ifndef PG8_SP2
#define PG8_SP2 true
#endif
#ifndef PG8_ALIGN
#define PG8_ALIGN true
#endif

#define LAS __attribute__((address_space(3)))
typedef unsigned short bf16_t;
typedef short bf16x8 __attribute__((ext_vector_type(8)));
typedef short bf16x4 __attribute__((ext_vector_type(4)));
typedef float f32x4 __attribute__((ext_vector_type(4)));
typedef float f32x16 __attribute__((ext_vector_type(16)));
typedef unsigned u32x4 __attribute__((ext_vector_type(4)));
typedef unsigned u32x2 __attribute__((ext_vector_type(2)));

constexpr int MTOK = 16384, DM = 1024, SEQ = 4096, NB = 4;
constexpr size_t MiB = 1u << 20;
constexpr size_t ARR = (size_t)MTOK * DM;
constexpr size_t WS_MODP = 0;
constexpr size_t WS_GATE = 786432;
constexpr size_t WS_AGG = 1 * MiB;
constexpr size_t WS_RSS = 5 * MiB;
constexpr size_t WS_WG = 6 * MiB;
constexpr size_t WS_WPA = 8 * MiB, WS_WPB = 10 * MiB, WS_WO = 12 * MiB, WS_WV = 14 * MiB;
constexpr size_t WS_WIN = 16 * MiB;
constexpr size_t WS_H = 32 * MiB;
constexpr size_t WS_XA = 64 * MiB, WS_ZA = 96 * MiB, WS_Q = 128 * MiB, WS_K = 160 * MiB, WS_ZB = 192 * MiB;
constexpr size_t WS_VT = 224 * MiB;
constexpr size_t WS_BAR = 802816;
constexpr int LDS_CIN = 131072, LDS_SEG = 131072 + 8192;
constexpr int LDS_MISC = 147456, LDS_RPB = 147456 + 256;
constexpr int LDS_BYTES = 147456 + 256 + 3840;

__device__ __forceinline__ float bf2f(unsigned short b) { return __uint_as_float(((unsigned)b) << 16); }
__device__ __forceinline__ unsigned pk2(float lo, float hi) { return pg8::cvt_pk_bf16(lo, hi); }
__device__ __forceinline__ float sigm(float v) { return __builtin_amdgcn_rcpf(1.f + __builtin_amdgcn_exp2f(-1.44269504089f * v)); }
__device__ __forceinline__ float wave_sum(float v) {
#pragma unroll
    for (int o = 1; o < 64; o <<= 1) v += __shfl_xor(v, o);
    return v;
}
#define LDS_WAIT() asm volatile("s_waitcnt lgkmcnt(0)" ::: "memory")

struct EpiProj {
    static constexpr bool PERM = true, AFTER_DRAIN = false;
    bf16_t* O5; bf16_t* OG;
    __device__ __forceinline__ void operator()(const f32x4 (&acc)[2][2][4][2], const pg8::Unit& u, int wr, int wc, int fr, int fq) const {
        const int arr = u.pn >> 2, colt = (u.pn & 3) * 256;
        bf16_t* base = arr < 5 ? O5 + (size_t)arr * ARR : OG + (size_t)(arr - 5) * ARR;
        const int mode = (arr == 1 || arr == 4) ? 1 : (arr >= 5 ? 2 : (arr == 2 ? 3 : 0));
        const int row0 = u.pm * 256 + wr * 64 + fr, col0 = colt + wc * 32 + 8 * fq;
#pragma unroll
        for (int ai = 0; ai < 2; ++ai)
#pragma unroll
            for (int m = 0; m < 4; ++m) { bf16_t* rowp = base + (size_t)(row0 + ai * 128 + m * 16) * DM + col0;
#pragma unroll
                for (int bj = 0; bj < 2; ++bj) { f32x4 v0 = acc[ai][bj][m][0], v1 = acc[ai][bj][m][1];
                    if (mode == 1) {
#pragma unroll
                        for (int j = 0; j < 4; ++j) { v0[j] = v0[j] * sigm(v0[j]); v1[j] = v1[j] * sigm(v1[j]); } }
                    else if (mode == 2) {
#pragma unroll
                        for (int j = 0; j < 4; ++j) { v0[j] = sigm(v0[j]); v1[j] = sigm(v1[j]); } }
                    else if (mode == 3) { v0 = v0 * (0.125f * 1.44269504089f); v1 = v1 * (0.125f * 1.44269504089f); }
                    u32x4 w; w.x = pk2(v0[0], v0[1]); w.y = pk2(v0[2], v0[3]); w.z = pk2(v1[0], v1[1]); w.w = pk2(v1[2], v1[3]);
                    *(u32x4*)(rowp + bj * 128) = w; } }
    }
};
struct EpiPlain {
    static constexpr bool PERM = true, AFTER_DRAIN = false;
    bf16_t* O; int ldc;
    __device__ __forceinline__ void operator()(const f32x4 (&acc)[2][2][4][2], const pg8::Unit& u, int wr, int wc, int fr, int fq) const {
        const int row0 = u.pm * 256 + wr * 64 + fr, col0 = u.pn * 256 + wc * 32 + 8 * fq;
#pragma unroll
        for (int ai = 0; ai < 2; ++ai)
#pragma unroll
            for (int m = 0; m < 4; ++m) { bf16_t* rowp = O + (size_t)(row0 + ai * 128 + m * 16) * ldc + col0;
#pragma unroll
                for (int bj = 0; bj < 2; ++bj) { const f32x4 v0 = acc[ai][bj][m][0], v1 = acc[ai][bj][m][1];
                    u32x4 w; w.x = pk2(v0[0], v0[1]); w.y = pk2(v0[2], v0[3]); w.z = pk2(v1[0], v1[1]); w.w = pk2(v1[2], v1[3]);
                    *(u32x4*)(rowp + bj * 128) = w; } }
    }
};
struct EpiGate2 {
    static constexpr bool PERM = true, AFTER_DRAIN = false;
    const bf16_t* Ga; const bf16_t* Gb; bf16_t* Tb; bf16_t* O;
    __device__ __forceinline__ void operator()(const f32x4 (&acc)[2][2][4][2], const pg8::Unit& u, int wr, int wc, int fr, int fq) const {
        const int row0 = u.pm * 256 + wr * 64 + fr, col0 = u.pn * 256 + wc * 32 + 8 * fq;
        const bf16_t* G = u.w ? Gb : Ga; bf16_t* dst = u.w ? O : Tb;
#pragma unroll
        for (int ai = 0; ai < 2; ++ai) {
            bf16x8 g[4][2], t[4][2];
#pragma unroll
            for (int m = 0; m < 4; ++m)
#pragma unroll
                for (int bj = 0; bj < 2; ++bj) { const size_t off = (size_t)(row0 + ai * 128 + m * 16) * DM + col0 + bj * 128;
                    g[m][bj] = *(const bf16x8*)(G + off);
                    if (u.w) t[m][bj] = *(const bf16x8*)(Tb + off); else t[m][bj] = (bf16x8){0, 0, 0, 0, 0, 0, 0, 0}; }
            asm volatile("" ::: "memory");
#pragma unroll
            for (int m = 0; m < 4; ++m)
#pragma unroll
                for (int bj = 0; bj < 2; ++bj) { const size_t off = (size_t)(row0 + ai * 128 + m * 16) * DM + col0 + bj * 128;
                    const f32x4 v0 = acc[ai][bj][m][0], v1 = acc[ai][bj][m][1];
                    float o[8];
#pragma unroll
                    for (int j = 0; j < 4; ++j) { o[j] = fmaf(bf2f((unsigned short)g[m][bj][j]), v0[j], bf2f((unsigned short)t[m][bj][j])); o[4 + j] = fmaf(bf2f((unsigned short)g[m][bj][4 + j]), v1[j], bf2f((unsigned short)t[m][bj][4 + j])); }
                    u32x4 w; w.x = pk2(o[0], o[1]); w.y = pk2(o[2], o[3]); w.z = pk2(o[4], o[5]); w.w = pk2(o[6], o[7]);
                    *(u32x4*)(dst + off) = w; }
            asm volatile("" ::: "memory");
        }
    }
};
struct EpiOut {
    static constexpr bool PERM = true, AFTER_DRAIN = false;
    const float* gate; bf16_t* O;
    __device__ __forceinline__ void operator()(const f32x4 (&acc)[2][2][4][2], const pg8::Unit& u, int wr, int wc, int fr, int fq) const {
        const int row0 = u.pm * 256 + wr * 64 + fr, col0 = u.pn * 256 + wc * 32 + 8 * fq;
        const float* gp = gate + (size_t)(u.pm >> 4) * DM + col0;
        f32x4 gv[2][2];
#pragma unroll
        for (int bj = 0; bj < 2; ++bj)
#pragma unroll
            for (int n = 0; n < 2; ++n) gv[bj][n] = *(const f32x4*)(gp + bj * 128 + n * 4);
#pragma unroll
        for (int ai = 0; ai < 2; ++ai)
#pragma unroll
            for (int m = 0; m < 4; ++m) { bf16_t* rowp = O + (size_t)(row0 + ai * 128 + m * 16) * DM + col0;
#pragma unroll
                for (int bj = 0; bj < 2; ++bj) { const f32x4 v0 = gv[bj][0] * acc[ai][bj][m][0], v1 = gv[bj][1] * acc[ai][bj][m][1];
                    u32x4 w; w.x = pk2(v0[0], v0[1]); w.y = pk2(v0[2], v0[3]); w.z = pk2(v1[0], v1[1]); w.w = pk2(v1[2], v1[3]);
                    *(u32x4*)(rowp + bj * 128) = w; } }
    }
};

__device__ __forceinline__ void p0_transpose_item(const float* W, int K, int N, bf16_t* WT, int dst_row0, int k0, int n0, LAS float* scr, int lane) {
#pragma unroll 8
    for (int i = 0; i < 32; ++i) { const int kk = 2 * i + (lane >> 5); scr[kk * 33 + (lane & 31)] = W[(size_t)(k0 + kk) * N + n0 + (lane & 31)]; }
    LDS_WAIT(); asm volatile("" ::: "memory");
    const int c = lane & 7;
#pragma unroll
    for (int j = 0; j < 4; ++j) { const int n = (lane >> 3) + 8 * j; const LAS float* s = scr + (8 * c) * 33 + n;
        u32x4 o; o.x = pk2(s[0 * 33], s[1 * 33]); o.y = pk2(s[2 * 33], s[3 * 33]); o.z = pk2(s[4 * 33], s[5 * 33]); o.w = pk2(s[6 * 33], s[7 * 33]);
        *(u32x4*)(WT + (size_t)(dst_row0 + n) * K + k0 + 8 * c) = o; }
    LDS_WAIT(); asm volatile("" ::: "memory");
}

struct Args { const float* in[23]; float* out; unsigned char* ws; };

__device__ __forceinline__ void p0_prologue(const Args& a, LAS unsigned char* lds, int gw, int NGW, int wave, int lane) {
    LAS float* scr = (LAS float*)(lds + wave * 16384);
    unsigned char* ws = a.ws;
    const float* c = a.in[1]; const float* w_c = a.in[3]; const float* w_in = a.in[5];
    float* modp = (float*)(ws + WS_MODP);
    constexpr int I_MOD = 768, I_IN = 16 * 256, I_SQ = 16 * 32, I_G = 4 * 16 * 2;
    constexpr int NITEMS = I_MOD + I_IN + 3 * I_SQ + I_G;
    for (int it = gw; it < NITEMS; it += NGW) {
        int r = it;
        if (r < I_MOD) {
            const int cgi = r % 48, kc = r / 48, col = cgi * 64 + lane, k0 = kc * 64;
            float sv[4];
#pragma unroll
            for (int b = 0; b < 4; ++b) { const float cv = c[b * DM + k0 + lane]; sv[b] = cv * sigm(cv); }
            float acc[4] = {0.f, 0.f, 0.f, 0.f};
#pragma unroll 8
            for (int kk = 0; kk < 64; ++kk) { const float w = w_c[(size_t)(k0 + kk) * 3072 + col];
#pragma unroll
                for (int b = 0; b < 4; ++b) acc[b] += __shfl(sv[b], kk) * w; }
#pragma unroll
            for (int b = 0; b < 4; ++b) modp[(size_t)(kc * 4 + b) * 3072 + col] = acc[b];
            continue;
        }
        r -= I_MOD;
        if (r < I_IN) { const int kb = r / 256, nb = r % 256, n0 = nb * 32, cb = n0 >> 10;
            if (cb == 4) p0_transpose_item(w_in, 1024, 8192, (bf16_t*)(ws + WS_WV), n0 - 4096, kb * 64, n0, scr, lane);
            else p0_transpose_item(w_in, 1024, 8192, (bf16_t*)(ws + WS_WIN), (cb < 4 ? cb : cb - 1) * 1024 + (n0 & 1023), kb * 64, n0, scr, lane);
            continue; }
        r -= I_IN;
        if (r < 3 * I_SQ) { const int which = r / I_SQ, rr = r % I_SQ, kb = rr / 32, nb = rr % 32;
            const float* W = which == 0 ? a.in[19] : (which == 1 ? a.in[20] : a.in[21]);
            bf16_t* WT = (bf16_t*)(ws + (which == 0 ? WS_WPA : (which == 1 ? WS_WPB : WS_WO)));
            p0_transpose_item(W, 1024, 1024, WT, nb * 32, kb * 64, nb * 32, scr, lane);
            continue; }
        r -= 3 * I_SQ;
        { const int g = r / 32, rr = r % 32, hb = rr / 2, nb = rr % 2;
            const float* W = (g == 0 ? a.in[8] : (g == 1 ? a.in[10] : (g == 2 ? a.in[13] : a.in[15]))) + (size_t)hb * 4096;
            bf16_t* WT = (bf16_t*)(ws + WS_WG) + (size_t)(g * 16 + hb) * 4096;
            p0_transpose_item(W, 64, 64, WT, nb * 32, 0, nb * 32, scr, lane); }
    }
}

__device__ __forceinline__ void p1_hpass(const Args& a, LAS unsigned char* lds, int G, int tid, int wave, int lane) {
    unsigned char* ws = a.ws;
    const float* x = a.in[0]; const float* g_pre = a.in[2]; const float* b_c = a.in[4];
    const float* modp = (const float*)(ws + WS_MODP);
    bf16_t* H = (bf16_t*)(ws + WS_H);
    LAS float* sh = (LAS float*)lds;
    for (int rb = blockIdx.x; rb < MTOK / 64; rb += G) {
        const int b = rb >> 6;
        __syncthreads();
        for (int idx = tid; idx < 2048; idx += 512) { float s = b_c[idx];
#pragma unroll
            for (int kc = 0; kc < 16; ++kc) s += modp[(size_t)(kc * 4 + b) * 3072 + idx];
            sh[idx] = idx < 1024 ? s : 1.f + s; }
        __syncthreads();
        for (int rr = wave; rr < 64; rr += 8) { const int row = rb * 64 + rr;
            const f32x4* xr = (const f32x4*)(x + (size_t)row * DM) + lane;
            f32x4 v[4]; float s = 0.f;
#pragma unroll
            for (int j = 0; j < 4; ++j) { v[j] = xr[64 * j]; s += (v[j][0] * v[j][0] + v[j][1] * v[j][1]) + (v[j][2] * v[j][2] + v[j][3] * v[j][3]); }
            const float rstd = __builtin_amdgcn_rsqf(wave_sum(s) * (1.f / 1024.f) + 1e-6f);
#pragma unroll
            for (int j = 0; j < 4; ++j) { const int col = 4 * lane + 256 * j;
                const f32x4 g = *(const f32x4*)(g_pre + col); const f32x4 sc = *(const LAS f32x4*)(sh + 1024 + col); const f32x4 sf = *(const LAS f32x4*)(sh + col);
                const f32x4 o = (v[j] * rstd) * g * sc + sf;
                u32x2 w; w.x = pk2(o[0], o[1]); w.y = pk2(o[2], o[3]);
                *(u32x2*)(H + (size_t)row * DM + col) = w; }
        }
    }
    float* gate = (float*)(ws + WS_GATE);
    for (int idx = blockIdx.x * 512 + tid; idx < 4096; idx += G * 512) { const int b = idx >> 10, col = idx & 1023; float s = b_c[2048 + col];
#pragma unroll
        for (int kc = 0; kc < 16; ++kc) s += modp[(size_t)(kc * 4 + b) * 3072 + 2048 + col];
        gate[idx] = s; }
}

__device__ __forceinline__ int attn_fk(int col) { return ((col >> 1) & 1) | (((col >> 3) & 3) << 1); }
__device__ __forceinline__ void attn_phase(const bf16_t* Q, const bf16_t* Kb, const bf16_t* VT, const bf16_t* ZB, const float* rpb, bf16_t* YB, LAS unsigned char* lds, int vcu, int G, int tid, int wave, int lane) {
    const int fr = lane & 15, fq = lane >> 4;
    constexpr float L2E = 1.44269504089f;
    LAS float* rpbL = (LAS float*)(lds + LDS_RPB);
    const int rsel = wave >> 2, j = wave & 3;
    const int cs = min(max(16 * j - 8, 0), 32);
    const int qc = 16 * j + fr, c0 = min(max(qc - 8, 0), 48);
    const int lcol = tid >> 3, lch = tid & 7;
    float maskadd[8];
#pragma unroll
    for (int e = 0; e < 8; ++e) { const int kcol = cs + 8 * fq + e; maskadd[e] = ((kcol >= c0) && (kcol < c0 + 16)) ? 0.f : -1e30f; }
    const int rpoff = cs + 8 * fq - qc + 31;
    for (int u = vcu; u < 256; u += G) {
        const int band = u & 3, h = (u >> 2) & 15, b = u >> 6, R0 = band * 16;
        __syncthreads();
        for (int i = tid; i < 15 * 64; i += 512) { const int dr = i >> 6, dc = (i & 63) - 16; rpbL[i] = (dc >= 0 && dc < 31) ? rpb[(size_t)(h * 15 + dr) * 31 + dc] * L2E : 0.f; }
        int loaded_hi = -1;
#pragma unroll 1
        for (int ss = 0; ss < 8; ++ss) {
            const int r = R0 + 2 * ss;
            const int lo = min(max(r - 4, 0), 56), hi = min(max(r - 3, 0), 56) + 7;
            const int first = loaded_hi < 0 ? lo : loaded_hi + 1;
            if (ss > 0) __syncthreads();
            {
                u32x4 kv[9], vv[9];
#pragma unroll
                for (int k = 0; k < 9; ++k) { const int row = first + k;
                    if (row <= hi) { const size_t tokrow = (size_t)b * SEQ + (size_t)row * 64;
                        kv[k] = *(const u32x4*)(Kb + (tokrow + lcol) * DM + h * 64 + lch * 8);
                        vv[k] = *(const u32x4*)(VT + (size_t)(h * 64 + lcol) * MTOK + tokrow + lch * 8); } }
#pragma unroll
                for (int k = 0; k < 9; ++k) { const int row = first + k;
                    if (row <= hi) { const int slot = row % 9;
                        *(LAS u32x4*)(lds + slot * 16384 + lcol * 128 + ((lch ^ attn_fk(lcol)) << 4)) = kv[k];
                        *(LAS u32x4*)(lds + slot * 16384 + 8192 + lcol * 128 + ((lch ^ ((lcol >> 1) & 7)) << 4)) = vv[k]; } }
            }
            loaded_hi = hi;
            __syncthreads();
            const int ro = r + rsel, r0 = min(max(ro - 4, 0), 56);
            const size_t tokq = (size_t)b * SEQ + ro * 64 + qc;
            bf16x8 qf[2];
#pragma unroll
            for (int ks = 0; ks < 2; ++ks) qf[ks] = *(const bf16x8*)(Q + tokq * DM + h * 64 + ks * 32 + fq * 8);
            f32x4 s[8][2];
            float mx = -1e30f;
#pragma unroll
            for (int w = 0; w < 8; ++w) { const int slot = (r0 + w) % 9; const LAS float* rp = rpbL + (r0 + w - ro + 7) * 64 + rpoff;
#pragma unroll
                for (int t = 0; t < 2; ++t) { const int kc = cs + 8 * (fr >> 2) + (fr & 3) + 4 * t; const int fk = attn_fk(kc);
                    f32x4 acc;
#pragma unroll
                    for (int i = 0; i < 4; ++i) acc[i] = rp[4 * t + i] + maskadd[4 * t + i];
#pragma unroll
                    for (int ks = 0; ks < 2; ++ks) { const bf16x8 kf = *(const LAS bf16x8*)(lds + slot * 16384 + kc * 128 + (((ks * 4 + fq) ^ fk) << 4));
                        acc = __builtin_amdgcn_mfma_f32_16x16x32_bf16(kf, qf[ks], acc, 0, 0, 0); }
                    s[w][t] = acc;
                    mx = fmaxf(fmaxf(mx, fmaxf(acc[0], acc[1])), fmaxf(acc[2], acc[3])); } }
            mx = fmaxf(mx, __shfl_xor(mx, 16)); mx = fmaxf(mx, __shfl_xor(mx, 32));
            float sum = 0.f; bf16x8 pf[8];
#pragma unroll
            for (int w = 0; w < 8; ++w) { float p[8];
#pragma unroll
                for (int t = 0; t < 2; ++t)
#pragma unroll
                    for (int i = 0; i < 4; ++i) { const float e = __builtin_amdgcn_exp2f(s[w][t][i] - mx); p[4 * t + i] = e; sum += e; }
                u32x4 pw; pw.x = pk2(p[0], p[1]); pw.y = pk2(p[2], p[3]); pw.z = pk2(p[4], p[5]); pw.w = pk2(p[6], p[7]);
                pf[w] = __builtin_bit_cast(bf16x8, pw); }
            sum += __shfl_xor(sum, 16); sum += __shfl_xor(sum, 32);
            const float inv = 1.f / sum;
            f32x4 o[4];
#pragma unroll
            for (int dt = 0; dt < 4; ++dt) o[dt] = (f32x4){0.f, 0.f, 0.f, 0.f};
#pragma unroll
            for (int w = 0; w < 8; ++w) { const int slot = (r0 + w) % 9;
#pragma unroll
                for (int dt = 0; dt < 4; ++dt) { const int d = dt * 16 + fr;
                    const bf16x8 vf = *(const LAS bf16x8*)(lds + slot * 16384 + 8192 + d * 128 + ((((cs >> 3) + fq) ^ ((d >> 1) & 7)) << 4));
                    o[dt] = __builtin_amdgcn_mfma_f32_16x16x32_bf16(vf, pf[w], o[dt], 0, 0, 0); } }
#pragma unroll
            for (int dt = 0; dt < 4; ++dt) { const size_t off = tokq * DM + h * 64 + dt * 16 + 4 * fq;
                const bf16x4 z = *(const bf16x4*)(ZB + off);
                u32x2 w; w.x = pk2(o[dt][0] * inv * bf2f((unsigned short)z[0]), o[dt][1] * inv * bf2f((unsigned short)z[1]));
                w.y = pk2(o[dt][2] * inv * bf2f((unsigned short)z[2]), o[dt][3] * inv * bf2f((unsigned short)z[3]));
                *(u32x2*)(YB + off) = w; }
        }
    }
    __syncthreads();
}

template <bool FINAL, int DIR>
__device__ __forceinline__ void scan_dir(const LAS bf16x8* afrL, int lane, int ct, const bf16_t* WGr, const bf16_t* WGi, float br, float bi, float cl, float Hin,
                                         const bf16x8 (&idf)[2], float& Aout, float& Uout, const bf16_t* ZAp, bf16_t* YAp, unsigned (&hp)[4][8]) {
    const int n = lane & 31, hf = lane >> 5;
    bf16x8 Br[4], Bi[4];
#pragma unroll
    for (int kk = 0; kk < 4; ++kk) { Br[kk] = *(const bf16x8*)(WGr + (size_t)(32 * ct + n) * 64 + 16 * kk + 8 * hf); Bi[kk] = *(const bf16x8*)(WGi + (size_t)(32 * ct + n) * 64 + 16 * kk + 8 * hf); }
    float H = Hin, Ap = 1.f;
#pragma unroll
    for (int si = 0; si < 4; ++si) { const int s = DIR ? 3 - si : si;
        __builtin_amdgcn_sched_barrier(0);
        f32x16 ar, ai, ax;
#pragma unroll
        for (int e = 0; e < 16; ++e) { ar[e] = 0.f; ai[e] = 0.f; ax[e] = 0.f; }
#pragma unroll
        for (int kk = 0; kk < 4; ++kk) { const bf16x8 av = afrL[(s * 4 + kk) * 64 + lane];
            ar = __builtin_amdgcn_mfma_f32_32x32x16_bf16(av, Br[kk], ar, 0, 0, 0); ai = __builtin_amdgcn_mfma_f32_32x32x16_bf16(av, Bi[kk], ai, 0, 0, 0); }
        { const bf16x8 a0 = afrL[(s * 4 + 2 * ct) * 64 + lane], a1 = afrL[(s * 4 + 2 * ct + 1) * 64 + lane];
            ax = __builtin_amdgcn_mfma_f32_32x32x16_bf16(a0, idf[0], ax, 0, 0, 0); ax = __builtin_amdgcn_mfma_f32_32x32x16_bf16(a1, idf[1], ax, 0, 0, 0); }
        const bf16_t* zs = ZAp + (size_t)(16 * s) * DM; bf16_t* ys = YAp + (size_t)(16 * s) * DM;
        float hv[16];
#pragma unroll
        for (int ei = 0; ei < 16; ++ei) { const int e = DIR ? 15 - ei : ei;
            const float er = 1.f + __builtin_amdgcn_exp2f(fminf(-1.44269504089f * (ar[e] + br), 60.f)), ei2 = 1.f + __builtin_amdgcn_exp2f(fminf(-1.44269504089f * (ai[e] + bi), 60.f));
            const float inv2 = __builtin_amdgcn_rcpf(er * ei2); const float r = ei2 * inv2, ig = er * inv2;
            const float av = __builtin_amdgcn_exp2f(cl * r);
            const float om = fmaxf(fmaf(-av, av, 1.f), 0.f);
            const float u = __builtin_amdgcn_sqrtf(om) * (ig * ax[e]);
            H = fmaf(av, H, u);
            hv[e] = H;
            if (!FINAL) Ap *= av; }
        if (FINAL) {
            if (DIR == 0) {
#pragma unroll
                for (int e2 = 0; e2 < 8; ++e2) hp[s][e2] = pk2(hv[2 * e2], hv[2 * e2 + 1]);
            } else {
#pragma unroll
                for (int e2 = 0; e2 < 8; ++e2) { const unsigned pw = hp[s][e2];
                    const float y0 = (hv[2 * e2] + __uint_as_float(pw << 16)) * bf2f(zs[(size_t)(2 * e2) * DM]);
                    const float y1 = (hv[2 * e2 + 1] + __uint_as_float(pw & 0xffff0000u)) * bf2f(zs[(size_t)(2 * e2 + 1) * DM]);
                    const unsigned yw = pk2(y0, y1);
                    ys[(size_t)(2 * e2) * DM] = (bf16_t)(yw & 0xffffu); ys[(size_t)(2 * e2 + 1) * DM] = (bf16_t)(yw >> 16); }
            }
        }
    }
    Aout = Ap; Uout = H;
}

template <bool FINAL>
__device__ __forceinline__ void scan_phase(const Args& a, LAS unsigned char* lds, int gw, int NGW, int wave, int lane) {
    unsigned char* ws = a.ws;
    const bf16_t* XA = (const bf16_t*)(ws + WS_XA); const bf16_t* ZA = (const bf16_t*)(ws + WS_ZA);
    const bf16_t* WG = (const bf16_t*)(ws + WS_WG);
    const float* conv_w = a.in[6]; const float* conv_b = a.in[7];
    typedef float f32x2 __attribute__((ext_vector_type(2)));
    f32x2* AGG = (f32x2*)(ws + WS_AGG);
    bf16_t* YA = (bf16_t*)(ws + WS_H);
    LAS bf16x8* afrL = (LAS bf16x8*)(lds + wave * 16384);
    const int n = lane & 31, hf = lane >> 5;
    bf16x8 idf[2];
#pragma unroll
    for (int k2 = 0; k2 < 2; ++k2)
#pragma unroll
        for (int jj = 0; jj < 8; ++jj) idf[k2][jj] = (16 * k2 + 8 * hf + jj == n) ? (short)0x3F80 : (short)0;
    for (int wt = gw; wt < 2048; wt += NGW) {
        const int cp = wt & 31, jb = (wt >> 5) & 15, b = wt >> 9, ch0 = jb * 64;
        { const int a_half = (n >> 2) & 1, a_idx = (n & 3) + 4 * (n >> 3), a_chunk = 2 * cp + a_half;
#pragma unroll 1
          for (int kk = 0; kk < 4; ++kk) { const int ch = ch0 + 16 * kk + 8 * hf;
              float cw[4][8], cb[8];
#pragma unroll
              for (int w = 0; w < 4; ++w) { const f32x4 c0 = *(const f32x4*)(conv_w + w * DM + ch), c1 = *(const f32x4*)(conv_w + w * DM + ch + 4);
#pragma unroll
                  for (int jj = 0; jj < 4; ++jj) { cw[w][jj] = c0[jj]; cw[w][4 + jj] = c1[jj]; } }
              { const f32x4 c0 = *(const f32x4*)(conv_b + ch), c1 = *(const f32x4*)(conv_b + ch + 4);
#pragma unroll
                  for (int jj = 0; jj < 4; ++jj) { cb[jj] = c0[jj]; cb[4 + jj] = c1[jj]; } }
#pragma unroll
              for (int s = 0; s < 4; ++s) { const int p = a_chunk * 64 + 16 * s + a_idx;
                  float acc[8];
#pragma unroll
                  for (int jj = 0; jj < 8; ++jj) acc[jj] = cb[jj];
#pragma unroll
                  for (int w = 0; w < 4; ++w) { const int pp = p + w - 2; const bool ok = (pp >= 0) && (pp < SEQ); const int pc = min(max(pp, 0), SEQ - 1);
                      const bf16x8 xv = *(const bf16x8*)(XA + ((size_t)b * SEQ + pc) * DM + ch);
#pragma unroll
                      for (int jj = 0; jj < 8; ++jj) acc[jj] = fmaf(cw[w][jj], ok ? bf2f((unsigned short)xv[jj]) : 0.f, acc[jj]); }
                  u32x4 pw; pw.x = pk2(acc[0], acc[1]); pw.y = pk2(acc[2], acc[3]); pw.z = pk2(acc[4], acc[5]); pw.w = pk2(acc[6], acc[7]);
                  afrL[(s * 4 + kk) * 64 + lane] = __builtin_bit_cast(bf16x8, pw); } } }
        LDS_WAIT(); asm volatile("" ::: "memory");
        const int chunk = 2 * cp + hf;
        if (FINAL) {
            const int tid = threadIdx.x, pdir = tid >> 8, pseg = (tid >> 6) & 3, pch = tid & 63, q = cp >> 3;
            LAS f32x2* segL = (LAS f32x2*)(lds + LDS_SEG);
            LAS float* cinL = (LAS float*)(lds + LDS_CIN);
            f32x2 g[16];
#pragma unroll
            for (int i = 0; i < 16; ++i) g[i] = AGG[((size_t)(b * 2 + pdir) * 64 + 16 * pseg + i) * DM + ch0 + pch];
            float As = 1.f, Us = 0.f;
#pragma unroll
            for (int ii = 0; ii < 16; ++ii) { const int i = pdir ? 15 - ii : ii; Us = fmaf(g[i][0], Us, g[i][1]); As *= g[i][0]; }
            __syncthreads();
            segL[(pdir * 4 + pseg) * 64 + pch] = (f32x2){As, Us};
            __syncthreads();
            if (pseg == q) { float Hc = 0.f;
                if (pdir == 0) { for (int s2 = 0; s2 < pseg; ++s2) { const f32x2 sg = segL[(0 * 4 + s2) * 64 + pch]; Hc = fmaf(sg[0], Hc, sg[1]); } }
                else { for (int s2 = 3; s2 > pseg; --s2) { const f32x2 sg = segL[(1 * 4 + s2) * 64 + pch]; Hc = fmaf(sg[0], Hc, sg[1]); } }
#pragma unroll
                for (int ii = 0; ii < 16; ++ii) { const int i = pdir ? 15 - ii : ii; cinL[(pdir * 16 + i) * 64 + pch] = Hc; Hc = fmaf(g[i][0], Hc, g[i][1]); } }
            __syncthreads();
        }
#pragma unroll 1
        for (int ct = 0; ct < 2; ++ct) { const int ch = ch0 + 32 * ct + n;
            float Af, Uf, Ab, Ub;
            unsigned hp[4][8];
            {
                const float br = a.in[9][ch], bi = a.in[11][ch]; const float lam = a.in[12][ch];
                const float cl = -8.f * 1.44269504089f * log1pf(expf(-lam));
                float Hin = 0.f;
                if (FINAL) Hin = ((const LAS float*)(lds + LDS_CIN))[(0 * 16 + (chunk & 15)) * 64 + 32 * ct + n];
                scan_dir<FINAL, 0>(afrL, lane, ct, WG + (size_t)(0 * 16 + jb) * 4096, WG + (size_t)(1 * 16 + jb) * 4096, br, bi, cl, Hin, idf, Af, Uf, ZA + ((size_t)b * SEQ + chunk * 64) * DM + ch, YA + ((size_t)b * SEQ + chunk * 64) * DM + ch, hp);
            }
            {
                const float br = a.in[14][ch], bi = a.in[16][ch]; const float lam = a.in[17][ch];
                const float cl = -8.f * 1.44269504089f * log1pf(expf(-lam));
                float Hin = 0.f;
                if (FINAL) Hin = ((const LAS float*)(lds + LDS_CIN))[(1 * 16 + (chunk & 15)) * 64 + 32 * ct + n];
                scan_dir<FINAL, 1>(afrL, lane, ct, WG + (size_t)(2 * 16 + jb) * 4096, WG + (size_t)(3 * 16 + jb) * 4096, br, bi, cl, Hin, idf, Ab, Ub, ZA + ((size_t)b * SEQ + chunk * 64) * DM + ch, YA + ((size_t)b * SEQ + chunk * 64) * DM + ch, hp);
            }
            if (!FINAL) {
                AGG[((size_t)(b * 2 + 0) * 64 + chunk) * DM + ch] = (f32x2){Af, Uf};
                AGG[((size_t)(b * 2 + 1) * 64 + chunk) * DM + ch] = (f32x2){Ab, Ub};
            }
        }
        LDS_WAIT(); asm volatile("" ::: "memory");
    }
}

__device__ __forceinline__ void final_norm(const Args& a, int gw, int NGW, int lane) {
    const float* x = a.in[0]; const float* g_final = a.in[22]; float* out = a.out;
    f32x4 g[4];
#pragma unroll
    for (int j = 0; j < 4; ++j) g[j] = *((const f32x4*)g_final + lane + 64 * j);
    for (int row = gw; row < MTOK; row += NGW) {
        f32x4* orow = (f32x4*)(out + (size_t)row * DM) + lane; const f32x4* xrow = (const f32x4*)(x + (size_t)row * DM) + lane;
        const bf16x4* brow = (const bf16x4*)((const bf16_t*)(a.ws + WS_ZB) + (size_t)row * DM) + lane;
        f32x4 v[4]; float ss = 0.f;
#pragma unroll
        for (int j = 0; j < 4; ++j) { const bf16x4 bb = brow[64 * j]; v[j] = xrow[64 * j];
            v[j][0] += bf2f((unsigned short)bb[0]); v[j][1] += bf2f((unsigned short)bb[1]); v[j][2] += bf2f((unsigned short)bb[2]); v[j][3] += bf2f((unsigned short)bb[3]);
            ss += (v[j][0] * v[j][0] + v[j][1] * v[j][1]) + (v[j][2] * v[j][2] + v[j][3] * v[j][3]); }
        const float rstd = __builtin_amdgcn_rsqf(wave_sum(ss) * (1.f / 1024.f) + 1e-6f);
#pragma unroll
        for (int j = 0; j < 4; ++j) orow[64 * j] = v[j] * rstd * g[j];
    }
}

#define XB_TMO      128
#define XB_XCNT(j)  (256  + 64 * (j))
#define XB_XSUB(j)  (1280 + 64 * (j))
#define XB_XGEN(j)  (2304 + 64 * (j))
#define XB_TOP      3328
#define XB_TOPGEN   3392
#define XCD_BAR_WORDS 3456
#define XB_SPIN_CAP (1u << 18)
__device__ __forceinline__ unsigned xb_ld(unsigned* p)              { return __hip_atomic_load(p, __ATOMIC_RELAXED, __HIP_MEMORY_SCOPE_AGENT); }
__device__ __forceinline__ unsigned xb_add(unsigned* p, unsigned v) { return __hip_atomic_fetch_add(p, v, __ATOMIC_RELAXED, __HIP_MEMORY_SCOPE_AGENT); }
__device__ __forceinline__ unsigned xb_xcc_id() { return (unsigned)__builtin_amdgcn_s_getreg((3 << 11) | 20) & 0xFu; }
#define XB_SPIN(cond, bar) do { unsigned _sp = 0; while (cond) { __builtin_amdgcn_s_sleep(1); \
    if ((++_sp & 255u) == 0u) { if (xb_ld(&(bar)[XB_TMO])) break; if (_sp > XB_SPIN_CAP) { atomicAdd(&(bar)[XB_TMO], 1u); break; } } } } while (0)
struct XcdBarrier { unsigned* bar; unsigned x; volatile LAS unsigned* st; };
__device__ __forceinline__ XcdBarrier xcd_barrier_post(unsigned* bar, volatile LAS unsigned* st) {
    XcdBarrier b; b.bar = bar; b.x = xb_xcc_id(); b.st = st;
    if (threadIdx.x == 0) (void)xb_add(&bar[XB_XCNT(b.x)], 1u);
    return b;
}
__device__ __forceinline__ void xcd_barrier_complete(unsigned* bar, unsigned x, unsigned& nloc, unsigned& nx) {
    const unsigned G = gridDim.x * gridDim.y * gridDim.z;
    unsigned sum, cnt, mine, sp = 0u;
    for (;;) {
        sum = 0u; cnt = 0u; mine = 0u;
#pragma unroll
        for (unsigned j = 0; j < 16; ++j) { const unsigned c = xb_ld(&bar[XB_XCNT(j)]); sum += c; cnt += (c > 0u) ? 1u : 0u; mine = (j == x) ? c : mine; }
        if (sum == G) break;
        __builtin_amdgcn_s_sleep(1);
        if ((++sp & 255u) == 0u) { if (xb_ld(&bar[XB_TMO])) break; if (sp > XB_SPIN_CAP) { atomicAdd(&bar[XB_TMO], 1u); break; } }
    }
    nloc = mine > 0u ? mine : 1u; nx = cnt > 0u ? cnt : 1u;
}
__device__ __forceinline__ void xcd_barrier(const XcdBarrier& b) {
    asm volatile("s_waitcnt vmcnt(0)" ::: "memory");
    __syncthreads();
    if (threadIdx.x == 0) {
        unsigned* bar = b.bar;
        __builtin_amdgcn_s_waitcnt(0);
        unsigned nloc = b.st[0], nx = b.st[1];
        if (nloc == 0u) { xcd_barrier_complete(bar, b.x, nloc, nx); b.st[0] = nloc; b.st[1] = nx; }
        const unsigned old = xb_add(&bar[XB_XSUB(b.x)], 1u);
        const unsigned gen = old / nloc;
        if (old + 1u == (gen + 1u) * nloc) {
            __builtin_amdgcn_fence(__ATOMIC_RELEASE, "agent");
            asm volatile("s_waitcnt vmcnt(0)" ::: "memory");
            const unsigned og = xb_add(&bar[XB_TOP], 1u);
            const unsigned tg = og / nx;
            if (og + 1u == (tg + 1u) * nx) xb_add(&bar[XB_TOPGEN], 1u);
            else XB_SPIN(xb_ld(&bar[XB_TOPGEN]) == tg, bar);
            __builtin_amdgcn_fence(__ATOMIC_ACQUIRE, "agent");
            xb_add(&bar[XB_XGEN(b.x)], 1u);
            asm volatile("s_waitcnt vmcnt(0)" ::: "memory");
        } else {
            XB_SPIN(xb_ld(&bar[XB_XGEN(b.x)]) == gen, bar);
            __builtin_amdgcn_fence(__ATOMIC_ACQUIRE, "agent");
            asm volatile("s_waitcnt vmcnt(0)" ::: "memory");
        }
    }
    __syncthreads();
}

__global__ void __launch_bounds__(512, 2) fwd_kernel(Args a) {
    extern __shared__ __attribute__((aligned(16))) unsigned char lds_raw[];
    LAS unsigned char* lds = (LAS unsigned char*)lds_raw;
    cg::grid_group grid = cg::this_grid();
    const int tid = threadIdx.x, lane = tid & 63, wave = __builtin_amdgcn_readfirstlane(tid >> 6);
    const int G = gridDim.x, bx = blockIdx.x;
    const int vcu = (G % 8 == 0) ? (bx % 8) * (G / 8) + bx / 8 : bx;
    const int gw = bx * 8 + wave, NGW = G * 8;
    unsigned char* ws = a.ws;
#ifdef PROBE_A0
    unsigned long long tA0 = 0, tA1 = 0, tB0 = 0, tB1 = 0;
#define STAMP(k) do { const unsigned long long _t = __builtin_amdgcn_s_memrealtime(); if ((k) == PROBE_A0) tA0 = _t; if ((k) == PROBE_A1) tA1 = _t; if ((k) == PROBE_B0) tB0 = _t; if ((k) == PROBE_B1) tB1 = _t; } while (0)
#else
#define STAMP(k) do {} while (0)
#endif
    STAMP(0);
    unsigned* barw = (unsigned*)(ws + WS_BAR);
    if (tid < 4) ((volatile LAS unsigned*)(lds + LDS_MISC))[tid] = 0u;
    __syncthreads();
    XcdBarrier xb = xcd_barrier_post(barw, (volatile LAS unsigned*)(lds + LDS_MISC));
    if (a.ws == nullptr) grid.sync();

#define PH(k) (!defined(ONLY) || ONLY == (k))
#if !defined(ONLY) || ONLY == 0
    p0_prologue(a, lds, gw, NGW, wave, lane);
#endif
    STAMP(1);
    xcd_barrier(xb);
    STAMP(2);
#if !defined(ONLY) || ONLY == 1
    p1_hpass(a, lds, G, tid, wave, lane);
#endif
    STAMP(3);
    xcd_barrier(xb);
    STAMP(4);
#if !defined(ONLY) || ONLY == 2
    {
        pg8::Gemm g{(const bf16_t*)(ws + WS_H), (const bf16_t*)(ws + WS_WIN), MTOK, 7168, 1024}; pg8::StaticOrder S; S.init(MTOK, 7168, G, bx);
        EpiProj E{(bf16_t*)(ws + WS_XA), (bf16_t*)a.out};
        pg8::gemm_phase<EpiProj, pg8::StaticOrder, PG8_ALIGN, PG8_SP2>(lds, g, S, E);
    }
    STAMP(5);
    {
        pg8::Gemm g{(const bf16_t*)(ws + WS_WV), (const bf16_t*)(ws + WS_H), 1024, MTOK, 1024}; pg8::StaticOrder S; S.init(1024, MTOK, G, bx);
        EpiPlain E{(bf16_t*)(ws + WS_VT), MTOK};
        pg8::gemm_phase<EpiPlain, pg8::StaticOrder, PG8_ALIGN, PG8_SP2>(lds, g, S, E);
    }
    STAMP(6);
#endif
    xcd_barrier(xb);
    STAMP(7);
#if !defined(ONLY) || ONLY == 3
    attn_phase((const bf16_t*)(ws + WS_Q), (const bf16_t*)(ws + WS_K), (const bf16_t*)(ws + WS_VT), (const bf16_t*)(ws + WS_ZB), a.in[18], (bf16_t*)(ws + WS_Q), lds, vcu, G, tid, wave, lane);
#endif
    STAMP(8);
#if !defined(ONLY) || ONLY == 4
    scan_phase<false>(a, lds, gw, NGW, wave, lane);
#endif
    STAMP(9);
    xcd_barrier(xb);
    STAMP(10);
#if !defined(ONLY) || ONLY == 5
    scan_phase<true>(a, lds, gw, NGW, wave, lane);
#endif
    STAMP(11);
    xcd_barrier(xb);
    STAMP(12);
#if !defined(ONLY) || ONLY == 6
    {
        pg8::Gemm g{(const bf16_t*)(ws + WS_H), (const bf16_t*)(ws + WS_WPA), MTOK, 1024, 1024, (const bf16_t*)(ws + WS_Q), (const bf16_t*)(ws + WS_WPB)}; pg8::PairOrder S; S.init(MTOK, 1024, G, bx);
        EpiGate2 E{(const bf16_t*)a.out, (const bf16_t*)a.out + ARR, (bf16_t*)(ws + WS_K), (bf16_t*)(ws + WS_XA)};
        pg8::gemm_phase<EpiGate2, pg8::PairOrder, PG8_ALIGN, PG8_SP2>(lds, g, S, E);
    }
    STAMP(14);
#endif
    xcd_barrier(xb);
    STAMP(15);
#if !defined(ONLY) || ONLY == 7
    {
        pg8::Gemm g{(const bf16_t*)(ws + WS_XA), (const bf16_t*)(ws + WS_WO), MTOK, 1024, 1024}; pg8::StaticOrder S; S.init(MTOK, 1024, G, bx);
        EpiOut E{(const float*)(ws + WS_GATE), (bf16_t*)(ws + WS_ZB)};
        pg8::gemm_phase<EpiOut, pg8::StaticOrder, PG8_ALIGN, PG8_SP2>(lds, g, S, E);
    }
    STAMP(16);
#endif
    xcd_barrier(xb);
    STAMP(17);
#if !defined(ONLY) || ONLY == 8
    final_norm(a, gw, NGW, lane);
#endif
#ifdef PROBE_A0
    STAMP(18);
    if (bx == 0) {
        const float dA = (float)(tA1 - tA0) * 0.01f, dB = (float)(tB1 - tB0) * 0.01f;
        __syncthreads();
        float* orow = a.out + (size_t)wave * DM;
        for (int i = lane; i < DM; i += 64) orow[i] += dB;
        __syncthreads();
        if (tid == 0) a.out[0] += dA;
    }
#endif
}

extern "C" void kernel_launch(void* const* d_in, const int* in_sizes, int n_in, void* d_out, int out_size, void* d_ws, size_t ws_size, hipStream_t stream) {
    static int grid = 0;
    if (grid == 0) {
        if (n_in != 23 || out_size != MTOK * DM || ws_size < 256 * MiB) { fprintf(stderr, "kernel_launch: unexpected problem shape (n_in %d, out %d, ws %zu)\n", n_in, out_size, ws_size); grid = -1; return; }
        int dev = 0, cus = 0, per_cu = 0;
        (void)hipGetDevice(&dev);
        (void)hipDeviceGetAttribute(&cus, hipDeviceAttributeMultiprocessorCount, dev);
        if (hipFuncSetAttribute((const void*)fwd_kernel, hipFuncAttributeMaxDynamicSharedMemorySize, LDS_BYTES) != hipSuccess) { fprintf(stderr, "kernel_launch: hipFuncSetAttribute failed\n"); grid = -1; return; }
        if (hipOccupancyMaxActiveBlocksPerMultiprocessor(&per_cu, (const void*)fwd_kernel, 512, LDS_BYTES) != hipSuccess || per_cu < 1) { fprintf(stderr, "kernel_launch: occupancy query failed (%d)\n", per_cu); per_cu = 1; (void)hipGetLastError(); }
        grid = cus * per_cu;
        if (grid <= 0) { grid = -1; return; }
    }
    if (grid < 0) return;
    Args a{};
    for (int i = 0; i < 23; ++i) a.in[i] = (const float*)d_in[i];
    a.out = (float*)d_out; a.ws = (unsigned char*)d_ws;
    void* args[] = {&a};
    if (hipMemsetAsync((unsigned char*)d_ws + WS_BAR, 0, XCD_BAR_WORDS * 4, stream) != hipSuccess) { fprintf(stderr, "kernel_launch: memset of the barrier words failed\n"); return; }
    hipError_t e = hipLaunchCooperativeKernel((const void*)fwd_kernel, dim3(grid), dim3(512), args, LDS_BYTES, stream);
    if (e != hipSuccess) fprintf(stderr, "kernel_launch: cooperative launch failed: %s (grid %d)\n", hipGetErrorString(e), grid);
}
```

```cpp
#include <hip/hip_runtime.h>
#include <hip/hip_cooperative_groups.h>
#include <cstdio>
#include <cstdint>
namespace cg = cooperative_groups;
namespace pg8 {
#define PG8_LAS __attribute__((address_space(3)))
typedef unsigned short bf16_t;
typedef short bf16x8 __attribute__((ext_vector_type(8)));
typedef float f32x4 __attribute__((ext_vector_type(4)));
typedef unsigned u32x4 __attribute__((ext_vector_type(4)));
constexpr int BM = 256, BK = 64, HALF = 128, HTB = HALF * BK * 2  , STAGE_BYTES = 8 * HTB, NXCD = 8, WGM = 8;

__host__ __device__ __forceinline__ int lds_byte(int r, int c) { const int st = (r >> 4) * 2 + (c >> 5), rr = r & 15, cc = c & 31, ob = rr * 64 + cc * 2; return st * 1024 + (ob ^ (((ob >> 9) & 1) << 5)); }
__host__ __device__ __forceinline__ void stage_rc(int b, int& R, int& C) { const int st = b / 1024, sb = b % 1024, swz = sb ^ (((sb >> 9) & 1) << 5); R = (st >> 1) * 16 + swz / 64; C = (st & 1) * 32 + (swz % 64) / 2; }
__host__ __device__ __forceinline__ int perm32(int rho) { const int n = rho >> 4, i = rho & 15; return 8 * (i >> 2) + 4 * n + (i & 3); }

struct Unit { int pm, pn, w; };
struct Gemm { const bf16_t* A; const bf16_t* Bt; int M, N, K; const bf16_t* A2; const bf16_t* Bt2; };

struct StaticOrder {
    int nM, nN, nwg, G, c;
    __host__ __device__ void init(int M, int N, int G_, int c_) { nM = M / BM; nN = N / BM; nwg = nM * nN; G = G_; c = c_; }
    __host__ __device__ bool next(int i, Unit& u) const {
        const long L = (long)i * G + c; if (L >= nwg) return false;
        int wgid = (int)L; { const int q = nwg / NXCD, r = nwg % NXCD, xcd = wgid % NXCD, off = wgid / NXCD; wgid = (xcd < r ? xcd * (q + 1) : r * (q + 1) + (xcd - r) * q) + off; }
        const int nig = WGM * nN, gid = wgid / nig, fm = gid * WGM, gsz = (nM - fm) < WGM ? (nM - fm) : WGM;
        u.pm = fm + ((wgid % nig) % gsz); u.pn = (wgid % nig) / gsz; u.w = 0; return true;
    }
    __device__ __forceinline__ void a_ready(const Unit&) const {}
    __device__ __forceinline__ void done(const Unit&) const {}
};
struct PairOrder : StaticOrder {
    __host__ __device__ bool next(int i, Unit& u) const { if (!StaticOrder::next(i >> 1, u)) return false; u.w = i & 1; return true; }
};
__device__ __forceinline__ unsigned cvt_pk_bf16(float lo, float hi) { unsigned r; asm volatile("v_cvt_pk_bf16_f32 %0, %1, %2" : "=v"(r) : "v"(lo), "v"(hi)); return r; }
typedef float f32x2 __attribute__((ext_vector_type(2)));
template <class Epi, class Sched, bool ALIGN_EPI = false, bool SP2 = false>
__device__ __forceinline__ void gemm_phase(PG8_LAS unsigned char* lds, const Gemm g, const Sched& S, const Epi& E) {
    const int tid = threadIdx.x, wid = __builtin_amdgcn_readfirstlane(tid >> 6), lane = tid & 63, wr = wid >> 2, wc = wid & 3, fr = lane & 15, fq = lane >> 4;
    const int K = g.K, nt = K / BK;
    unsigned voffA[2], voffB[2];
#pragma unroll
    for (int i = 0; i < 2; ++i) { int R, C; stage_rc(tid * 16 + i * 8192, R, C); const int Rb = Epi::PERM ? ((R & ~31) + perm32(R & 31)) : R;
        voffA[i] = (unsigned)(R * K + C) * 2u; voffB[i] = (unsigned)(Rb * K + C) * 2u; }
    const size_t kstep = (size_t)(BK * 2);
    const size_t hstep = (size_t)HALF * K * 2;
    const size_t tstep = 2 * hstep;
    const unsigned ldsw = (unsigned)wid * 1024u;
    const int aoff = lds_byte(wr * 64 + fr, fq * 8), boff = lds_byte(wc * 32 + fr, fq * 8);
#define PG8_SA(b, h) (((b) * 2 + (h)) * HTB)
#define PG8_SB(b, h) ((4 + (b) * 2 + (h)) * HTB)
#define PG8_STAGE(bufoff, gbase, voff) do { _Pragma("unroll") for (int _i = 0; _i < 2; ++_i) \
        __builtin_amdgcn_global_load_lds((const unsigned*)((const char*)(gbase) + (voff)[_i]), (PG8_LAS unsigned*)(lds + (bufoff) + ldsw + _i * 8192), 16, 0, 0); } while (0)
#define PG8_LDA(dst, b, h) do { _Pragma("unroll") for (int m = 0; m < 4; ++m) _Pragma("unroll") for (int k = 0; k < 2; ++k) dst[m][k] = *(const PG8_LAS bf16x8*)(lds + PG8_SA(b, h) + aoff + m * 2048 + k * 1024); } while (0)
#define PG8_LDB(dst, b, h) do { _Pragma("unroll") for (int n = 0; n < 2; ++n) _Pragma("unroll") for (int k = 0; k < 2; ++k) dst[n][k] = *(const PG8_LAS bf16x8*)(lds + PG8_SB(b, h) + boff + n * 2048 + k * 1024); } while (0)
#define PG8_MMA(ai, bj, At, Bt) do { __builtin_amdgcn_s_setprio(1); _Pragma("unroll") for (int m = 0; m < 4; ++m) _Pragma("unroll") for (int n = 0; n < 2; ++n) _Pragma("unroll") for (int k = 0; k < 2; ++k) \
        acc[ai][bj][m][n] = __builtin_amdgcn_mfma_f32_16x16x32_bf16(Bt[n][k], At[m][k], acc[ai][bj][m][n], 0, 0, 0); __builtin_amdgcn_s_setprio(0); } while (0)
#define PG8_WAIT_V(n) asm volatile("s_waitcnt vmcnt(" #n ")" ::: "memory")
#define PG8_WAIT_L(n) asm volatile("s_waitcnt lgkmcnt(" #n ")" ::: "memory")
#define PG8_BAR __builtin_amdgcn_s_barrier()
#define PG8_SCHED __builtin_amdgcn_sched_barrier(0)
    Unit cur, nxt; int ui = 0;
    if (!S.next(0, cur)) return;
    f32x4 acc[2][2][4][2];
#pragma unroll
    for (int a = 0; a < 2; ++a)
#pragma unroll
        for (int b = 0; b < 2; ++b)
#pragma unroll
            for (int m = 0; m < 4; ++m)
#pragma unroll
                for (int n = 0; n < 2; ++n) acc[a][b][m][n] = (f32x4){0.f, 0.f, 0.f, 0.f};
    bf16x8 At[4][2], B0[2][2], B1[2][2];
    const char* cA = (const char*)(cur.w ? g.A2 : g.A) + (size_t)cur.pm * tstep; const char* cB = (const char*)(cur.w ? g.Bt2 : g.Bt) + (size_t)cur.pn * tstep;
    S.a_ready(cur);
    if constexpr (SP2) {
        PG8_STAGE(PG8_SB(0, 0), cB, voffB); PG8_STAGE(PG8_SB(0, 1), cB + hstep, voffB); PG8_STAGE(PG8_SA(0, 0), cA, voffA); PG8_STAGE(PG8_SA(0, 1), cA + hstep, voffA);
        if (wr == 1) PG8_BAR;
        PG8_WAIT_V(2); PG8_BAR;
        PG8_STAGE(PG8_SB(1, 0), cB + kstep, voffB); PG8_STAGE(PG8_SA(1, 0), cA + kstep, voffA); PG8_STAGE(PG8_SB(1, 1), cB + hstep + kstep, voffB);
        PG8_WAIT_V(6); PG8_BAR;
    } else {
        PG8_STAGE(PG8_SB(0, 0), cB, voffB); PG8_STAGE(PG8_SA(0, 0), cA, voffA); PG8_STAGE(PG8_SB(0, 1), cB + hstep, voffB); PG8_STAGE(PG8_SA(0, 1), cA + hstep, voffA);
        if (wr == 1) PG8_BAR;
        PG8_WAIT_V(4); PG8_BAR;
        PG8_STAGE(PG8_SB(1, 0), cB + kstep, voffB); PG8_STAGE(PG8_SA(1, 0), cA + kstep, voffA); PG8_STAGE(PG8_SB(1, 1), cB + hstep + kstep, voffB);
        PG8_WAIT_V(6); PG8_BAR;
    }
    for (;;) {
        const bool has_next = S.next(ui + 1, nxt);
        const char* nA = has_next ? (const char*)(nxt.w ? g.A2 : g.A) + (size_t)nxt.pm * tstep : cA; const char* nB = has_next ? (const char*)(nxt.w ? g.Bt2 : g.Bt) + (size_t)nxt.pn * tstep : cB;
        for (int t = 0; t < nt; t += 2) {
            const bool last = (t == nt - 2);
            const char* a1 = cA + (size_t)(t + 1) * kstep;
            const char* a2 = last ? nA : cA + (size_t)(t + 2) * kstep; const char* b2 = last ? nB : cB + (size_t)(t + 2) * kstep;
            const char* a3 = a2 + kstep; const char* b3 = b2 + kstep;
            if (last && has_next) S.a_ready(nxt);
            if constexpr (SP2) {
            PG8_LDB(B0, 0, 0); PG8_LDB(B1, 0, 1); PG8_SCHED; PG8_LDA(At, 0, 0); PG8_STAGE(PG8_SA(1, 1), a1 + hstep, voffA);
            PG8_WAIT_V(8); PG8_WAIT_L(0); PG8_BAR; PG8_MMA(0, 0, At, B0); PG8_MMA(0, 1, At, B1); PG8_BAR; PG8_SCHED;
            PG8_LDA(At, 0, 1); PG8_STAGE(PG8_SB(0, 0), b2, voffB); PG8_STAGE(PG8_SB(0, 1), b2 + hstep, voffB); PG8_STAGE(PG8_SA(0, 0), a2, voffA);
            PG8_WAIT_V(8); PG8_WAIT_L(0); PG8_BAR; PG8_MMA(1, 0, At, B0); PG8_MMA(1, 1, At, B1); PG8_BAR; PG8_SCHED;
            PG8_LDB(B0, 1, 0); PG8_LDB(B1, 1, 1); PG8_SCHED; PG8_LDA(At, 1, 0); PG8_STAGE(PG8_SA(0, 1), a2 + hstep, voffA);
            PG8_WAIT_V(8); PG8_WAIT_L(0); PG8_BAR; PG8_MMA(0, 0, At, B0); PG8_MMA(0, 1, At, B1); PG8_BAR; PG8_SCHED;
            PG8_LDA(At, 1, 1); PG8_STAGE(PG8_SB(1, 0), b3, voffB); PG8_STAGE(PG8_SB(1, 1), b3 + hstep, voffB); PG8_STAGE(PG8_SA(1, 0), a3, voffA);
            PG8_WAIT_V(8); PG8_WAIT_L(0); PG8_BAR; PG8_MMA(1, 0, At, B0); PG8_MMA(1, 1, At, B1); PG8_BAR; PG8_SCHED;
            } else {
            PG8_LDB(B0, 0, 0); PG8_SCHED; PG8_LDA(At, 0, 0); PG8_STAGE(PG8_SA(1, 1), a1 + hstep, voffA);
            PG8_WAIT_L(8); PG8_BAR; PG8_WAIT_L(0); PG8_MMA(0, 0, At, B0); PG8_BAR; PG8_SCHED;
            PG8_LDB(B1, 0, 1); PG8_STAGE(PG8_SB(0, 0), b2, voffB);
            PG8_BAR; PG8_WAIT_L(0); PG8_MMA(0, 1, At, B1); PG8_BAR;
            PG8_LDA(At, 0, 1); PG8_STAGE(PG8_SA(0, 0), a2, voffA);
            PG8_BAR; PG8_WAIT_L(0); PG8_MMA(1, 0, At, B0); PG8_BAR; PG8_SCHED;
            PG8_STAGE(PG8_SB(0, 1), b2 + hstep, voffB);
            PG8_WAIT_V(6); PG8_BAR; PG8_MMA(1, 1, At, B1); PG8_BAR;
            PG8_LDB(B0, 1, 0); PG8_SCHED; PG8_LDA(At, 1, 0); PG8_STAGE(PG8_SA(0, 1), a2 + hstep, voffA);
            PG8_WAIT_L(8); PG8_BAR; PG8_WAIT_L(0); PG8_MMA(0, 0, At, B0); PG8_BAR; PG8_SCHED;
            PG8_LDB(B1, 1, 1); PG8_STAGE(PG8_SB(1, 0), b3, voffB);
            PG8_BAR; PG8_WAIT_L(0); PG8_MMA(0, 1, At, B1); PG8_BAR;
            PG8_LDA(At, 1, 1); PG8_STAGE(PG8_SA(1, 0), a3, voffA);
            PG8_BAR; PG8_WAIT_L(0); PG8_MMA(1, 0, At, B0); PG8_BAR; PG8_SCHED;
            PG8_STAGE(PG8_SB(1, 1), b3 + hstep, voffB);
            PG8_WAIT_V(6); PG8_BAR; PG8_MMA(1, 1, At, B1); PG8_BAR;
            }
        }
        if constexpr (ALIGN_EPI) { if (wr == 0) PG8_BAR; }
        if constexpr (!Epi::AFTER_DRAIN) { E(acc, cur, wr, wc, fr, fq); S.done(cur); }
        if (!has_next) break;
#pragma unroll
        for (int a = 0; a < 2; ++a)
#pragma unroll
            for (int b = 0; b < 2; ++b)
#pragma unroll
                for (int m = 0; m < 4; ++m)
#pragma unroll
                    for (int n = 0; n < 2; ++n) acc[a][b][m][n] = (f32x4){0.f, 0.f, 0.f, 0.f};
        cur = nxt; cA = nA; cB = nB; ++ui;
        if constexpr (ALIGN_EPI) { if (wr == 1) PG8_BAR; }
    }
    PG8_WAIT_V(0);
    if constexpr (!ALIGN_EPI) { if (wr == 0) PG8_BAR; }
    PG8_BAR;
    if constexpr (Epi::AFTER_DRAIN) { E.fused(acc, cur, wr, wc, fr, fq, lds, wid, lane); S.done(cur); }
#undef PG8_SA
#undef PG8_SB
#undef PG8_STAGE
#undef PG8_LDA
#undef PG8_LDB
#undef PG8_MMA
#undef PG8_WAIT_V
#undef PG8_WAIT_L
#undef PG8_BAR
#undef PG8_SCHED
}
}
#ifndef PG8_SP2
#define PG8_SP2 true
#endif
#ifndef PG8_ALIGN
#define PG8_ALIGN true
#endif

#define LAS __attribute__((address_space(3)))
typedef unsigned short bf16_t;
typedef short bf16x8 __attribute__((ext_vector_type(8)));
typedef short bf16x4 __attribute__((ext_vector_type(4)));
typedef float f32x4 __attribute__((ext_vector_type(4)));
typedef float f32x16 __attribute__((ext_vector_type(16)));
typedef unsigned u32x4 __attribute__((ext_vector_type(4)));
typedef unsigned u32x2 __attribute__((ext_vector_type(2)));

constexpr int MTOK = 16384, DM = 1024, SEQ = 4096, NB = 4;
constexpr size_t MiB = 1u << 20;
constexpr size_t ARR = (size_t)MTOK * DM;
constexpr size_t WS_MODP = 0;
constexpr size_t WS_GATE = 786432;
constexpr size_t WS_AGG = 1 * MiB;
constexpr size_t WS_RSS = 5 * MiB;
constexpr size_t WS_WG = 6 * MiB;
constexpr size_t WS_WPA = 8 * MiB, WS_WPB = 10 * MiB, WS_WO = 12 * MiB, WS_WV = 14 * MiB;
constexpr size_t WS_WIN = 16 * MiB;
constexpr size_t WS_H = 32 * MiB;
constexpr size_t WS_XA = 64 * MiB, WS_ZA = 96 * MiB, WS_Q = 128 * MiB, WS_K = 160 * MiB, WS_ZB = 192 * MiB;
constexpr size_t WS_VT = 224 * MiB;
constexpr size_t WS_BAR = 802816;
constexpr int LDS_CIN = 131072, LDS_SEG = 131072 + 8192;
constexpr int LDS_MISC = 147456, LDS_RPB = 147456 + 256;
constexpr int LDS_BYTES = 147456 + 256 + 3840;

__device__ __forceinline__ float bf2f(unsigned short b) { return __uint_as_float(((unsigned)b) << 16); }
__device__ __forceinline__ unsigned pk2(float lo, float hi) { return pg8::cvt_pk_bf16(lo, hi); }
__device__ __forceinline__ float sigm(float v) { return __builtin_amdgcn_rcpf(1.f + __builtin_amdgcn_exp2f(-1.44269504089f * v)); }
__device__ __forceinline__ float wave_sum(float v) {
#pragma unroll
    for (int o = 1; o < 64; o <<= 1) v += __shfl_xor(v, o);
    return v;
}
#define LDS_WAIT() asm volatile("s_waitcnt lgkmcnt(0)" ::: "memory")

struct EpiProj {
    static constexpr bool PERM = true, AFTER_DRAIN = false;
    bf16_t* O5; bf16_t* OG;
    __device__ __forceinline__ void operator()(const f32x4 (&acc)[2][2][4][2], const pg8::Unit& u, int wr, int wc, int fr, int fq) const {
        const int arr = u.pn >> 2, colt = (u.pn & 3) * 256;
        bf16_t* base = arr < 5 ? O5 + (size_t)arr * ARR : OG + (size_t)(arr - 5) * ARR;
        const int mode = (arr == 1 || arr == 4) ? 1 : (arr >= 5 ? 2 : (arr == 2 ? 3 : 0));
        const int row0 = u.pm * 256 + wr * 64 + fr, col0 = colt + wc * 32 + 8 * fq;
#pragma unroll
        for (int ai = 0; ai < 2; ++ai)
#pragma unroll
            for (int m = 0; m < 4; ++m) { bf16_t* rowp = base + (size_t)(row0 + ai * 128 + m * 16) * DM + col0;
#pragma unroll
                for (int bj = 0; bj < 2; ++bj) { f32x4 v0 = acc[ai][bj][m][0], v1 = acc[ai][bj][m][1];
                    if (mode == 1) {
#pragma unroll
                        for (int j = 0; j < 4; ++j) { v0[j] = v0[j] * sigm(v0[j]); v1[j] = v1[j] * sigm(v1[j]); } }
                    else if (mode == 2) {
#pragma unroll
                        for (int j = 0; j < 4; ++j) { v0[j] = sigm(v0[j]); v1[j] = sigm(v1[j]); } }
                    else if (mode == 3) { v0 = v0 * (0.125f * 1.44269504089f); v1 = v1 * (0.125f * 1.44269504089f); }
                    u32x4 w; w.x = pk2(v0[0], v0[1]); w.y = pk2(v0[2], v0[3]); w.z = pk2(v1[0], v1[1]); w.w = pk2(v1[2], v1[3]);
                    *(u32x4*)(rowp + bj * 128) = w; } }
    }
};
struct EpiPlain {
    static constexpr bool PERM = true, AFTER_DRAIN = false;
    bf16_t* O; int ldc;
    __device__ __forceinline__ void operator()(const f32x4 (&acc)[2][2][4][2], const pg8::Unit& u, int wr, int wc, int fr, int fq) const {
        const int row0 = u.pm * 256 + wr * 64 + fr, col0 = u.pn * 256 + wc * 32 + 8 * fq;
#pragma unroll
        for (int ai = 0; ai < 2; ++ai)
#pragma unroll
            for (int m = 0; m < 4; ++m) { bf16_t* rowp = O + (size_t)(row0 + ai * 128 + m * 16) * ldc + col0;
#pragma unroll
                for (int bj = 0; bj < 2; ++bj) { const f32x4 v0 = acc[ai][bj][m][0], v1 = acc[ai][bj][m][1];
                    u32x4 w; w.x = pk2(v0[0], v0[1]); w.y = pk2(v0[2], v0[3]); w.z = pk2(v1[0], v1[1]); w.w = pk2(v1[2], v1[3]);
                    *(u32x4*)(rowp + bj * 128) = w; } }
    }
};
struct EpiGate2 {
    static constexpr bool PERM = true, AFTER_DRAIN = false;
    const bf16_t* Ga; const bf16_t* Gb; bf16_t* Tb; bf16_t* O;
    __device__ __forceinline__ void operator()(const f32x4 (&acc)[2][2][4][2], const pg8::Unit& u, int wr, int wc, int fr, int fq) const {
        const int row0 = u.pm * 256 + wr * 64 + fr, col0 = u.pn * 256 + wc * 32 + 8 * fq;
        const bf16_t* G = u.w ? Gb : Ga; bf16_t* dst = u.w ? O : Tb;
#pragma unroll
        for (int ai = 0; ai < 2; ++ai) {
            bf16x8 g[4][2], t[4][2];
#pragma unroll
            for (int m = 0; m < 4; ++m)
#pragma unroll
                for (int bj = 0; bj < 2; ++bj) { const size_t off = (size_t)(row0 + ai * 128 + m * 16) * DM + col0 + bj * 128;
                    g[m][bj] = *(const bf16x8*)(G + off);
                    if (u.w) t[m][bj] = *(const bf16x8*)(Tb + off); else t[m][bj] = (bf16x8){0, 0, 0, 0, 0, 0, 0, 0}; }
            asm volatile("" ::: "memory");
#pragma unroll
            for (int m = 0; m < 4; ++m)
#pragma unroll
                for (int bj = 0; bj < 2; ++bj) { const size_t off = (size_t)(row0 + ai * 128 + m * 16) * DM + col0 + bj * 128;
                    const f32x4 v0 = acc[ai][bj][m][0], v1 = acc[ai][bj][m][1];
                    float o[8];
#pragma unroll
                    for (int j = 0; j < 4; ++j) { o[j] = fmaf(bf2f((unsigned short)g[m][bj][j]), v0[j], bf2f((unsigned short)t[m][bj][j])); o[4 + j] = fmaf(bf2f((unsigned short)g[m][bj][4 + j]), v1[j], bf2f((unsigned short)t[m][bj][4 + j])); }
                    u32x4 w; w.x = pk2(o[0], o[1]); w.y = pk2(o[2], o[3]); w.z = pk2(o[4], o[5]); w.w = pk2(o[6], o[7]);
                    *(u32x4*)(dst + off) = w; }
            asm volatile("" ::: "memory");
        }
    }
};
struct EpiOut {
    static constexpr bool PERM = true, AFTER_DRAIN = false;
    const float* gate; bf16_t* O;
    __device__ __forceinline__ void operator()(const f32x4 (&acc)[2][2][4][2], const pg8::Unit& u, int wr, int wc, int fr, int fq) const {
        const int row0 = u.pm * 256 + wr * 64 + fr, col0 = u.pn * 256 + wc * 32 + 8 * fq;
        const float* gp = gate + (size_t)(u.pm >> 4) * DM + col0;
        f32x4 gv[2][2];
#pragma unroll
        for (int bj = 0; bj < 2; ++bj)
#pragma unroll
            for (int n = 0; n < 2; ++n) gv[bj][n] = *(const f32x4*)(gp + bj * 128 + n * 4);
#pragma unroll
        for (int ai = 0; ai < 2; ++ai)
#pragma unroll
            for (int m = 0; m < 4; ++m) { bf16_t* rowp = O + (size_t)(row0 + ai * 128 + m * 16) * DM + col0;
#pragma unroll
                for (int bj = 0; bj < 2; ++bj) { const f32x4 v0 = gv[bj][0] * acc[ai][bj][m][0], v1 = gv[bj][1] * acc[ai][bj][m][1];
                    u32x4 w; w.x = pk2(v0[0], v0[1]); w.y = pk2(v0[2], v0[3]); w.z = pk2(v1[0], v1[1]); w.w = pk2(v1[2], v1[3]);
                    *(u32x4*)(rowp + bj * 128) = w; } }
    }
};

__device__ __forceinline__ void p0_transpose_item(const float* W, int K, int N, bf16_t* WT, int dst_row0, int k0, int n0, LAS float* scr, int lane, float scale = 1.f) {
    float wv[32];
#pragma unroll
    for (int i = 0; i < 32; ++i) { const int kk = 2 * i + (lane >> 5); wv[i] = W[(size_t)(k0 + kk) * N + n0 + (lane & 31)]; }
#pragma unroll
    for (int i = 0; i < 32; ++i) { const int kk = 2 * i + (lane >> 5); scr[kk * 33 + (lane & 31)] = wv[i] * scale; }
    LDS_WAIT(); asm volatile("" ::: "memory");
    const int c = lane & 7;
#pragma unroll
    for (int j = 0; j < 4; ++j) { const int n = (lane >> 3) + 8 * j; const LAS float* s = scr + (8 * c) * 33 + n;
        u32x4 o; o.x = pk2(s[0 * 33], s[1 * 33]); o.y = pk2(s[2 * 33], s[3 * 33]); o.z = pk2(s[4 * 33], s[5 * 33]); o.w = pk2(s[6 * 33], s[7 * 33]);
        *(u32x4*)(WT + (size_t)(dst_row0 + n) * K + k0 + 8 * c) = o; }
    LDS_WAIT(); asm volatile("" ::: "memory");
}

struct Args { const float* in[23]; float* out; unsigned char* ws; };

__device__ __forceinline__ void p0_prologue(const Args& a, LAS unsigned char* lds, int gw, int NGW, int wave, int lane) {
    LAS float* scr = (LAS float*)(lds + wave * 16384);
    unsigned char* ws = a.ws;
    const float* c = a.in[1]; const float* w_c = a.in[3]; const float* w_in = a.in[5];
    float* modp = (float*)(ws + WS_MODP);
    constexpr int I_MOD = 768, I_IN = 16 * 256, I_SQ = 16 * 32, I_G = 4 * 16 * 2;
    constexpr int NITEMS = I_MOD + I_IN + 3 * I_SQ + I_G;
    for (int it = gw; it < NITEMS; it += NGW) {
        int r = it;
        if (r < I_MOD) {
            const int cgi = r % 48, kc = r / 48, col = cgi * 64 + lane, k0 = kc * 64;
            float sv[4];
#pragma unroll
            for (int b = 0; b < 4; ++b) { const float cv = c[b * DM + k0 + lane]; sv[b] = cv * sigm(cv); }
            float acc[4] = {0.f, 0.f, 0.f, 0.f};
#pragma unroll 32
            for (int kk = 0; kk < 64; ++kk) { const float w = w_c[(size_t)(k0 + kk) * 3072 + col];
#pragma unroll
                for (int b = 0; b < 4; ++b) acc[b] += __shfl(sv[b], kk) * w; }
#pragma unroll
            for (int b = 0; b < 4; ++b) modp[(size_t)(kc * 4 + b) * 3072 + col] = acc[b];
            continue;
        }
        r -= I_MOD;
        if (r < I_IN) { const int kb = r / 256, nb = r % 256, n0 = nb * 32, cb = n0 >> 10;
            if (cb == 4) p0_transpose_item(w_in, 1024, 8192, (bf16_t*)(ws + WS_WV), n0 - 4096, kb * 64, n0, scr, lane);
            else p0_transpose_item(w_in, 1024, 8192, (bf16_t*)(ws + WS_WIN), (cb < 4 ? cb : cb - 1) * 1024 + (n0 & 1023), kb * 64, n0, scr, lane);
            continue; }
        r -= I_IN;
        if (r < 3 * I_SQ) { const int which = r / I_SQ, rr = r % I_SQ, kb = rr / 32, nb = rr % 32;
            const float* W = which == 0 ? a.in[19] : (which == 1 ? a.in[20] : a.in[21]);
            bf16_t* WT = (bf16_t*)(ws + (which == 0 ? WS_WPA : (which == 1 ? WS_WPB : WS_WO)));
            p0_transpose_item(W, 1024, 1024, WT, nb * 32, kb * 64, nb * 32, scr, lane);
            continue; }
        r -= 3 * I_SQ;
        { const int g = r / 32, rr = r % 32, hb = rr / 2, nb = rr % 2;
            const float* W = (g == 0 ? a.in[8] : (g == 1 ? a.in[10] : (g == 2 ? a.in[13] : a.in[15]))) + (size_t)hb * 4096;
            bf16_t* WT = (bf16_t*)(ws + WS_WG) + (size_t)(g * 16 + hb) * 4096;
            p0_transpose_item(W, 64, 64, WT, nb * 32, 0, nb * 32, scr, lane, -1.44269504089f); }
    }
}

__device__ __forceinline__ void p1_hpass(const Args& a, LAS unsigned char* lds, int G, int tid, int wave, int lane) {
    unsigned char* ws = a.ws;
    const float* x = a.in[0]; const float* g_pre = a.in[2]; const float* b_c = a.in[4];
    const float* modp = (const float*)(ws + WS_MODP);
    bf16_t* H = (bf16_t*)(ws + WS_H);
    LAS float* sh = (LAS float*)lds;
    for (int rb = blockIdx.x; rb < MTOK / 64; rb += G) {
        const int b = rb >> 6;
        __syncthreads();
        for (int idx = tid; idx < 2048; idx += 512) { float s = b_c[idx];
#pragma unroll
            for (int kc = 0; kc < 16; ++kc) s += modp[(size_t)(kc * 4 + b) * 3072 + idx];
            sh[idx] = idx < 1024 ? s : 1.f + s; }
        __syncthreads();
        for (int rr = wave; rr < 64; rr += 16) {
            const int row0 = rb * 64 + rr;
            f32x4 v[2][4]; float s[2] = {0.f, 0.f};
#pragma unroll
            for (int q = 0; q < 2; ++q) { const f32x4* xr = (const f32x4*)(x + (size_t)(row0 + 8 * q) * DM) + lane;
#pragma unroll
                for (int j = 0; j < 4; ++j) v[q][j] = xr[64 * j]; }
#pragma unroll
            for (int q = 0; q < 2; ++q)
#pragma unroll
                for (int j = 0; j < 4; ++j) s[q] += (v[q][j][0] * v[q][j][0] + v[q][j][1] * v[q][j][1]) + (v[q][j][2] * v[q][j][2] + v[q][j][3] * v[q][j][3]);
#pragma unroll
            for (int q = 0; q < 2; ++q) { const float rstd = __builtin_amdgcn_rsqf(wave_sum(s[q]) * (1.f / 1024.f) + 1e-6f);
#pragma unroll
                for (int j = 0; j < 4; ++j) { const int col = 4 * lane + 256 * j;
                    const f32x4 g = *(const f32x4*)(g_pre + col); const f32x4 sc = *(const LAS f32x4*)(sh + 1024 + col); const f32x4 sf = *(const LAS f32x4*)(sh + col);
                    const f32x4 o = (v[q][j] * rstd) * g * sc + sf;
                    u32x2 w; w.x = pk2(o[0], o[1]); w.y = pk2(o[2], o[3]);
                    *(u32x2*)(H + (size_t)(row0 + 8 * q) * DM + col) = w; } }
        }
    }
    float* gate = (float*)(ws + WS_GATE);
    for (int idx = blockIdx.x * 512 + tid; idx < 4096; idx += G * 512) { const int b = idx >> 10, col = idx & 1023; float s = b_c[2048 + col];
#pragma unroll
        for (int kc = 0; kc < 16; ++kc) s += modp[(size_t)(kc * 4 + b) * 3072 + 2048 + col];
        gate[idx] = s; }
}

__device__ __forceinline__ int attn_fk(int col) { return ((col >> 1) & 1) | (((col >> 3) & 3) << 1); }
__device__ __forceinline__ void attn_phase(const bf16_t* Q, const bf16_t* Kb, const bf16_t* VT, const bf16_t* ZB, const float* rpb, bf16_t* YB, LAS unsigned char* lds, int vcu, int G, int tid, int wave, int lane) {
    const int fr = lane & 15, fq = lane >> 4;
    constexpr float L2E = 1.44269504089f;
    LAS float* rpbL = (LAS float*)(lds + LDS_RPB);
    const int rsel = wave >> 2, j = wave & 3;
    const int cs = min(max(16 * j - 8, 0), 32);
    const int qc = 16 * j + fr, c0 = min(max(qc - 8, 0), 48);
    const int lcol = tid >> 3, lch = tid & 7;
    float maskadd[8];
#pragma unroll
    for (int e = 0; e < 8; ++e) { const int kcol = cs + 8 * fq + e; maskadd[e] = ((kcol >= c0) && (kcol < c0 + 16)) ? 0.f : -1e30f; }
    const int rpoff = cs + 8 * fq - qc + 31;
    for (int u = vcu; u < 256; u += G) {
        const int band = u & 3, h = (u >> 2) & 15, b = u >> 6, R0 = band * 16;
        __syncthreads();
        for (int i = tid; i < 15 * 64; i += 512) { const int dr = i >> 6, dc = (i & 63) - 16; rpbL[i] = (dc >= 0 && dc < 31) ? rpb[(size_t)(h * 15 + dr) * 31 + dc] * L2E : 0.f; }
        int loaded_hi = -1;
#pragma unroll 1
        for (int ss = 0; ss < 8; ++ss) {
            const int r = R0 + 2 * ss;
            const int lo = min(max(r - 4, 0), 56), hi = min(max(r - 3, 0), 56) + 7;
            const int first = loaded_hi < 0 ? lo : loaded_hi + 1;
            if (ss > 0) __syncthreads();
            {
                u32x4 kv[9], vv[9];
#pragma unroll
                for (int k = 0; k < 9; ++k) { const int row = first + k;
                    if (row <= hi) { const size_t tokrow = (size_t)b * SEQ + (size_t)row * 64;
                        kv[k] = *(const u32x4*)(Kb + (tokrow + lcol) * DM + h * 64 + lch * 8);
                        vv[k] = *(const u32x4*)(VT + (size_t)(h * 64 + lcol) * MTOK + tokrow + lch * 8); } }
#pragma unroll
                for (int k = 0; k < 9; ++k) { const int row = first + k;
                    if (row <= hi) { const int slot = row % 9;
                        *(LAS u32x4*)(lds + slot * 16384 + lcol * 128 + ((lch ^ attn_fk(lcol)) << 4)) = kv[k];
                        *(LAS u32x4*)(lds + slot * 16384 + 8192 + lcol * 128 + ((lch ^ ((lcol >> 1) & 7)) << 4)) = vv[k]; } }
            }
            loaded_hi = hi;
            __syncthreads();
            const int ro = r + rsel, r0 = min(max(ro - 4, 0), 56);
            const size_t tokq = (size_t)b * SEQ + ro * 64 + qc;
            bf16x8 qf[2];
#pragma unroll
            for (int ks = 0; ks < 2; ++ks) qf[ks] = *(const bf16x8*)(Q + tokq * DM + h * 64 + ks * 32 + fq * 8);
            f32x4 s[8][2];
            float mx = -1e30f;
#pragma unroll
            for (int w = 0; w < 8; ++w) { const int slot = (r0 + w) % 9; const LAS float* rp = rpbL + (r0 + w - ro + 7) * 64 + rpoff;
#pragma unroll
                for (int t = 0; t < 2; ++t) { const int kc = cs + 8 * (fr >> 2) + (fr & 3) + 4 * t; const int fk = attn_fk(kc);
                    f32x4 acc;
#pragma unroll
                    for (int i = 0; i < 4; ++i) acc[i] = rp[4 * t + i] + maskadd[4 * t + i];
#pragma unroll
                    for (int ks = 0; ks < 2; ++ks) { const bf16x8 kf = *(const LAS bf16x8*)(lds + slot * 16384 + kc * 128 + (((ks * 4 + fq) ^ fk) << 4));
                        acc = __builtin_amdgcn_mfma_f32_16x16x32_bf16(kf, qf[ks], acc, 0, 0, 0); }
                    s[w][t] = acc;
                    mx = fmaxf(fmaxf(mx, fmaxf(acc[0], acc[1])), fmaxf(acc[2], acc[3])); } }
            mx = fmaxf(mx, __shfl_xor(mx, 16)); mx = fmaxf(mx, __shfl_xor(mx, 32));
            float sum = 0.f; bf16x8 pf[8];
#pragma unroll
            for (int w = 0; w < 8; ++w) { float p[8];
#pragma unroll
                for (int t = 0; t < 2; ++t)
#pragma unroll
                    for (int i = 0; i < 4; ++i) { const float e = __builtin_amdgcn_exp2f(s[w][t][i] - mx); p[4 * t + i] = e; sum += e; }
                u32x4 pw; pw.x = pk2(p[0], p[1]); pw.y = pk2(p[2], p[3]); pw.z = pk2(p[4], p[5]); pw.w = pk2(p[6], p[7]);
                pf[w] = __builtin_bit_cast(bf16x8, pw); }
            sum += __shfl_xor(sum, 16); sum += __shfl_xor(sum, 32);
            const float inv = 1.f / sum;
            f32x4 o[4];
#pragma unroll
            for (int dt = 0; dt < 4; ++dt) o[dt] = (f32x4){0.f, 0.f, 0.f, 0.f};
#pragma unroll
            for (int w = 0; w < 8; ++w) { const int slot = (r0 + w) % 9;
#pragma unroll
                for (int dt = 0; dt < 4; ++dt) { const int d = dt * 16 + fr;
                    const bf16x8 vf = *(const LAS bf16x8*)(lds + slot * 16384 + 8192 + d * 128 + ((((cs >> 3) + fq) ^ ((d >> 1) & 7)) << 4));
                    o[dt] = __builtin_amdgcn_mfma_f32_16x16x32_bf16(vf, pf[w], o[dt], 0, 0, 0); } }
#pragma unroll
            for (int dt = 0; dt < 4; ++dt) { const size_t off = tokq * DM + h * 64 + dt * 16 + 4 * fq;
                const bf16x4 z = *(const bf16x4*)(ZB + off);
                u32x2 w; w.x = pk2(o[dt][0] * inv * bf2f((unsigned short)z[0]), o[dt][1] * inv * bf2f((unsigned short)z[1]));
                w.y = pk2(o[dt][2] * inv * bf2f((unsigned short)z[2]), o[dt][3] * inv * bf2f((unsigned short)z[3]));
                *(u32x2*)(YB + off) = w; }
        }
    }
    __syncthreads();
}

template <bool FINAL, int DIR>
__device__ __forceinline__ void scan_dir(const LAS bf16x8* afrL, int lane, int ct, const bf16_t* WGr, const bf16_t* WGi, float br, float bi, float cl, float Hin,
                                         const bf16x8 (&idf)[2], float& Aout, float& Uout, const bf16_t* ZAp, bf16_t* YAp, unsigned (&hp)[4][8]) {
    const int n = lane & 31, hf = lane >> 5;
    bf16x8 Br[4], Bi[4];
#pragma unroll
    for (int kk = 0; kk < 4; ++kk) { Br[kk] = *(const bf16x8*)(WGr + (size_t)(32 * ct + n) * 64 + 16 * kk + 8 * hf); Bi[kk] = *(const bf16x8*)(WGi + (size_t)(32 * ct + n) * 64 + 16 * kk + 8 * hf); }
    float H = Hin, Ap = 1.f;
#pragma unroll
    for (int si = 0; si < 4; ++si) { const int s = DIR ? 3 - si : si;
        __builtin_amdgcn_sched_barrier(0);
        f32x16 ar, ai, ax;
#pragma unroll
        for (int e = 0; e < 16; ++e) { ar[e] = br; ai[e] = bi; ax[e] = 0.f; }
#pragma unroll
        for (int kk = 0; kk < 4; ++kk) { const bf16x8 av = afrL[(s * 4 + kk) * 64 + lane];
            ar = __builtin_amdgcn_mfma_f32_32x32x16_bf16(av, Br[kk], ar, 0, 0, 0); ai = __builtin_amdgcn_mfma_f32_32x32x16_bf16(av, Bi[kk], ai, 0, 0, 0); }
        { const bf16x8 a0 = afrL[(s * 4 + 2 * ct) * 64 + lane], a1 = afrL[(s * 4 + 2 * ct + 1) * 64 + lane];
            ax = __builtin_amdgcn_mfma_f32_32x32x16_bf16(a0, idf[0], ax, 0, 0, 0); ax = __builtin_amdgcn_mfma_f32_32x32x16_bf16(a1, idf[1], ax, 0, 0, 0); }
        const bf16_t* zs = ZAp + (size_t)(16 * s) * DM; bf16_t* ys = YAp + (size_t)(16 * s) * DM;
        float hv[16];
#pragma unroll
        for (int ei = 0; ei < 16; ++ei) { const int e = DIR ? 15 - ei : ei;
            const float r = __builtin_amdgcn_rcpf(1.f + __builtin_amdgcn_exp2f(ar[e])), ig = __builtin_amdgcn_rcpf(1.f + __builtin_amdgcn_exp2f(ai[e]));
            const float av = __builtin_amdgcn_exp2f(cl * r);
            const float om = fmaf(-av, av, 1.f);
            const float u = __builtin_amdgcn_sqrtf(om) * (ig * ax[e]);
            H = fmaf(av, H, u);
            hv[e] = H;
            if (!FINAL) Ap *= av; }
        if (FINAL) {
            if (DIR == 0) {
#pragma unroll
                for (int e2 = 0; e2 < 8; ++e2) hp[s][e2] = pk2(hv[2 * e2], hv[2 * e2 + 1]);
            } else {
#pragma unroll
                for (int e2 = 0; e2 < 8; ++e2) { const unsigned pw = hp[s][e2];
                    const float y0 = (hv[2 * e2] + __uint_as_float(pw << 16)) * bf2f(zs[(size_t)(2 * e2) * DM]);
                    const float y1 = (hv[2 * e2 + 1] + __uint_as_float(pw & 0xffff0000u)) * bf2f(zs[(size_t)(2 * e2 + 1) * DM]);
                    const unsigned yw = pk2(y0, y1);
                    ys[(size_t)(2 * e2) * DM] = (bf16_t)(yw & 0xffffu); ys[(size_t)(2 * e2 + 1) * DM] = (bf16_t)(yw >> 16); }
            }
        }
    }
    Aout = Ap; Uout = H;
}

template <bool FINAL>
__device__ __forceinline__ void scan_phase(const Args& a, LAS unsigned char* lds, int gw, int NGW, int wave, int lane) {
    unsigned char* ws = a.ws;
    const bf16_t* XA = (const bf16_t*)(ws + WS_XA); const bf16_t* ZA = (const bf16_t*)(ws + WS_ZA);
    const bf16_t* WG = (const bf16_t*)(ws + WS_WG);
    const float* conv_w = a.in[6]; const float* conv_b = a.in[7];
    typedef float f32x2 __attribute__((ext_vector_type(2)));
    f32x2* AGG = (f32x2*)(ws + WS_AGG);
    bf16_t* YA = (bf16_t*)(ws + WS_H);
    LAS bf16x8* afrL = (LAS bf16x8*)(lds + wave * 16384);
    const int n = lane & 31, hf = lane >> 5;
    bf16x8 idf[2];
#pragma unroll
    for (int k2 = 0; k2 < 2; ++k2)
#pragma unroll
        for (int jj = 0; jj < 8; ++jj) idf[k2][jj] = (16 * k2 + 8 * hf + jj == n) ? (short)0x3F80 : (short)0;
    for (int wt = gw; wt < 2048; wt += NGW) {
        const int cp = wt & 31, jb = (wt >> 5) & 15, b = wt >> 9, ch0 = jb * 64;
        { const int a_half = (n >> 2) & 1, a_idx = (n & 3) + 4 * (n >> 3), a_chunk = 2 * cp + a_half;
#pragma unroll 1
          for (int kk = 0; kk < 4; ++kk) { const int ch = ch0 + 16 * kk + 8 * hf;
              float cw[4][8], cb[8];
#pragma unroll
              for (int w = 0; w < 4; ++w) { const f32x4 c0 = *(const f32x4*)(conv_w + w * DM + ch), c1 = *(const f32x4*)(conv_w + w * DM + ch + 4);
#pragma unroll
                  for (int jj = 0; jj < 4; ++jj) { cw[w][jj] = c0[jj]; cw[w][4 + jj] = c1[jj]; } }
              { const f32x4 c0 = *(const f32x4*)(conv_b + ch), c1 = *(const f32x4*)(conv_b + ch + 4);
#pragma unroll
                  for (int jj = 0; jj < 4; ++jj) { cb[jj] = c0[jj]; cb[4 + jj] = c1[jj]; } }
#pragma unroll
              for (int s = 0; s < 4; ++s) { const int p = a_chunk * 64 + 16 * s + a_idx;
                  float acc[8];
#pragma unroll
                  for (int jj = 0; jj < 8; ++jj) acc[jj] = cb[jj];
#pragma unroll
                  for (int w = 0; w < 4; ++w) { const int pp = p + w - 2; const bool ok = (pp >= 0) && (pp < SEQ); const int pc = min(max(pp, 0), SEQ - 1);
                      const bf16x8 xv = *(const bf16x8*)(XA + ((size_t)b * SEQ + pc) * DM + ch);
#pragma unroll
                      for (int jj = 0; jj < 8; ++jj) acc[jj] = fmaf(cw[w][jj], ok ? bf2f((unsigned short)xv[jj]) : 0.f, acc[jj]); }
                  u32x4 pw; pw.x = pk2(acc[0], acc[1]); pw.y = pk2(acc[2], acc[3]); pw.z = pk2(acc[4], acc[5]); pw.w = pk2(acc[6], acc[7]);
                  afrL[(s * 4 + kk) * 64 + lane] = __builtin_bit_cast(bf16x8, pw); } } }
        LDS_WAIT(); asm volatile("" ::: "memory");
        const int chunk = 2 * cp + hf;
        if (FINAL) {
            const int tid = threadIdx.x, pdir = tid >> 8, pseg = (tid >> 6) & 3, pch = tid & 63, q = cp >> 3;
            LAS f32x2* segL = (LAS f32x2*)(lds + LDS_SEG);
            LAS float* cinL = (LAS float*)(lds + LDS_CIN);
            f32x2 g[16];
#pragma unroll
            for (int i = 0; i < 16; ++i) g[i] = AGG[((size_t)(b * 2 + pdir) * 64 + 16 * pseg + i) * DM + ch0 + pch];
            float As = 1.f, Us = 0.f;
#pragma unroll
            for (int ii = 0; ii < 16; ++ii) { const int i = pdir ? 15 - ii : ii; Us = fmaf(g[i][0], Us, g[i][1]); As *= g[i][0]; }
            __syncthreads();
            segL[(pdir * 4 + pseg) * 64 + pch] = (f32x2){As, Us};
            __syncthreads();
            if (pseg == q) { float Hc = 0.f;
                if (pdir == 0) { for (int s2 = 0; s2 < pseg; ++s2) { const f32x2 sg = segL[(0 * 4 + s2) * 64 + pch]; Hc = fmaf(sg[0], Hc, sg[1]); } }
                else { for (int s2 = 3; s2 > pseg; --s2) { const f32x2 sg = segL[(1 * 4 + s2) * 64 + pch]; Hc = fmaf(sg[0], Hc, sg[1]); } }
#pragma unroll
                for (int ii = 0; ii < 16; ++ii) { const int i = pdir ? 15 - ii : ii; cinL[(pdir * 16 + i) * 64 + pch] = Hc; Hc = fmaf(g[i][0], Hc, g[i][1]); } }
            __syncthreads();
        }
#pragma unroll 1
        for (int ct = 0; ct < 2; ++ct) { const int ch = ch0 + 32 * ct + n;
            float Af, Uf, Ab, Ub;
            unsigned hp[4][8];
            {
                const float br = -1.44269504089f * a.in[9][ch], bi = -1.44269504089f * a.in[11][ch]; const float lam = a.in[12][ch];
                const float cl = -8.f * 1.44269504089f * log1pf(expf(-lam));
                float Hin = 0.f;
                if (FINAL) Hin = ((const LAS float*)(lds + LDS_CIN))[(0 * 16 + (chunk & 15)) * 64 + 32 * ct + n];
                scan_dir<FINAL, 0>(afrL, lane, ct, WG + (size_t)(0 * 16 + jb) * 4096, WG + (size_t)(1 * 16 + jb) * 4096, br, bi, cl, Hin, idf, Af, Uf, ZA + ((size_t)b * SEQ + chunk * 64) * DM + ch, YA + ((size_t)b * SEQ + chunk * 64) * DM + ch, hp);
            }
            {
                const float br = -1.44269504089f * a.in[14][ch], bi = -1.44269504089f * a.in[16][ch]; const float lam = a.in[17][ch];
                const float cl = -8.f * 1.44269504089f * log1pf(expf(-lam));
                float Hin = 0.f;
                if (FINAL) Hin = ((const LAS float*)(lds + LDS_CIN))[(1 * 16 + (chunk & 15)) * 64 + 32 * ct + n];
                scan_dir<FINAL, 1>(afrL, lane, ct, WG + (size_t)(2 * 16 + jb) * 4096, WG + (size_t)(3 * 16 + jb) * 4096, br, bi, cl, Hin, idf, Ab, Ub, ZA + ((size_t)b * SEQ + chunk * 64) * DM + ch, YA + ((size_t)b * SEQ + chunk * 64) * DM + ch, hp);
            }
            if (!FINAL) {
                AGG[((size_t)(b * 2 + 0) * 64 + chunk) * DM + ch] = (f32x2){Af, Uf};
                AGG[((size_t)(b * 2 + 1) * 64 + chunk) * DM + ch] = (f32x2){Ab, Ub};
            }
        }
        LDS_WAIT(); asm volatile("" ::: "memory");
    }
}

__device__ __forceinline__ void final_norm(const Args& a, int gw, int NGW, int lane) {
    const float* x = a.in[0]; const float* g_final = a.in[22]; float* out = a.out;
    f32x4 g[4];
#pragma unroll
    for (int j = 0; j < 4; ++j) g[j] = *((const f32x4*)g_final + lane + 64 * j);
    for (int row = gw; row < MTOK; row += NGW) {
        f32x4* orow = (f32x4*)(out + (size_t)row * DM) + lane; const f32x4* xrow = (const f32x4*)(x + (size_t)row * DM) + lane;
        const bf16x4* brow = (const bf16x4*)((const bf16_t*)(a.ws + WS_ZB) + (size_t)row * DM) + lane;
        f32x4 v[4]; float ss = 0.f;
#pragma unroll
        for (int j = 0; j < 4; ++j) { const bf16x4 bb = brow[64 * j]; v[j] = xrow[64 * j];
            v[j][0] += bf2f((unsigned short)bb[0]); v[j][1] += bf2f((unsigned short)bb[1]); v[j][2] += bf2f((unsigned short)bb[2]); v[j][3] += bf2f((unsigned short)bb[3]);
            ss += (v[j][0] * v[j][0] + v[j][1] * v[j][1]) + (v[j][2] * v[j][2] + v[j][3] * v[j][3]); }
        const float rstd = __builtin_amdgcn_rsqf(wave_sum(ss) * (1.f / 1024.f) + 1e-6f);
#pragma unroll
        for (int j = 0; j < 4; ++j) orow[64 * j] = v[j] * rstd * g[j];
    }
}

#define XB_TMO      128
#define XB_XCNT(j)  (256  + 64 * (j))
#define XB_XSUB(j)  (1280 + 64 * (j))
#define XB_XGEN(j)  (2304 + 64 * (j))
#define XB_TOP      3328
#define XB_TOPGEN   3392
#define XCD_BAR_WORDS 3456
#define XB_SPIN_CAP (1u << 18)
__device__ __forceinline__ unsigned xb_ld(unsigned* p)              { return __hip_atomic_load(p, __ATOMIC_RELAXED, __HIP_MEMORY_SCOPE_AGENT); }
__device__ __forceinline__ unsigned xb_add(unsigned* p, unsigned v) { return __hip_atomic_fetch_add(p, v, __ATOMIC_RELAXED, __HIP_MEMORY_SCOPE_AGENT); }
__device__ __forceinline__ unsigned xb_xcc_id() { return (unsigned)__builtin_amdgcn_s_getreg((3 << 11) | 20) & 0xFu; }
#define XB_SPIN(cond, bar) do { unsigned _sp = 0; while (cond) { __builtin_amdgcn_s_sleep(1); \
    if ((++_sp & 255u) == 0u) { if (xb_ld(&(bar)[XB_TMO])) break; if (_sp > XB_SPIN_CAP) { atomicAdd(&(bar)[XB_TMO], 1u); break; } } } } while (0)
struct XcdBarrier { unsigned* bar; unsigned x; volatile LAS unsigned* st; };
__device__ __forceinline__ XcdBarrier xcd_barrier_post(unsigned* bar, volatile LAS unsigned* st) {
    XcdBarrier b; b.bar = bar; b.x = xb_xcc_id(); b.st = st;
    if (threadIdx.x == 0) (void)xb_add(&bar[XB_XCNT(b.x)], 1u);
    return b;
}
__device__ __forceinline__ void xcd_barrier_complete(unsigned* bar, unsigned x, unsigned& nloc, unsigned& nx) {
    const unsigned G = gridDim.x * gridDim.y * gridDim.z;
    unsigned sum, cnt, mine, sp = 0u;
    for (;;) {
        sum = 0u; cnt = 0u; mine = 0u;
#pragma unroll
        for (unsigned j = 0; j < 16; ++j) { const unsigned c = xb_ld(&bar[XB_XCNT(j)]); sum += c; cnt += (c > 0u) ? 1u : 0u; mine = (j == x) ? c : mine; }
        if (sum == G) break;
        __builtin_amdgcn_s_sleep(1);
        if ((++sp & 255u) == 0u) { if (xb_ld(&bar[XB_TMO])) break; if (sp > XB_SPIN_CAP) { atomicAdd(&bar[XB_TMO], 1u); break; } }
    }
    nloc = mine > 0u ? mine : 1u; nx = cnt > 0u ? cnt : 1u;
}
__device__ __forceinline__ void xcd_barrier(const XcdBarrier& b) {
    asm volatile("s_waitcnt vmcnt(0)" ::: "memory");
    __syncthreads();
    if (threadIdx.x == 0) {
        unsigned* bar = b.bar;
        __builtin_amdgcn_s_waitcnt(0);
        unsigned nloc = b.st[0], nx = b.st[1];
        if (nloc == 0u) { xcd_barrier_complete(bar, b.x, nloc, nx); b.st[0] = nloc; b.st[1] = nx; }
        const unsigned old = xb_add(&bar[XB_XSUB(b.x)], 1u);
        const unsigned gen = old / nloc;
        if (old + 1u == (gen + 1u) * nloc) {
            __builtin_amdgcn_fence(__ATOMIC_RELEASE, "agent");
            asm volatile("s_waitcnt vmcnt(0)" ::: "memory");
            const unsigned og = xb_add(&bar[XB_TOP], 1u);
            const unsigned tg = og / nx;
            if (og + 1u == (tg + 1u) * nx) xb_add(&bar[XB_TOPGEN], 1u);
            else XB_SPIN(xb_ld(&bar[XB_TOPGEN]) == tg, bar);
            __builtin_amdgcn_fence(__ATOMIC_ACQUIRE, "agent");
            xb_add(&bar[XB_XGEN(b.x)], 1u);
            asm volatile("s_waitcnt vmcnt(0)" ::: "memory");
        } else {
            XB_SPIN(xb_ld(&bar[XB_XGEN(b.x)]) == gen, bar);
            __builtin_amdgcn_fence(__ATOMIC_ACQUIRE, "agent");
            asm volatile("s_waitcnt vmcnt(0)" ::: "memory");
        }
    }
    __syncthreads();
}

__global__ void __launch_bounds__(512, 2) fwd_kernel(Args a) {
    extern __shared__ __attribute__((aligned(16))) unsigned char lds_raw[];
    LAS unsigned char* lds = (LAS unsigned char*)lds_raw;
    cg::grid_group grid = cg::this_grid();
    const int tid = threadIdx.x, lane = tid & 63, wave = __builtin_amdgcn_readfirstlane(tid >> 6);
    const int G = gridDim.x, bx = blockIdx.x;
    const int vcu = (G % 8 == 0) ? (bx % 8) * (G / 8) + bx / 8 : bx;
    const int gw = bx * 8 + wave, NGW = G * 8;
    unsigned char* ws = a.ws;
#ifdef PROBE_A0
    unsigned long long tA0 = 0, tA1 = 0, tB0 = 0, tB1 = 0;
#define STAMP(k) do { const unsigned long long _t = __builtin_amdgcn_s_memrealtime(); if ((k) == PROBE_A0) tA0 = _t; if ((k) == PROBE_A1) tA1 = _t; if ((k) == PROBE_B0) tB0 = _t; if ((k) == PROBE_B1) tB1 = _t; } while (0)
#else
#define STAMP(k) do {} while (0)
#endif
    STAMP(0);
    unsigned* barw = (unsigned*)(ws + WS_BAR);
    if (tid < 4) ((volatile LAS unsigned*)(lds + LDS_MISC))[tid] = 0u;
    __syncthreads();
    XcdBarrier xb = xcd_barrier_post(barw, (volatile LAS unsigned*)(lds + LDS_MISC));
    if (a.ws == nullptr) grid.sync();

#define PH(k) (!defined(ONLY) || ONLY == (k))
#if !defined(ONLY) || ONLY == 0
    p0_prologue(a, lds, gw, NGW, wave, lane);
#endif
    STAMP(1);
    xcd_barrier(xb);
    STAMP(2);
#if !defined(ONLY) || ONLY == 1
    p1_hpass(a, lds, G, tid, wave, lane);
#endif
    STAMP(3);
    xcd_barrier(xb);
    STAMP(4);
#if !defined(ONLY) || ONLY == 2
    {
        pg8::Gemm g{(const bf16_t*)(ws + WS_H), (const bf16_t*)(ws + WS_WIN), MTOK, 7168, 1024}; pg8::StaticOrder S; S.init(MTOK, 7168, G, bx);
        EpiProj E{(bf16_t*)(ws + WS_XA), (bf16_t*)a.out};
        pg8::gemm_phase<EpiProj, pg8::StaticOrder, PG8_ALIGN, PG8_SP2>(lds, g, S, E);
    }
    STAMP(5);
    {
        pg8::Gemm g{(const bf16_t*)(ws + WS_WV), (const bf16_t*)(ws + WS_H), 1024, MTOK, 1024}; pg8::StaticOrder S; S.init(1024, MTOK, G, bx);
        EpiPlain E{(bf16_t*)(ws + WS_VT), MTOK};
        pg8::gemm_phase<EpiPlain, pg8::StaticOrder, PG8_ALIGN, PG8_SP2>(lds, g, S, E);
    }
    STAMP(6);
#endif
    xcd_barrier(xb);
    STAMP(7);
#if !defined(ONLY) || ONLY == 3
    attn_phase((const bf16_t*)(ws + WS_Q), (const bf16_t*)(ws + WS_K), (const bf16_t*)(ws + WS_VT), (const bf16_t*)(ws + WS_ZB), a.in[18], (bf16_t*)(ws + WS_Q), lds, vcu, G, tid, wave, lane);
#endif
    STAMP(8);
#if !defined(ONLY) || ONLY == 4
    scan_phase<false>(a, lds, gw, NGW, wave, lane);
#endif
    STAMP(9);
    xcd_barrier(xb);
    STAMP(10);
#if !defined(ONLY) || ONLY == 5
    scan_phase<true>(a, lds, gw, NGW, wave, lane);
#endif
    STAMP(11);
    xcd_barrier(xb);
    STAMP(12);
#if !defined(ONLY) || ONLY == 6
    {
        pg8::Gemm g{(const bf16_t*)(ws + WS_H), (const bf16_t*)(ws + WS_WPA), MTOK, 1024, 1024, (const bf16_t*)(ws + WS_Q), (const bf16_t*)(ws + WS_WPB)}; pg8::PairOrder S; S.init(MTOK, 1024, G, bx);
        EpiGate2 E{(const bf16_t*)a.out, (const bf16_t*)a.out + ARR, (bf16_t*)(ws + WS_K), (bf16_t*)(ws + WS_XA)};
        pg8::gemm_phase<EpiGate2, pg8::PairOrder, PG8_ALIGN, PG8_SP2>(lds, g, S, E);
    }
    STAMP(14);
#endif
    xcd_barrier(xb);
    STAMP(15);
#if !defined(ONLY) || ONLY == 7
    {
        pg8::Gemm g{(const bf16_t*)(ws + WS_XA), (const bf16_t*)(ws + WS_WO), MTOK, 1024, 1024}; pg8::StaticOrder S; S.init(MTOK, 1024, G, bx);
        EpiOut E{(const float*)(ws + WS_GATE), (bf16_t*)(ws + WS_ZB)};
        pg8::gemm_phase<EpiOut, pg8::StaticOrder, PG8_ALIGN, PG8_SP2>(lds, g, S, E);
    }
    STAMP(16);
#endif
    xcd_barrier(xb);
    STAMP(17);
#if !defined(ONLY) || ONLY == 8
    final_norm(a, gw, NGW, lane);
#endif
#ifdef PROBE_A0
    STAMP(18);
    if (bx == 0) {
        const float dA = (float)(tA1 - tA0) * 0.01f, dB = (float)(tB1 - tB0) * 0.01f;
        __syncthreads();
        float* orow = a.out + (size_t)wave * DM;
        for (int i = lane; i < DM; i += 64) orow[i] += dB;
        __syncthreads();
        if (tid == 0) a.out[0] += dA;
    }
#endif
}

extern "C" void kernel_launch(void* const* d_in, const int* in_sizes, int n_in, void* d_out, int out_size, void* d_ws, size_t ws_size, hipStream_t stream) {
    static int grid = 0;
    if (grid == 0) {
        if (n_in != 23 || out_size != MTOK * DM || ws_size < 256 * MiB) { fprintf(stderr, "kernel_launch: unexpected problem shape (n_in %d, out %d, ws %zu)\n", n_in, out_size, ws_size); grid = -1; return; }
        int dev = 0, cus = 0, per_cu = 0;
        (void)hipGetDevice(&dev);
        (void)hipDeviceGetAttribute(&cus, hipDeviceAttributeMultiprocessorCount, dev);
        if (hipFuncSetAttribute((const void*)fwd_kernel, hipFuncAttributeMaxDynamicSharedMemorySize, LDS_BYTES) != hipSuccess) { fprintf(stderr, "kernel_launch: hipFuncSetAttribute failed\n"); grid = -1; return; }
        if (hipOccupancyMaxActiveBlocksPerMultiprocessor(&per_cu, (const void*)fwd_kernel, 512, LDS_BYTES) != hipSuccess || per_cu < 1) { fprintf(stderr, "kernel_launch: occupancy query failed (%d)\n", per_cu); per_cu = 1; (void)hipGetLastError(); }
        grid = cus * per_cu;
        if (grid <= 0) { grid = -1; return; }
    }
    if (grid < 0) return;
    Args a{};
    for (int i = 0; i < 23; ++i) a.in[i] = (const float*)d_in[i];
    a.out = (float*)d_out; a.ws = (unsigned char*)d_ws;
    void* args[] = {&a};
    if (hipMemsetAsync((unsigned char*)d_ws + WS_BAR, 0, XCD_BAR_WORDS * 4, stream) != hipSuccess) { fprintf(stderr, "kernel_launch: memset of the barrier words failed\n"); return; }
    hipError_t e = hipLaunchCooperativeKernel((const void*)fwd_kernel, dim3(grid), dim3(512), args, LDS_BYTES, stream);
    if (e != hipSuccess) fprintf(stderr, "kernel_launch: cooperative launch failed: %s (grid %d)\n", hipGetErrorString(e), grid);
}
```

```cpp
#include <hip/hip_runtime.h>
#include <hip/hip_cooperative_groups.h>
#include <cstdio>
#include <cstdint>
namespace cg = cooperative_groups;
namespace pg8 {
#define PG8_LAS __attribute__((address_space(3)))
typedef unsigned short bf16_t;
typedef short bf16x8 __attribute__((ext_vector_type(8)));
typedef float f32x4 __attribute__((ext_vector_type(4)));
typedef unsigned u32x4 __attribute__((ext_vector_type(4)));
constexpr int BM = 256, BK = 64, HALF = 128, HTB = HALF * BK * 2  , STAGE_BYTES = 8 * HTB, NXCD = 8, WGM = 8;

__host__ __device__ __forceinline__ int lds_byte(int r, int c) { const int st = (r >> 4) * 2 + (c >> 5), rr = r & 15, cc = c & 31, ob = rr * 64 + cc * 2; return st * 1024 + (ob ^ (((ob >> 9) & 1) << 5)); }
__host__ __device__ __forceinline__ void stage_rc(int b, int& R, int& C) { const int st = b / 1024, sb = b % 1024, swz = sb ^ (((sb >> 9) & 1) << 5); R = (st >> 1) * 16 + swz / 64; C = (st & 1) * 32 + (swz % 64) / 2; }
__host__ __device__ __forceinline__ int perm32(int rho) { const int n = rho >> 4, i = rho & 15; return 8 * (i >> 2) + 4 * n + (i & 3); }

struct Unit { int pm, pn, w; };
struct Gemm { const bf16_t* A; const bf16_t* Bt; int M, N, K; const bf16_t* A2; const bf16_t* Bt2; };

struct StaticOrder {
    int nM, nN, nwg, G, c;
    __host__ __device__ void init(int M, int N, int G_, int c_) { nM = M / BM; nN = N / BM; nwg = nM * nN; G = G_; c = c_; }
    __host__ __device__ bool next(int i, Unit& u) const {
        const long L = (long)i * G + c; if (L >= nwg) return false;
        int wgid = (int)L; { const int q = nwg / NXCD, r = nwg % NXCD, xcd = wgid % NXCD, off = wgid / NXCD; wgid = (xcd < r ? xcd * (q + 1) : r * (q + 1) + (xcd - r) * q) + off; }
        const int nig = WGM * nN, gid = wgid / nig, fm = gid * WGM, gsz = (nM - fm) < WGM ? (nM - fm) : WGM;
        u.pm = fm + ((wgid % nig) % gsz); u.pn = (wgid % nig) / gsz; u.w = 0; return true;
    }
    __device__ __forceinline__ void a_ready(const Unit&) const {}
    __device__ __forceinline__ void done(const Unit&) const {}
};
struct ChainOrder {
    StaticOrder s0, s1; int n0;
    __host__ __device__ void init(int M0, int N0, int M1, int N1, int G, int c) { s0.init(M0, N0, G, c); s1.init(M1, N1, G, c); n0 = 0; Unit t; while (s0.next(n0, t)) ++n0; }
    __host__ __device__ bool next(int i, Unit& u) const { if (i < n0) return s0.next(i, u); if (!s1.next(i - n0, u)) return false; u.w = 1; return true; }
    __device__ __forceinline__ void a_ready(const Unit&) const {}
    __device__ __forceinline__ void done(const Unit&) const {}
};
struct PairOrder : StaticOrder {
    __host__ __device__ bool next(int i, Unit& u) const { if (!StaticOrder::next(i >> 1, u)) return false; u.w = i & 1; return true; }
};
__device__ __forceinline__ unsigned cvt_pk_bf16(float lo, float hi) { unsigned r; asm volatile("v_cvt_pk_bf16_f32 %0, %1, %2" : "=v"(r) : "v"(lo), "v"(hi)); return r; }
typedef float f32x2 __attribute__((ext_vector_type(2)));
template <class Epi, class Sched, bool ALIGN_EPI = false, bool SP2 = false>
__device__ __forceinline__ void gemm_phase(PG8_LAS unsigned char* lds, const Gemm g, const Sched& S, const Epi& E) {
    const int tid = threadIdx.x, wid = __builtin_amdgcn_readfirstlane(tid >> 6), lane = tid & 63, wr = wid >> 2, wc = wid & 3, fr = lane & 15, fq = lane >> 4;
    const int K = g.K, nt = K / BK;
    unsigned voffA[2], voffB[2];
#pragma unroll
    for (int i = 0; i < 2; ++i) { int R, C; stage_rc(tid * 16 + i * 8192, R, C); const int Rb = Epi::PERM ? ((R & ~31) + perm32(R & 31)) : R;
        voffA[i] = (unsigned)(R * K + C) * 2u; voffB[i] = (unsigned)(Rb * K + C) * 2u; }
    const size_t kstep = (size_t)(BK * 2);
    const size_t hstep = (size_t)HALF * K * 2;
    const size_t tstep = 2 * hstep;
    const unsigned ldsw = (unsigned)wid * 1024u;
    const int aoff = lds_byte(wr * 64 + fr, fq * 8), boff = lds_byte(wc * 32 + fr, fq * 8);
#define PG8_SA(b, h) (((b) * 2 + (h)) * HTB)
#define PG8_SB(b, h) ((4 + (b) * 2 + (h)) * HTB)
#define PG8_STAGE(bufoff, gbase, voff) do { _Pragma("unroll") for (int _i = 0; _i < 2; ++_i) \
        __builtin_amdgcn_global_load_lds((const unsigned*)((const char*)(gbase) + (voff)[_i]), (PG8_LAS unsigned*)(lds + (bufoff) + ldsw + _i * 8192), 16, 0, 0); } while (0)
#define PG8_LDA(dst, b, h) do { _Pragma("unroll") for (int m = 0; m < 4; ++m) _Pragma("unroll") for (int k = 0; k < 2; ++k) dst[m][k] = *(const PG8_LAS bf16x8*)(lds + PG8_SA(b, h) + aoff + m * 2048 + k * 1024); } while (0)
#define PG8_LDB(dst, b, h) do { _Pragma("unroll") for (int n = 0; n < 2; ++n) _Pragma("unroll") for (int k = 0; k < 2; ++k) dst[n][k] = *(const PG8_LAS bf16x8*)(lds + PG8_SB(b, h) + boff + n * 2048 + k * 1024); } while (0)
#define PG8_MMA(ai, bj, At, Bt) do { __builtin_amdgcn_s_setprio(1); _Pragma("unroll") for (int m = 0; m < 4; ++m) _Pragma("unroll") for (int n = 0; n < 2; ++n) _Pragma("unroll") for (int k = 0; k < 2; ++k) \
        acc[ai][bj][m][n] = __builtin_amdgcn_mfma_f32_16x16x32_bf16(Bt[n][k], At[m][k], acc[ai][bj][m][n], 0, 0, 0); __builtin_amdgcn_s_setprio(0); } while (0)
#define PG8_WAIT_V(n) asm volatile("s_waitcnt vmcnt(" #n ")" ::: "memory")
#define PG8_WAIT_L(n) asm volatile("s_waitcnt lgkmcnt(" #n ")" ::: "memory")
#define PG8_BAR __builtin_amdgcn_s_barrier()
#define PG8_SCHED __builtin_amdgcn_sched_barrier(0)
    Unit cur, nxt; int ui = 0;
    if (!S.next(0, cur)) return;
    f32x4 acc[2][2][4][2];
#pragma unroll
    for (int a = 0; a < 2; ++a)
#pragma unroll
        for (int b = 0; b < 2; ++b)
#pragma unroll
            for (int m = 0; m < 4; ++m)
#pragma unroll
                for (int n = 0; n < 2; ++n) acc[a][b][m][n] = (f32x4){0.f, 0.f, 0.f, 0.f};
    bf16x8 At[4][2], B0[2][2], B1[2][2];
    const char* cA = (const char*)(cur.w ? g.A2 : g.A) + (size_t)cur.pm * tstep; const char* cB = (const char*)(cur.w ? g.Bt2 : g.Bt) + (size_t)cur.pn * tstep;
    S.a_ready(cur);
    if constexpr (SP2) {
        PG8_STAGE(PG8_SB(0, 0), cB, voffB); PG8_STAGE(PG8_SB(0, 1), cB + hstep, voffB); PG8_STAGE(PG8_SA(0, 0), cA, voffA); PG8_STAGE(PG8_SA(0, 1), cA + hstep, voffA);
        if (wr == 1) PG8_BAR;
        PG8_WAIT_V(2); PG8_BAR;
        PG8_STAGE(PG8_SB(1, 0), cB + kstep, voffB); PG8_STAGE(PG8_SA(1, 0), cA + kstep, voffA); PG8_STAGE(PG8_SB(1, 1), cB + hstep + kstep, voffB);
        PG8_WAIT_V(6); PG8_BAR;
    } else {
        PG8_STAGE(PG8_SB(0, 0), cB, voffB); PG8_STAGE(PG8_SA(0, 0), cA, voffA); PG8_STAGE(PG8_SB(0, 1), cB + hstep, voffB); PG8_STAGE(PG8_SA(0, 1), cA + hstep, voffA);
        if (wr == 1) PG8_BAR;
        PG8_WAIT_V(4); PG8_BAR;
        PG8_STAGE(PG8_SB(1, 0), cB + kstep, voffB); PG8_STAGE(PG8_SA(1, 0), cA + kstep, voffA); PG8_STAGE(PG8_SB(1, 1), cB + hstep + kstep, voffB);
        PG8_WAIT_V(6); PG8_BAR;
    }
    for (;;) {
        const bool has_next = S.next(ui + 1, nxt);
        const char* nA = has_next ? (const char*)(nxt.w ? g.A2 : g.A) + (size_t)nxt.pm * tstep : cA; const char* nB = has_next ? (const char*)(nxt.w ? g.Bt2 : g.Bt) + (size_t)nxt.pn * tstep : cB;
        for (int t = 0; t < nt; t += 2) {
            const bool last = (t == nt - 2);
            const char* a1 = cA + (size_t)(t + 1) * kstep;
            const char* a2 = last ? nA : cA + (size_t)(t + 2) * kstep; const char* b2 = last ? nB : cB + (size_t)(t + 2) * kstep;
            const char* a3 = a2 + kstep; const char* b3 = b2 + kstep;
            if (last && has_next) S.a_ready(nxt);
            if constexpr (SP2) {
            PG8_LDB(B0, 0, 0); PG8_LDB(B1, 0, 1); PG8_SCHED; PG8_LDA(At, 0, 0); PG8_STAGE(PG8_SA(1, 1), a1 + hstep, voffA);
            PG8_WAIT_V(8); PG8_WAIT_L(0); PG8_BAR; PG8_MMA(0, 0, At, B0); PG8_MMA(0, 1, At, B1); PG8_BAR; PG8_SCHED;
            PG8_LDA(At, 0, 1); PG8_STAGE(PG8_SB(0, 0), b2, voffB); PG8_STAGE(PG8_SB(0, 1), b2 + hstep, voffB); PG8_STAGE(PG8_SA(0, 0), a2, voffA);
            PG8_WAIT_V(8); PG8_WAIT_L(0); PG8_BAR; PG8_MMA(1, 0, At, B0); PG8_MMA(1, 1, At, B1); PG8_BAR; PG8_SCHED;
            PG8_LDB(B0, 1, 0); PG8_LDB(B1, 1, 1); PG8_SCHED; PG8_LDA(At, 1, 0); PG8_STAGE(PG8_SA(0, 1), a2 + hstep, voffA);
            PG8_WAIT_V(8); PG8_WAIT_L(0); PG8_BAR; PG8_MMA(0, 0, At, B0); PG8_MMA(0, 1, At, B1); PG8_BAR; PG8_SCHED;
            PG8_LDA(At, 1, 1); PG8_STAGE(PG8_SB(1, 0), b3, voffB); PG8_STAGE(PG8_SB(1, 1), b3 + hstep, voffB); PG8_STAGE(PG8_SA(1, 0), a3, voffA);
            PG8_WAIT_V(8); PG8_WAIT_L(0); PG8_BAR; PG8_MMA(1, 0, At, B0); PG8_MMA(1, 1, At, B1); PG8_BAR; PG8_SCHED;
            } else {
            PG8_LDB(B0, 0, 0); PG8_SCHED; PG8_LDA(At, 0, 0); PG8_STAGE(PG8_SA(1, 1), a1 + hstep, voffA);
            PG8_WAIT_L(8); PG8_BAR; PG8_WAIT_L(0); PG8_MMA(0, 0, At, B0); PG8_BAR; PG8_SCHED;
            PG8_LDB(B1, 0, 1); PG8_STAGE(PG8_SB(0, 0), b2, voffB);
            PG8_BAR; PG8_WAIT_L(0); PG8_MMA(0, 1, At, B1); PG8_BAR;
            PG8_LDA(At, 0, 1); PG8_STAGE(PG8_SA(0, 0), a2, voffA);
            PG8_BAR; PG8_WAIT_L(0); PG8_MMA(1, 0, At, B0); PG8_BAR; PG8_SCHED;
            PG8_STAGE(PG8_SB(0, 1), b2 + hstep, voffB);
            PG8_WAIT_V(6); PG8_BAR; PG8_MMA(1, 1, At, B1); PG8_BAR;
            PG8_LDB(B0, 1, 0); PG8_SCHED; PG8_LDA(At, 1, 0); PG8_STAGE(PG8_SA(0, 1), a2 + hstep, voffA);
            PG8_WAIT_L(8); PG8_BAR; PG8_WAIT_L(0); PG8_MMA(0, 0, At, B0); PG8_BAR; PG8_SCHED;
            PG8_LDB(B1, 1, 1); PG8_STAGE(PG8_SB(1, 0), b3, voffB);
            PG8_BAR; PG8_WAIT_L(0); PG8_MMA(0, 1, At, B1); PG8_BAR;
            PG8_LDA(At, 1, 1); PG8_STAGE(PG8_SA(1, 0), a3, voffA);
            PG8_BAR; PG8_WAIT_L(0); PG8_MMA(1, 0, At, B0); PG8_BAR; PG8_SCHED;
            PG8_STAGE(PG8_SB(1, 1), b3 + hstep, voffB);
            PG8_WAIT_V(6); PG8_BAR; PG8_MMA(1, 1, At, B1); PG8_BAR;
            }
        }
        if constexpr (ALIGN_EPI) { if (wr == 0) PG8_BAR; }
        if constexpr (!Epi::AFTER_DRAIN) { E(acc, cur, wr, wc, fr, fq); S.done(cur); }
        if (!has_next) break;
#pragma unroll
        for (int a = 0; a < 2; ++a)
#pragma unroll
            for (int b = 0; b < 2; ++b)
#pragma unroll
                for (int m = 0; m < 4; ++m)
#pragma unroll
                    for (int n = 0; n < 2; ++n) acc[a][b][m][n] = (f32x4){0.f, 0.f, 0.f, 0.f};
        cur = nxt; cA = nA; cB = nB; ++ui;
        if constexpr (ALIGN_EPI) { if (wr == 1) PG8_BAR; }
    }
    PG8_WAIT_V(0);
    if constexpr (!ALIGN_EPI) { if (wr == 0) PG8_BAR; }
    PG8_BAR;
    if constexpr (Epi::AFTER_DRAIN) { E.fused(acc, cur, wr, wc, fr, fq, lds, wid, lane); S.done(cur); }
#undef PG8_SA
#undef PG8_SB
#undef PG8_STAGE
#undef PG8_LDA
#undef PG8_LDB
#undef PG8_MMA
#undef PG8_WAIT_V
#undef PG8_WAIT_L
#undef PG8_BAR
#undef PG8_SCHED
}
}
#ifndef PG8_SP2
#define PG8_SP2 true
#endif
#ifndef PG8_ALIGN
#define PG8_ALIGN true
#endif

#define LAS __attribute__((address_space(3)))
typedef unsigned short bf16_t;
typedef short bf16x8 __attribute__((ext_vector_type(8)));
typedef short bf16x4 __attribute__((ext_vector_type(4)));
typedef float f32x4 __attribute__((ext_vector_type(4)));
typedef float f32x16 __attribute__((ext_vector_type(16)));
typedef unsigned u32x4 __attribute__((ext_vector_type(4)));
typedef unsigned u32x2 __attribute__((ext_vector_type(2)));

constexpr int MTOK = 16384, DM = 1024, SEQ = 4096, NB = 4;
constexpr size_t MiB = 1u << 20;
constexpr size_t ARR = (size_t)MTOK * DM;
constexpr size_t WS_MODP = 0;
constexpr size_t WS_GATE = 786432;
constexpr size_t WS_AGG = 1 * MiB;
constexpr size_t WS_RSS = 5 * MiB;
constexpr size_t WS_WG = 6 * MiB;
constexpr size_t WS_WPA = 8 * MiB, WS_WPB = 10 * MiB, WS_WO = 12 * MiB, WS_WV = 14 * MiB;
constexpr size_t WS_WIN = 16 * MiB;
constexpr size_t WS_H = 32 * MiB;
constexpr size_t WS_XA = 64 * MiB, WS_ZA = 96 * MiB, WS_Q = 128 * MiB, WS_K = 160 * MiB, WS_ZB = 192 * MiB;
constexpr size_t WS_VT = 224 * MiB;
constexpr size_t WS_BAR = 802816;
constexpr int LDS_CIN = 131072, LDS_SEG = 131072 + 8192;
constexpr int LDS_MISC = 147456, LDS_RPB = 147456 + 256;
constexpr int LDS_BYTES = 147456 + 256 + 3840;

__device__ __forceinline__ float bf2f(unsigned short b) { return __uint_as_float(((unsigned)b) << 16); }
__device__ __forceinline__ unsigned pk2(float lo, float hi) { return pg8::cvt_pk_bf16(lo, hi); }
__device__ __forceinline__ float sigm(float v) { return __builtin_amdgcn_rcpf(1.f + __builtin_amdgcn_exp2f(-1.44269504089f * v)); }
__device__ __forceinline__ float wave_sum(float v) {
#pragma unroll
    for (int o = 1; o < 64; o <<= 1) v += __shfl_xor(v, o);
    return v;
}
#define LDS_WAIT() asm volatile("s_waitcnt lgkmcnt(0)" ::: "memory")

struct EpiProj {
    static constexpr bool PERM = true, AFTER_DRAIN = false;
    bf16_t* O5; bf16_t* OG;
    __device__ __forceinline__ void operator()(const f32x4 (&acc)[2][2][4][2], const pg8::Unit& u, int wr, int wc, int fr, int fq) const {
        const int arr = u.pn >> 2, colt = (u.pn & 3) * 256;
        bf16_t* base = arr < 5 ? O5 + (size_t)arr * ARR : OG + (size_t)(arr - 5) * ARR;
        const int mode = (arr == 1 || arr == 4) ? 1 : (arr >= 5 ? 2 : (arr == 2 ? 3 : 0));
        const int row0 = u.pm * 256 + wr * 64 + fr, col0 = colt + wc * 32 + 8 * fq;
#pragma unroll
        for (int ai = 0; ai < 2; ++ai)
#pragma unroll
            for (int m = 0; m < 4; ++m) { bf16_t* rowp = base + (size_t)(row0 + ai * 128 + m * 16) * DM + col0;
#pragma unroll
                for (int bj = 0; bj < 2; ++bj) { f32x4 v0 = acc[ai][bj][m][0], v1 = acc[ai][bj][m][1];
                    if (mode == 1) {
#pragma unroll
                        for (int j = 0; j < 4; ++j) { v0[j] = v0[j] * sigm(v0[j]); v1[j] = v1[j] * sigm(v1[j]); } }
                    else if (mode == 2) {
#pragma unroll
                        for (int j = 0; j < 4; ++j) { v0[j] = sigm(v0[j]); v1[j] = sigm(v1[j]); } }
                    else if (mode == 3) { v0 = v0 * (0.125f * 1.44269504089f); v1 = v1 * (0.125f * 1.44269504089f); }
                    u32x4 w; w.x = pk2(v0[0], v0[1]); w.y = pk2(v0[2], v0[3]); w.z = pk2(v1[0], v1[1]); w.w = pk2(v1[2], v1[3]);
                    *(u32x4*)(rowp + bj * 128) = w; } }
    }
};
struct EpiPlain {
    static constexpr bool PERM = true, AFTER_DRAIN = false;
    bf16_t* O; int ldc;
    __device__ __forceinline__ void operator()(const f32x4 (&acc)[2][2][4][2], const pg8::Unit& u, int wr, int wc, int fr, int fq) const {
        const int row0 = u.pm * 256 + wr * 64 + fr, col0 = u.pn * 256 + wc * 32 + 8 * fq;
#pragma unroll
        for (int ai = 0; ai < 2; ++ai)
#pragma unroll
            for (int m = 0; m < 4; ++m) { bf16_t* rowp = O + (size_t)(row0 + ai * 128 + m * 16) * ldc + col0;
#pragma unroll
                for (int bj = 0; bj < 2; ++bj) { const f32x4 v0 = acc[ai][bj][m][0], v1 = acc[ai][bj][m][1];
                    u32x4 w; w.x = pk2(v0[0], v0[1]); w.y = pk2(v0[2], v0[3]); w.z = pk2(v1[0], v1[1]); w.w = pk2(v1[2], v1[3]);
                    *(u32x4*)(rowp + bj * 128) = w; } }
    }
};
struct EpiProjVT {
    static constexpr bool PERM = true, AFTER_DRAIN = false;
    EpiProj p; EpiPlain v;
    __device__ __forceinline__ void operator()(const f32x4 (&acc)[2][2][4][2], const pg8::Unit& u, int wr, int wc, int fr, int fq) const { if (u.w) v(acc, u, wr, wc, fr, fq); else p(acc, u, wr, wc, fr, fq); }
};
struct EpiGate2 {
    static constexpr bool PERM = true, AFTER_DRAIN = false;
    const bf16_t* Ga; const bf16_t* Gb; bf16_t* Tb; bf16_t* O;
    __device__ __forceinline__ void operator()(const f32x4 (&acc)[2][2][4][2], const pg8::Unit& u, int wr, int wc, int fr, int fq) const {
        const int row0 = u.pm * 256 + wr * 64 + fr, col0 = u.pn * 256 + wc * 32 + 8 * fq;
        const bf16_t* G = u.w ? Gb : Ga; bf16_t* dst = u.w ? O : Tb;
#pragma unroll
        for (int ai = 0; ai < 2; ++ai) {
            bf16x8 g[4][2], t[4][2];
#pragma unroll
            for (int m = 0; m < 4; ++m)
#pragma unroll
                for (int bj = 0; bj < 2; ++bj) { const size_t off = (size_t)(row0 + ai * 128 + m * 16) * DM + col0 + bj * 128;
                    g[m][bj] = *(const bf16x8*)(G + off);
                    if (u.w) t[m][bj] = *(const bf16x8*)(Tb + off); else t[m][bj] = (bf16x8){0, 0, 0, 0, 0, 0, 0, 0}; }
            asm volatile("" ::: "memory");
#pragma unroll
            for (int m = 0; m < 4; ++m)
#pragma unroll
                for (int bj = 0; bj < 2; ++bj) { const size_t off = (size_t)(row0 + ai * 128 + m * 16) * DM + col0 + bj * 128;
                    const f32x4 v0 = acc[ai][bj][m][0], v1 = acc[ai][bj][m][1];
                    float o[8];
#pragma unroll
                    for (int j = 0; j < 4; ++j) { o[j] = fmaf(bf2f((unsigned short)g[m][bj][j]), v0[j], bf2f((unsigned short)t[m][bj][j])); o[4 + j] = fmaf(bf2f((unsigned short)g[m][bj][4 + j]), v1[j], bf2f((unsigned short)t[m][bj][4 + j])); }
                    u32x4 w; w.x = pk2(o[0], o[1]); w.y = pk2(o[2], o[3]); w.z = pk2(o[4], o[5]); w.w = pk2(o[6], o[7]);
                    *(u32x4*)(dst + off) = w; }
            asm volatile("" ::: "memory");
        }
    }
};
struct EpiOut {
    static constexpr bool PERM = true, AFTER_DRAIN = false;
    const float* gate; bf16_t* O;
    __device__ __forceinline__ void operator()(const f32x4 (&acc)[2][2][4][2], const pg8::Unit& u, int wr, int wc, int fr, int fq) const {
        const int row0 = u.pm * 256 + wr * 64 + fr, col0 = u.pn * 256 + wc * 32 + 8 * fq;
        const float* gp = gate + (size_t)(u.pm >> 4) * DM + col0;
        f32x4 gv[2][2];
#pragma unroll
        for (int bj = 0; bj < 2; ++bj)
#pragma unroll
            for (int n = 0; n < 2; ++n) gv[bj][n] = *(const f32x4*)(gp + bj * 128 + n * 4);
#pragma unroll
        for (int ai = 0; ai < 2; ++ai)
#pragma unroll
            for (int m = 0; m < 4; ++m) { bf16_t* rowp = O + (size_t)(row0 + ai * 128 + m * 16) * DM + col0;
#pragma unroll
                for (int bj = 0; bj < 2; ++bj) { const f32x4 v0 = gv[bj][0] * acc[ai][bj][m][0], v1 = gv[bj][1] * acc[ai][bj][m][1];
                    u32x4 w; w.x = pk2(v0[0], v0[1]); w.y = pk2(v0[2], v0[3]); w.z = pk2(v1[0], v1[1]); w.w = pk2(v1[2], v1[3]);
                    *(u32x4*)(rowp + bj * 128) = w; } }
    }
};

__device__ __forceinline__ void p0_transpose_item(const float* W, int K, int N, bf16_t* WT, int dst_row0, int k0, int n0, LAS float* scr, int lane, float scale = 1.f) {
    float wv[32];
#pragma unroll
    for (int i = 0; i < 32; ++i) { const int kk = 2 * i + (lane >> 5); wv[i] = W[(size_t)(k0 + kk) * N + n0 + (lane & 31)]; }
#pragma unroll
    for (int i = 0; i < 32; ++i) { const int kk = 2 * i + (lane >> 5); scr[kk * 33 + (lane & 31)] = wv[i] * scale; }
    LDS_WAIT(); asm volatile("" ::: "memory");
    const int c = lane & 7;
#pragma unroll
    for (int j = 0; j < 4; ++j) { const int n = (lane >> 3) + 8 * j; const LAS float* s = scr + (8 * c) * 33 + n;
        u32x4 o; o.x = pk2(s[0 * 33], s[1 * 33]); o.y = pk2(s[2 * 33], s[3 * 33]); o.z = pk2(s[4 * 33], s[5 * 33]); o.w = pk2(s[6 * 33], s[7 * 33]);
        *(u32x4*)(WT + (size_t)(dst_row0 + n) * K + k0 + 8 * c) = o; }
    LDS_WAIT(); asm volatile("" ::: "memory");
}

struct Args { const float* in[23]; float* out; unsigned char* ws; };

__device__ __forceinline__ void p0_prologue(const Args& a, LAS unsigned char* lds, int gw, int NGW, int wave, int lane) {
    LAS float* scr = (LAS float*)(lds + wave * 16384);
    unsigned char* ws = a.ws;
    const float* c = a.in[1]; const float* w_c = a.in[3]; const float* w_in = a.in[5];
    float* modp = (float*)(ws + WS_MODP);
    constexpr int I_MOD = 768, I_IN = 16 * 256, I_SQ = 16 * 32, I_G = 4 * 16 * 2;
    constexpr int NITEMS = I_MOD + I_IN + 3 * I_SQ + I_G;
    for (int it = gw; it < NITEMS; it += NGW) {
        int r = it;
        if (r < I_MOD) {
            const int cgi = r % 48, kc = r / 48, col = cgi * 64 + lane, k0 = kc * 64;
            float sv[4];
#pragma unroll
            for (int b = 0; b < 4; ++b) { const float cv = c[b * DM + k0 + lane]; sv[b] = cv * sigm(cv); }
            float acc[4] = {0.f, 0.f, 0.f, 0.f};
#pragma unroll 32
            for (int kk = 0; kk < 64; ++kk) { const float w = w_c[(size_t)(k0 + kk) * 3072 + col];
#pragma unroll
                for (int b = 0; b < 4; ++b) acc[b] += __shfl(sv[b], kk) * w; }
#pragma unroll
            for (int b = 0; b < 4; ++b) modp[(size_t)(kc * 4 + b) * 3072 + col] = acc[b];
            continue;
        }
        r -= I_MOD;
        if (r < I_IN) { const int kb = r / 256, nb = r % 256, n0 = nb * 32, cb = n0 >> 10;
            if (cb == 4) p0_transpose_item(w_in, 1024, 8192, (bf16_t*)(ws + WS_WV), n0 - 4096, kb * 64, n0, scr, lane);
            else p0_transpose_item(w_in, 1024, 8192, (bf16_t*)(ws + WS_WIN), (cb < 4 ? cb : cb - 1) * 1024 + (n0 & 1023), kb * 64, n0, scr, lane);
            continue; }
        r -= I_IN;
        if (r < 3 * I_SQ) { const int which = r / I_SQ, rr = r % I_SQ, kb = rr / 32, nb = rr % 32;
            const float* W = which == 0 ? a.in[19] : (which == 1 ? a.in[20] : a.in[21]);
            bf16_t* WT = (bf16_t*)(ws + (which == 0 ? WS_WPA : (which == 1 ? WS_WPB : WS_WO)));
            p0_transpose_item(W, 1024, 1024, WT, nb * 32, kb * 64, nb * 32, scr, lane);
            continue; }
        r -= 3 * I_SQ;
        { const int g = r / 32, rr = r % 32, hb = rr / 2, nb = rr % 2;
            const float* W = (g == 0 ? a.in[8] : (g == 1 ? a.in[10] : (g == 2 ? a.in[13] : a.in[15]))) + (size_t)hb * 4096;
            bf16_t* WT = (bf16_t*)(ws + WS_WG) + (size_t)(g * 16 + hb) * 4096;
            p0_transpose_item(W, 64, 64, WT, nb * 32, 0, nb * 32, scr, lane, -1.44269504089f); }
    }
}

__device__ __forceinline__ void p1_hpass(const Args& a, LAS unsigned char* lds, int G, int tid, int wave, int lane) {
    unsigned char* ws = a.ws;
    const float* x = a.in[0]; const float* g_pre = a.in[2]; const float* b_c = a.in[4];
    const float* modp = (const float*)(ws + WS_MODP);
    bf16_t* H = (bf16_t*)(ws + WS_H);
    LAS float* sh = (LAS float*)lds;
    for (int rb = blockIdx.x; rb < MTOK / 64; rb += G) {
        const int b = rb >> 6;
        __syncthreads();
        for (int idx = tid; idx < 2048; idx += 512) { float s = b_c[idx];
#pragma unroll
            for (int kc = 0; kc < 16; ++kc) s += modp[(size_t)(kc * 4 + b) * 3072 + idx];
            sh[idx] = idx < 1024 ? s : 1.f + s; }
        __syncthreads();
        for (int rr = wave; rr < 64; rr += 16) {
            const int row0 = rb * 64 + rr;
            f32x4 v[2][4]; float s[2] = {0.f, 0.f};
#pragma unroll
            for (int q = 0; q < 2; ++q) { const f32x4* xr = (const f32x4*)(x + (size_t)(row0 + 8 * q) * DM) + lane;
#pragma unroll
                for (int j = 0; j < 4; ++j) v[q][j] = xr[64 * j]; }
#pragma unroll
            for (int q = 0; q < 2; ++q)
#pragma unroll
                for (int j = 0; j < 4; ++j) s[q] += (v[q][j][0] * v[q][j][0] + v[q][j][1] * v[q][j][1]) + (v[q][j][2] * v[q][j][2] + v[q][j][3] * v[q][j][3]);
#pragma unroll
            for (int q = 0; q < 2; ++q) { const float rstd = __builtin_amdgcn_rsqf(wave_sum(s[q]) * (1.f / 1024.f) + 1e-6f);
#pragma unroll
                for (int j = 0; j < 4; ++j) { const int col = 4 * lane + 256 * j;
                    const f32x4 g = *(const f32x4*)(g_pre + col); const f32x4 sc = *(const LAS f32x4*)(sh + 1024 + col); const f32x4 sf = *(const LAS f32x4*)(sh + col);
                    const f32x4 o = (v[q][j] * rstd) * g * sc + sf;
                    u32x2 w; w.x = pk2(o[0], o[1]); w.y = pk2(o[2], o[3]);
                    *(u32x2*)(H + (size_t)(row0 + 8 * q) * DM + col) = w; } }
        }
    }
    float* gate = (float*)(ws + WS_GATE);
    for (int idx = blockIdx.x * 512 + tid; idx < 4096; idx += G * 512) { const int b = idx >> 10, col = idx & 1023; float s = b_c[2048 + col];
#pragma unroll
        for (int kc = 0; kc < 16; ++kc) s += modp[(size_t)(kc * 4 + b) * 3072 + 2048 + col];
        gate[idx] = s; }
}

__device__ __forceinline__ int attn_fk(int col) { return ((col >> 1) & 1) | (((col >> 3) & 3) << 1); }
__device__ __forceinline__ void attn_phase(const bf16_t* Q, const bf16_t* Kb, const bf16_t* VT, const bf16_t* ZB, const float* rpb, bf16_t* YB, LAS unsigned char* lds, int vcu, int G, int tid, int wave, int lane) {
    const int fr = lane & 15, fq = lane >> 4;
    constexpr float L2E = 1.44269504089f;
    LAS float* rpbL = (LAS float*)(lds + LDS_RPB);
    const int rsel = wave >> 2, j = wave & 3;
    const int cs = min(max(16 * j - 8, 0), 32);
    const int qc = 16 * j + fr, c0 = min(max(qc - 8, 0), 48);
    const int lcol = tid >> 3, lch = tid & 7;
    float maskadd[8];
#pragma unroll
    for (int e = 0; e < 8; ++e) { const int kcol = cs + 8 * fq + e; maskadd[e] = ((kcol >= c0) && (kcol < c0 + 16)) ? 0.f : -1e30f; }
    const int rpoff = cs + 8 * fq - qc + 31;
    for (int u = vcu; u < 256; u += G) {
        const int band = u & 3, h = (u >> 2) & 15, b = u >> 6, R0 = band * 16;
        __syncthreads();
        for (int i = tid; i < 15 * 64; i += 512) { const int dr = i >> 6, dc = (i & 63) - 16; rpbL[i] = (dc >= 0 && dc < 31) ? rpb[(size_t)(h * 15 + dr) * 31 + dc] * L2E : 0.f; }
        int loaded_hi = -1;
#pragma unroll 1
        for (int ss = 0; ss < 8; ++ss) {
            const int r = R0 + 2 * ss;
            const int lo = min(max(r - 4, 0), 56), hi = min(max(r - 3, 0), 56) + 7;
            const int first = loaded_hi < 0 ? lo : loaded_hi + 1;
            if (ss > 0) __syncthreads();
            {
                u32x4 kv[9], vv[9];
#pragma unroll
                for (int k = 0; k < 9; ++k) { const int row = first + k;
                    if (row <= hi) { const size_t tokrow = (size_t)b * SEQ + (size_t)row * 64;
                        kv[k] = *(const u32x4*)(Kb + (tokrow + lcol) * DM + h * 64 + lch * 8);
                        vv[k] = *(const u32x4*)(VT + (size_t)(h * 64 + lcol) * MTOK + tokrow + lch * 8); } }
#pragma unroll
                for (int k = 0; k < 9; ++k) { const int row = first + k;
                    if (row <= hi) { const int slot = row % 9;
                        *(LAS u32x4*)(lds + slot * 16384 + lcol * 128 + ((lch ^ attn_fk(lcol)) << 4)) = kv[k];
                        *(LAS u32x4*)(lds + slot * 16384 + 8192 + lcol * 128 + ((lch ^ ((lcol >> 1) & 7)) << 4)) = vv[k]; } }
            }
            loaded_hi = hi;
            __syncthreads();
            const int ro = r + rsel, r0 = min(max(ro - 4, 0), 56);
            const size_t tokq = (size_t)b * SEQ + ro * 64 + qc;
            bf16x8 qf[2];
#pragma unroll
            for (int ks = 0; ks < 2; ++ks) qf[ks] = *(const bf16x8*)(Q + tokq * DM + h * 64 + ks * 32 + fq * 8);
            f32x4 s[8][2];
            float mx = -1e30f;
#pragma unroll
            for (int w = 0; w < 8; ++w) { const int slot = (r0 + w) % 9; const LAS float* rp = rpbL + (r0 + w - ro + 7) * 64 + rpoff;
#pragma unroll
                for (int t = 0; t < 2; ++t) { const int kc = cs + 8 * (fr >> 2) + (fr & 3) + 4 * t; const int fk = attn_fk(kc);
                    f32x4 acc;
#pragma unroll
                    for (int i = 0; i < 4; ++i) acc[i] = rp[4 * t + i] + maskadd[4 * t + i];
#pragma unroll
                    for (int ks = 0; ks < 2; ++ks) { const bf16x8 kf = *(const LAS bf16x8*)(lds + slot * 16384 + kc * 128 + (((ks * 4 + fq) ^ fk) << 4));
                        acc = __builtin_amdgcn_mfma_f32_16x16x32_bf16(kf, qf[ks], acc, 0, 0, 0); }
                    s[w][t] = acc;
                    mx = fmaxf(fmaxf(mx, fmaxf(acc[0], acc[1])), fmaxf(acc[2], acc[3])); } }
            mx = fmaxf(mx, __shfl_xor(mx, 16)); mx = fmaxf(mx, __shfl_xor(mx, 32));
            float sum = 0.f; bf16x8 pf[8];
#pragma unroll
            for (int w = 0; w < 8; ++w) { float p[8];
#pragma unroll
                for (int t = 0; t < 2; ++t)
#pragma unroll
                    for (int i = 0; i < 4; ++i) { const float e = __builtin_amdgcn_exp2f(s[w][t][i] - mx); p[4 * t + i] = e; sum += e; }
                u32x4 pw; pw.x = pk2(p[0], p[1]); pw.y = pk2(p[2], p[3]); pw.z = pk2(p[4], p[5]); pw.w = pk2(p[6], p[7]);
                pf[w] = __builtin_bit_cast(bf16x8, pw); }
            sum += __shfl_xor(sum, 16); sum += __shfl_xor(sum, 32);
            const float inv = 1.f / sum;
            f32x4 o[4];
#pragma unroll
            for (int dt = 0; dt < 4; ++dt) o[dt] = (f32x4){0.f, 0.f, 0.f, 0.f};
#pragma unroll
            for (int w = 0; w < 8; ++w) { const int slot = (r0 + w) % 9;
#pragma unroll
                for (int dt = 0; dt < 4; ++dt) { const int d = dt * 16 + fr;
                    const bf16x8 vf = *(const LAS bf16x8*)(lds + slot * 16384 + 8192 + d * 128 + ((((cs >> 3) + fq) ^ ((d >> 1) & 7)) << 4));
                    o[dt] = __builtin_amdgcn_mfma_f32_16x16x32_bf16(vf, pf[w], o[dt], 0, 0, 0); } }
#pragma unroll
            for (int dt = 0; dt < 4; ++dt) { const size_t off = tokq * DM + h * 64 + dt * 16 + 4 * fq;
                const bf16x4 z = *(const bf16x4*)(ZB + off);
                u32x2 w; w.x = pk2(o[dt][0] * inv * bf2f((unsigned short)z[0]), o[dt][1] * inv * bf2f((unsigned short)z[1]));
                w.y = pk2(o[dt][2] * inv * bf2f((unsigned short)z[2]), o[dt][3] * inv * bf2f((unsigned short)z[3]));
                *(u32x2*)(YB + off) = w; }
        }
    }
    __syncthreads();
}

template <bool FINAL, int DIR>
__device__ __forceinline__ void scan_dir(const LAS bf16x8* afrL, int lane, int ct, const bf16_t* WGr, const bf16_t* WGi, float br, float bi, float cl, float Hin,
                                         const bf16x8 (&idf)[2], float& Aout, float& Uout, const bf16_t* ZAp, bf16_t* YAp, unsigned (&hp)[4][8]) {
    const int n = lane & 31, hf = lane >> 5;
    bf16x8 Br[4], Bi[4];
#pragma unroll
    for (int kk = 0; kk < 4; ++kk) { Br[kk] = *(const bf16x8*)(WGr + (size_t)(32 * ct + n) * 64 + 16 * kk + 8 * hf); Bi[kk] = *(const bf16x8*)(WGi + (size_t)(32 * ct + n) * 64 + 16 * kk + 8 * hf); }
    float H = Hin, Ap = 1.f;
#pragma unroll
    for (int si = 0; si < 4; ++si) { const int s = DIR ? 3 - si : si;
        __builtin_amdgcn_sched_barrier(0);
        f32x16 ar, ai, ax;
#pragma unroll
        for (int e = 0; e < 16; ++e) { ar[e] = br; ai[e] = bi; ax[e] = 0.f; }
#pragma unroll
        for (int kk = 0; kk < 4; ++kk) { const bf16x8 av = afrL[(s * 4 + kk) * 64 + lane];
            ar = __builtin_amdgcn_mfma_f32_32x32x16_bf16(av, Br[kk], ar, 0, 0, 0); ai = __builtin_amdgcn_mfma_f32_32x32x16_bf16(av, Bi[kk], ai, 0, 0, 0); }
        { const bf16x8 a0 = afrL[(s * 4 + 2 * ct) * 64 + lane], a1 = afrL[(s * 4 + 2 * ct + 1) * 64 + lane];
            ax = __builtin_amdgcn_mfma_f32_32x32x16_bf16(a0, idf[0], ax, 0, 0, 0); ax = __builtin_amdgcn_mfma_f32_32x32x16_bf16(a1, idf[1], ax, 0, 0, 0); }
        const bf16_t* zs = ZAp + (size_t)(16 * s) * DM; bf16_t* ys = YAp + (size_t)(16 * s) * DM;
        float hv[16];
#pragma unroll
        for (int ei = 0; ei < 16; ++ei) { const int e = DIR ? 15 - ei : ei;
            const float r = __builtin_amdgcn_rcpf(1.f + __builtin_amdgcn_exp2f(ar[e])), ig = __builtin_amdgcn_rcpf(1.f + __builtin_amdgcn_exp2f(ai[e]));
            const float av = __builtin_amdgcn_exp2f(cl * r);
            const float om = fmaf(-av, av, 1.f);
            const float u = __builtin_amdgcn_sqrtf(om) * (ig * ax[e]);
            H = fmaf(av, H, u);
            hv[e] = H;
            if (!FINAL) Ap *= av; }
        if (FINAL) {
            if (DIR == 0) {
#pragma unroll
                for (int e2 = 0; e2 < 8; ++e2) hp[s][e2] = pk2(hv[2 * e2], hv[2 * e2 + 1]);
            } else {
#pragma unroll
                for (int e2 = 0; e2 < 8; ++e2) { const unsigned pw = hp[s][e2];
                    const float y0 = (hv[2 * e2] + __uint_as_float(pw << 16)) * bf2f(zs[(size_t)(2 * e2) * DM]);
                    const float y1 = (hv[2 * e2 + 1] + __uint_as_float(pw & 0xffff0000u)) * bf2f(zs[(size_t)(2 * e2 + 1) * DM]);
                    const unsigned yw = pk2(y0, y1);
                    ys[(size_t)(2 * e2) * DM] = (bf16_t)(yw & 0xffffu); ys[(size_t)(2 * e2 + 1) * DM] = (bf16_t)(yw >> 16); }
            }
        }
    }
    Aout = Ap; Uout = H;
}

template <bool FINAL>
__device__ __forceinline__ void scan_phase(const Args& a, LAS unsigned char* lds, int gw, int NGW, int wave, int lane) {
    unsigned char* ws = a.ws;
    const bf16_t* XA = (const bf16_t*)(ws + WS_XA); const bf16_t* ZA = (const bf16_t*)(ws + WS_ZA);
    const bf16_t* WG = (const bf16_t*)(ws + WS_WG);
    const float* conv_w = a.in[6]; const float* conv_b = a.in[7];
    typedef float f32x2 __attribute__((ext_vector_type(2)));
    f32x2* AGG = (f32x2*)(ws + WS_AGG);
    bf16_t* YA = (bf16_t*)(ws + WS_H);
    LAS bf16x8* afrL = (LAS bf16x8*)(lds + wave * 16384);
    const int n = lane & 31, hf = lane >> 5;
    bf16x8 idf[2];
#pragma unroll
    for (int k2 = 0; k2 < 2; ++k2)
#pragma unroll
        for (int jj = 0; jj < 8; ++jj) idf[k2][jj] = (16 * k2 + 8 * hf + jj == n) ? (short)0x3F80 : (short)0;
    for (int wt = gw; wt < 2048; wt += NGW) {
        const int cp = wt & 31, jb = (wt >> 5) & 15, b = wt >> 9, ch0 = jb * 64;
        { const int a_half = (n >> 2) & 1, a_idx = (n & 3) + 4 * (n >> 3), a_chunk = 2 * cp + a_half;
#pragma unroll 1
          for (int kk = 0; kk < 4; ++kk) { const int ch = ch0 + 16 * kk + 8 * hf;
              float cw[4][8], cb[8];
#pragma unroll
              for (int w = 0; w < 4; ++w) { const f32x4 c0 = *(const f32x4*)(conv_w + w * DM + ch), c1 = *(const f32x4*)(conv_w + w * DM + ch + 4);
#pragma unroll
                  for (int jj = 0; jj < 4; ++jj) { cw[w][jj] = c0[jj]; cw[w][4 + jj] = c1[jj]; } }
              { const f32x4 c0 = *(const f32x4*)(conv_b + ch), c1 = *(const f32x4*)(conv_b + ch + 4);
#pragma unroll
                  for (int jj = 0; jj < 4; ++jj) { cb[jj] = c0[jj]; cb[4 + jj] = c1[jj]; } }
#pragma unroll
              for (int s = 0; s < 4; ++s) { const int p = a_chunk * 64 + 16 * s + a_idx;
                  float acc[8];
#pragma unroll
                  for (int jj = 0; jj < 8; ++jj) acc[jj] = cb[jj];
#pragma unroll
                  for (int w = 0; w < 4; ++w) { const int pp = p + w - 2; const bool ok = (pp >= 0) && (pp < SEQ); const int pc = min(max(pp, 0), SEQ - 1);
                      const bf16x8 xv = *(const bf16x8*)(XA + ((size_t)b * SEQ + pc) * DM + ch);
#pragma unroll
                      for (int jj = 0; jj < 8; ++jj) acc[jj] = fmaf(cw[w][jj], ok ? bf2f((unsigned short)xv[jj]) : 0.f, acc[jj]); }
                  u32x4 pw; pw.x = pk2(acc[0], acc[1]); pw.y = pk2(acc[2], acc[3]); pw.z = pk2(acc[4], acc[5]); pw.w = pk2(acc[6], acc[7]);
                  afrL[(s * 4 + kk) * 64 + lane] = __builtin_bit_cast(bf16x8, pw); } } }
        LDS_WAIT(); asm volatile("" ::: "memory");
        const int chunk = 2 * cp + hf;
        if (FINAL) {
            const int tid = threadIdx.x, pdir = tid >> 8, pseg = (tid >> 6) & 3, pch = tid & 63, q = cp >> 3;
            LAS f32x2* segL = (LAS f32x2*)(lds + LDS_SEG);
            LAS float* cinL = (LAS float*)(lds + LDS_CIN);
            f32x2 g[16];
#pragma unroll
            for (int i = 0; i < 16; ++i) g[i] = AGG[((size_t)(b * 2 + pdir) * 64 + 16 * pseg + i) * DM + ch0 + pch];
            float As = 1.f, Us = 0.f;
#pragma unroll
            for (int ii = 0; ii < 16; ++ii) { const int i = pdir ? 15 - ii : ii; Us = fmaf(g[i][0], Us, g[i][1]); As *= g[i][0]; }
            __syncthreads();
            segL[(pdir * 4 + pseg) * 64 + pch] = (f32x2){As, Us};
            __syncthreads();
            if (pseg == q) { float Hc = 0.f;
                if (pdir == 0) { for (int s2 = 0; s2 < pseg; ++s2) { const f32x2 sg = segL[(0 * 4 + s2) * 64 + pch]; Hc = fmaf(sg[0], Hc, sg[1]); } }
                else { for (int s2 = 3; s2 > pseg; --s2) { const f32x2 sg = segL[(1 * 4 + s2) * 64 + pch]; Hc = fmaf(sg[0], Hc, sg[1]); } }
#pragma unroll
                for (int ii = 0; ii < 16; ++ii) { const int i = pdir ? 15 - ii : ii; cinL[(pdir * 16 + i) * 64 + pch] = Hc; Hc = fmaf(g[i][0], Hc, g[i][1]); } }
            __syncthreads();
        }
#pragma unroll 1
        for (int ct = 0; ct < 2; ++ct) { const int ch = ch0 + 32 * ct + n;
            float Af, Uf, Ab, Ub;
            unsigned hp[4][8];
            {
                const float br = -1.44269504089f * a.in[9][ch], bi = -1.44269504089f * a.in[11][ch]; const float lam = a.in[12][ch];
                const float cl = -8.f * 1.44269504089f * log1pf(expf(-lam));
                float Hin = 0.f;
                if (FINAL) Hin = ((const LAS float*)(lds + LDS_CIN))[(0 * 16 + (chunk & 15)) * 64 + 32 * ct + n];
                scan_dir<FINAL, 0>(afrL, lane, ct, WG + (size_t)(0 * 16 + jb) * 4096, WG + (size_t)(1 * 16 + jb) * 4096, br, bi, cl, Hin, idf, Af, Uf, ZA + ((size_t)b * SEQ + chunk * 64) * DM + ch, YA + ((size_t)b * SEQ + chunk * 64) * DM + ch, hp);
            }
            {
                const float br = -1.44269504089f * a.in[14][ch], bi = -1.44269504089f * a.in[16][ch]; const float lam = a.in[17][ch];
                const float cl = -8.f * 1.44269504089f * log1pf(expf(-lam));
                float Hin = 0.f;
                if (FINAL) Hin = ((const LAS float*)(lds + LDS_CIN))[(1 * 16 + (chunk & 15)) * 64 + 32 * ct + n];
                scan_dir<FINAL, 1>(afrL, lane, ct, WG + (size_t)(2 * 16 + jb) * 4096, WG + (size_t)(3 * 16 + jb) * 4096, br, bi, cl, Hin, idf, Ab, Ub, ZA + ((size_t)b * SEQ + chunk * 64) * DM + ch, YA + ((size_t)b * SEQ + chunk * 64) * DM + ch, hp);
            }
            if (!FINAL) {
                AGG[((size_t)(b * 2 + 0) * 64 + chunk) * DM + ch] = (f32x2){Af, Uf};
                AGG[((size_t)(b * 2 + 1) * 64 + chunk) * DM + ch] = (f32x2){Ab, Ub};
            }
        }
        LDS_WAIT(); asm volatile("" ::: "memory");
    }
}

__device__ __forceinline__ void final_norm(const Args& a, int gw, int NGW, int lane) {
    const float* x = a.in[0]; const float* g_final = a.in[22]; float* out = a.out;
    f32x4 g[4];
#pragma unroll
    for (int j = 0; j < 4; ++j) g[j] = *((const f32x4*)g_final + lane + 64 * j);
    for (int row0 = gw; row0 < MTOK; row0 += 2 * NGW) {
        f32x4 v[2][4]; bf16x4 bb[2][4]; float ss[2] = {0.f, 0.f};
#pragma unroll
        for (int q = 0; q < 2; ++q) { const int row = min(row0 + q * NGW, MTOK - 1);
            const f32x4* xrow = (const f32x4*)(x + (size_t)row * DM) + lane; const bf16x4* brow = (const bf16x4*)((const bf16_t*)(a.ws + WS_ZB) + (size_t)row * DM) + lane;
#pragma unroll
            for (int j = 0; j < 4; ++j) { v[q][j] = xrow[64 * j]; bb[q][j] = brow[64 * j]; } }
#pragma unroll
        for (int q = 0; q < 2; ++q)
#pragma unroll
            for (int j = 0; j < 4; ++j) {
                v[q][j][0] += bf2f((unsigned short)bb[q][j][0]); v[q][j][1] += bf2f((unsigned short)bb[q][j][1]); v[q][j][2] += bf2f((unsigned short)bb[q][j][2]); v[q][j][3] += bf2f((unsigned short)bb[q][j][3]);
                ss[q] += (v[q][j][0] * v[q][j][0] + v[q][j][1] * v[q][j][1]) + (v[q][j][2] * v[q][j][2] + v[q][j][3] * v[q][j][3]); }
#pragma unroll
        for (int q = 0; q < 2; ++q) { const int row = row0 + q * NGW;
            const float rstd = __builtin_amdgcn_rsqf(wave_sum(ss[q]) * (1.f / 1024.f) + 1e-6f);
            if (row < MTOK) { f32x4* orow = (f32x4*)(out + (size_t)row * DM) + lane;
#pragma unroll
                for (int j = 0; j < 4; ++j) orow[64 * j] = v[q][j] * rstd * g[j]; } }
    }
}

#define XB_TMO      128
#define XB_XCNT(j)  (256  + 64 * (j))
#define XB_XSUB(j)  (1280 + 64 * (j))
#define XB_XGEN(j)  (2304 + 64 * (j))
#define XB_TOP      3328
#define XB_TOPGEN   3392
#define XCD_BAR_WORDS 3456
#define XB_SPIN_CAP (1u << 18)
__device__ __forceinline__ unsigned xb_ld(unsigned* p)              { return __hip_atomic_load(p, __ATOMIC_RELAXED, __HIP_MEMORY_SCOPE_AGENT); }
__device__ __forceinline__ unsigned xb_add(unsigned* p, unsigned v) { return __hip_atomic_fetch_add(p, v, __ATOMIC_RELAXED, __HIP_MEMORY_SCOPE_AGENT); }
__device__ __forceinline__ unsigned xb_xcc_id() { return (unsigned)__builtin_amdgcn_s_getreg((3 << 11) | 20) & 0xFu; }
#define XB_SPIN(cond, bar) do { unsigned _sp = 0; while (cond) { __builtin_amdgcn_s_sleep(1); \
    if ((++_sp & 255u) == 0u) { if (xb_ld(&(bar)[XB_TMO])) break; if (_sp > XB_SPIN_CAP) { atomicAdd(&(bar)[XB_TMO], 1u); break; } } } } while (0)
struct XcdBarrier { unsigned* bar; unsigned x; volatile LAS unsigned* st; };
__device__ __forceinline__ XcdBarrier xcd_barrier_post(unsigned* bar, volatile LAS unsigned* st) {
    XcdBarrier b; b.bar = bar; b.x = xb_xcc_id(); b.st = st;
    if (threadIdx.x == 0) (void)xb_add(&bar[XB_XCNT(b.x)], 1u);
    return b;
}
__device__ __forceinline__ void xcd_barrier_complete(unsigned* bar, unsigned x, unsigned& nloc, unsigned& nx) {
    const unsigned G = gridDim.x * gridDim.y * gridDim.z;
    unsigned sum, cnt, mine, sp = 0u;
    for (;;) {
        sum = 0u; cnt = 0u; mine = 0u;
#pragma unroll
        for (unsigned j = 0; j < 16; ++j) { const unsigned c = xb_ld(&bar[XB_XCNT(j)]); sum += c; cnt += (c > 0u) ? 1u : 0u; mine = (j == x) ? c : mine; }
        if (sum == G) break;
        __builtin_amdgcn_s_sleep(1);
        if ((++sp & 255u) == 0u) { if (xb_ld(&bar[XB_TMO])) break; if (sp > XB_SPIN_CAP) { atomicAdd(&bar[XB_TMO], 1u); break; } }
    }
    nloc = mine > 0u ? mine : 1u; nx = cnt > 0u ? cnt : 1u;
}
__device__ __forceinline__ void xcd_barrier(const XcdBarrier& b) {
    asm volatile("s_waitcnt vmcnt(0)" ::: "memory");
    __syncthreads();
    if (threadIdx.x == 0) {
        unsigned* bar = b.bar;
        __builtin_amdgcn_s_waitcnt(0);
        unsigned nloc = b.st[0], nx = b.st[1];
        if (nloc == 0u) { xcd_barrier_complete(bar, b.x, nloc, nx); b.st[0] = nloc; b.st[1] = nx; }
        const unsigned old = xb_add(&bar[XB_XSUB(b.x)], 1u);
        const unsigned gen = old / nloc;
        if (old + 1u == (gen + 1u) * nloc) {
            __builtin_amdgcn_fence(__ATOMIC_RELEASE, "agent");
            asm volatile("s_waitcnt vmcnt(0)" ::: "memory");
            const unsigned og = xb_add(&bar[XB_TOP], 1u);
            const unsigned tg = og / nx;
            if (og + 1u == (tg + 1u) * nx) xb_add(&bar[XB_TOPGEN], 1u);
            else XB_SPIN(xb_ld(&bar[XB_TOPGEN]) == tg, bar);
            __builtin_amdgcn_fence(__ATOMIC_ACQUIRE, "agent");
            xb_add(&bar[XB_XGEN(b.x)], 1u);
            asm volatile("s_waitcnt vmcnt(0)" ::: "memory");
        } else {
            XB_SPIN(xb_ld(&bar[XB_XGEN(b.x)]) == gen, bar);
            __builtin_amdgcn_fence(__ATOMIC_ACQUIRE, "agent");
            asm volatile("s_waitcnt vmcnt(0)" ::: "memory");
        }
    }
    __syncthreads();
}

__global__ void __launch_bounds__(512, 2) fwd_kernel(Args a) {
    extern __shared__ __attribute__((aligned(16))) unsigned char lds_raw[];
    LAS unsigned char* lds = (LAS unsigned char*)lds_raw;
    cg::grid_group grid = cg::this_grid();
    const int tid = threadIdx.x, lane = tid & 63, wave = __builtin_amdgcn_readfirstlane(tid >> 6);
    const int G = gridDim.x, bx = blockIdx.x;
    const int vcu = (G % 8 == 0) ? (bx % 8) * (G / 8) + bx / 8 : bx;
    const int gw = bx * 8 + wave, NGW = G * 8;
    unsigned char* ws = a.ws;
#ifdef PROBE_A0
    unsigned long long tA0 = 0, tA1 = 0, tB0 = 0, tB1 = 0;
#define STAMP(k) do { const unsigned long long _t = __builtin_amdgcn_s_memrealtime(); if ((k) == PROBE_A0) tA0 = _t; if ((k) == PROBE_A1) tA1 = _t; if ((k) == PROBE_B0) tB0 = _t; if ((k) == PROBE_B1) tB1 = _t; } while (0)
#else
#define STAMP(k) do {} while (0)
#endif
    STAMP(0);
    unsigned* barw = (unsigned*)(ws + WS_BAR);
    if (tid < 4) ((volatile LAS unsigned*)(lds + LDS_MISC))[tid] = 0u;
    __syncthreads();
    XcdBarrier xb = xcd_barrier_post(barw, (volatile LAS unsigned*)(lds + LDS_MISC));
    if (a.ws == nullptr) grid.sync();

#define PH(k) (!defined(ONLY) || ONLY == (k))
#if !defined(ONLY) || ONLY == 0
    p0_prologue(a, lds, gw, NGW, wave, lane);
#endif
    STAMP(1);
    xcd_barrier(xb);
    STAMP(2);
#if !defined(ONLY) || ONLY == 1
    p1_hpass(a, lds, G, tid, wave, lane);
#endif
    STAMP(3);
    xcd_barrier(xb);
    STAMP(4);
#if !defined(ONLY) || ONLY == 2
    {
        pg8::Gemm g{(const bf16_t*)(ws + WS_H), (const bf16_t*)(ws + WS_WIN), MTOK, 7168, 1024, (const bf16_t*)(ws + WS_WV), (const bf16_t*)(ws + WS_H)};
        pg8::ChainOrder S; S.init(MTOK, 7168, 1024, MTOK, G, bx);
        EpiProjVT E{EpiProj{(bf16_t*)(ws + WS_XA), (bf16_t*)a.out}, EpiPlain{(bf16_t*)(ws + WS_VT), MTOK}};
        pg8::gemm_phase<EpiProjVT, pg8::ChainOrder, PG8_ALIGN, PG8_SP2>(lds, g, S, E);
    }
    STAMP(5);
    STAMP(6);
#endif
    xcd_barrier(xb);
    STAMP(7);
#if !defined(ONLY) || ONLY == 3
    attn_phase((const bf16_t*)(ws + WS_Q), (const bf16_t*)(ws + WS_K), (const bf16_t*)(ws + WS_VT), (const bf16_t*)(ws + WS_ZB), a.in[18], (bf16_t*)(ws + WS_Q), lds, vcu, G, tid, wave, lane);
#endif
    STAMP(8);
#if !defined(ONLY) || ONLY == 4
    scan_phase<false>(a, lds, gw, NGW, wave, lane);
#endif
    STAMP(9);
    xcd_barrier(xb);
    STAMP(10);
#if !defined(ONLY) || ONLY == 5
    scan_phase<true>(a, lds, gw, NGW, wave, lane);
#endif
    STAMP(11);
    xcd_barrier(xb);
    STAMP(12);
#if !defined(ONLY) || ONLY == 6
    {
        pg8::Gemm g{(const bf16_t*)(ws + WS_H), (const bf16_t*)(ws + WS_WPA), MTOK, 1024, 1024, (const bf16_t*)(ws + WS_Q), (const bf16_t*)(ws + WS_WPB)}; pg8::PairOrder S; S.init(MTOK, 1024, G, bx);
        EpiGate2 E{(const bf16_t*)a.out, (const bf16_t*)a.out + ARR, (bf16_t*)(ws + WS_K), (bf16_t*)(ws + WS_XA)};
        pg8::gemm_phase<EpiGate2, pg8::PairOrder, PG8_ALIGN, PG8_SP2>(lds, g, S, E);
    }
    STAMP(14);
#endif
    xcd_barrier(xb);
    STAMP(15);
#if !defined(ONLY) || ONLY == 7
    {
        pg8::Gemm g{(const bf16_t*)(ws + WS_XA), (const bf16_t*)(ws + WS_WO), MTOK, 1024, 1024}; pg8::StaticOrder S; S.init(MTOK, 1024, G, bx);
        EpiOut E{(const float*)(ws + WS_GATE), (bf16_t*)(ws + WS_ZB)};
        pg8::gemm_phase<EpiOut, pg8::StaticOrder, PG8_ALIGN, PG8_SP2>(lds, g, S, E);
    }
    STAMP(16);
#endif
    xcd_barrier(xb);
    STAMP(17);
#if !defined(ONLY) || ONLY == 8
    final_norm(a, gw, NGW, lane);
#endif
#ifdef PROBE_A0
    STAMP(18);
    if (bx == 0) {
        const float dA = (float)(tA1 - tA0) * 0.01f, dB = (float)(tB1 - tB0) * 0.01f;
        __syncthreads();
        float* orow = a.out + (size_t)wave * DM;
        for (int i = lane; i < DM; i += 64) orow[i] += dB;
        __syncthreads();
        if (tid == 0) a.out[0] += dA;
    }
#endif
}

extern "C" void kernel_launch(void* const* d_in, const int* in_sizes, int n_in, void* d_out, int out_size, void* d_ws, size_t ws_size, hipStream_t stream) {
    static int grid = 0;
    if (grid == 0) {
        if (n_in != 23 || out_size != MTOK * DM || ws_size < 256 * MiB) { fprintf(stderr, "kernel_launch: unexpected problem shape (n_in %d, out %d, ws %zu)\n", n_in, out_size, ws_size); grid = -1; return; }
        int dev = 0, cus = 0, per_cu = 0;
        (void)hipGetDevice(&dev);
        (void)hipDeviceGetAttribute(&cus, hipDeviceAttributeMultiprocessorCount, dev);
        if (hipFuncSetAttribute((const void*)fwd_kernel, hipFuncAttributeMaxDynamicSharedMemorySize, LDS_BYTES) != hipSuccess) { fprintf(stderr, "kernel_launch: hipFuncSetAttribute failed\n"); grid = -1; return; }
        if (hipOccupancyMaxActiveBlocksPerMultiprocessor(&per_cu, (const void*)fwd_kernel, 512, LDS_BYTES) != hipSuccess || per_cu < 1) { fprintf(stderr, "kernel_launch: occupancy query failed (%d)\n", per_cu); per_cu = 1; (void)hipGetLastError(); }
        grid = cus * per_cu;
        if (grid <= 0) { grid = -1; return; }
    }
    if (grid < 0) return;
    Args a{};
    for (int i = 0; i < 23; ++i) a.in[i] = (const float*)d_in[i];
    a.out = (float*)d_out; a.ws = (unsigned char*)d_ws;
    void* args[] = {&a};
    if (hipMemsetAsync((unsigned char*)d_ws + WS_BAR, 0, XCD_BAR_WORDS * 4, stream) != hipSuccess) { fprintf(stderr, "kernel_launch: memset of the barrier words failed\n"); return; }
    hipError_t e = hipLaunchCooperativeKernel((const void*)fwd_kernel, dim3(grid), dim3(512), args, LDS_BYTES, stream);
    if (e != hipSuccess) fprintf(stderr, "kernel_launch: cooperative launch failed: %s (grid %d)\n", hipGetErrorString(e), grid);
}
```

```cpp
#include <hip/hip_runtime.h>
#include <hip/hip_cooperative_groups.h>
#include <cstdio>
#include <cstdint>
namespace cg = cooperative_groups;
namespace pg8 {
#define PG8_LAS __attribute__((address_space(3)))
typedef unsigned short bf16_t;
typedef short bf16x8 __attribute__((ext_vector_type(8)));
typedef float f32x4 __attribute__((ext_vector_type(4)));
typedef unsigned u32x4 __attribute__((ext_vector_type(4)));
constexpr int BM = 256, BK = 64, HALF = 128, HTB = HALF * BK * 2  , STAGE_BYTES = 8 * HTB, NXCD = 8, WGM = 8;

__host__ __device__ __forceinline__ int lds_byte(int r, int c) { const int st = (r >> 4) * 2 + (c >> 5), rr = r & 15, cc = c & 31, ob = rr * 64 + cc * 2; return st * 1024 + (ob ^ (((ob >> 9) & 1) << 5)); }
__host__ __device__ __forceinline__ void stage_rc(int b, int& R, int& C) { const int st = b / 1024, sb = b % 1024, swz = sb ^ (((sb >> 9) & 1) << 5); R = (st >> 1) * 16 + swz / 64; C = (st & 1) * 32 + (swz % 64) / 2; }
__host__ __device__ __forceinline__ int perm32(int rho) { const int n = rho >> 4, i = rho & 15; return 8 * (i >> 2) + 4 * n + (i & 3); }

struct Unit { int pm, pn, w; };
struct Gemm { const bf16_t* A; const bf16_t* Bt; int M, N, K; const bf16_t* A2; const bf16_t* Bt2; };

struct StaticOrder {
    int nM, nN, nwg, G, c;
    __host__ __device__ void init(int M, int N, int G_, int c_) { nM = M / BM; nN = N / BM; nwg = nM * nN; G = G_; c = c_; }
    __host__ __device__ bool next(int i, Unit& u) const {
        const long L = (long)i * G + c; if (L >= nwg) return false;
        int wgid = (int)L; { const int q = nwg / NXCD, r = nwg % NXCD, xcd = wgid % NXCD, off = wgid / NXCD; wgid = (xcd < r ? xcd * (q + 1) : r * (q + 1) + (xcd - r) * q) + off; }
        const int nig = WGM * nN, gid = wgid / nig, fm = gid * WGM, gsz = (nM - fm) < WGM ? (nM - fm) : WGM;
        u.pm = fm + ((wgid % nig) % gsz); u.pn = (wgid % nig) / gsz; u.w = 0; return true;
    }
    __device__ __forceinline__ void a_ready(const Unit&) const {}
    __device__ __forceinline__ void done(const Unit&) const {}
};
struct ChainOrder {
    StaticOrder s0, s1; int n0;
    __host__ __device__ void init(int M0, int N0, int M1, int N1, int G, int c) { s0.init(M0, N0, G, c); s1.init(M1, N1, G, c); n0 = 0; Unit t; while (s0.next(n0, t)) ++n0; }
    __host__ __device__ bool next(int i, Unit& u) const { if (i < n0) return s0.next(i, u); if (!s1.next(i - n0, u)) return false; u.w = 1; return true; }
    __device__ __forceinline__ void a_ready(const Unit&) const {}
    __device__ __forceinline__ void done(const Unit&) const {}
};
struct PairOrder : StaticOrder {
    __host__ __device__ bool next(int i, Unit& u) const { if (!StaticOrder::next(i >> 1, u)) return false; u.w = i & 1; return true; }
};
__device__ __forceinline__ unsigned cvt_pk_bf16(float lo, float hi) { unsigned r; asm volatile("v_cvt_pk_bf16_f32 %0, %1, %2" : "=v"(r) : "v"(lo), "v"(hi)); return r; }
typedef float f32x2 __attribute__((ext_vector_type(2)));
template <class Epi, class Sched, bool ALIGN_EPI = false, bool SP2 = false>
__device__ __forceinline__ void gemm_phase(PG8_LAS unsigned char* lds, const Gemm g, const Sched& S, const Epi& E) {
    const int tid = threadIdx.x, wid = __builtin_amdgcn_readfirstlane(tid >> 6), lane = tid & 63, wr = wid >> 2, wc = wid & 3, fr = lane & 15, fq = lane >> 4;
    const int K = g.K, nt = K / BK;
    unsigned voffA[2], voffB[2];
#pragma unroll
    for (int i = 0; i < 2; ++i) { int R, C; stage_rc(tid * 16 + i * 8192, R, C); const int Rb = Epi::PERM ? ((R & ~31) + perm32(R & 31)) : R;
        voffA[i] = (unsigned)(R * K + C) * 2u; voffB[i] = (unsigned)(Rb * K + C) * 2u; }
    const size_t kstep = (size_t)(BK * 2);
    const size_t hstep = (size_t)HALF * K * 2;
    const size_t tstep = 2 * hstep;
    const unsigned ldsw = (unsigned)wid * 1024u;
    const int aoff = lds_byte(wr * 64 + fr, fq * 8), boff = lds_byte(wc * 32 + fr, fq * 8);
#define PG8_SA(b, h) (((b) * 2 + (h)) * HTB)
#define PG8_SB(b, h) ((4 + (b) * 2 + (h)) * HTB)
#define PG8_STAGE(bufoff, gbase, voff) do { _Pragma("unroll") for (int _i = 0; _i < 2; ++_i) \
        __builtin_amdgcn_global_load_lds((const unsigned*)((const char*)(gbase) + (voff)[_i]), (PG8_LAS unsigned*)(lds + (bufoff) + ldsw + _i * 8192), 16, 0, 0); } while (0)
#define PG8_LDA(dst, b, h) do { _Pragma("unroll") for (int m = 0; m < 4; ++m) _Pragma("unroll") for (int k = 0; k < 2; ++k) dst[m][k] = *(const PG8_LAS bf16x8*)(lds + PG8_SA(b, h) + aoff + m * 2048 + k * 1024); } while (0)
#define PG8_LDB(dst, b, h) do { _Pragma("unroll") for (int n = 0; n < 2; ++n) _Pragma("unroll") for (int k = 0; k < 2; ++k) dst[n][k] = *(const PG8_LAS bf16x8*)(lds + PG8_SB(b, h) + boff + n * 2048 + k * 1024); } while (0)
#define PG8_MMA(ai, bj, At, Bt) do { __builtin_amdgcn_s_setprio(1); _Pragma("unroll") for (int m = 0; m < 4; ++m) _Pragma("unroll") for (int n = 0; n < 2; ++n) _Pragma("unroll") for (int k = 0; k < 2; ++k) \
        acc[ai][bj][m][n] = __builtin_amdgcn_mfma_f32_16x16x32_bf16(Bt[n][k], At[m][k], acc[ai][bj][m][n], 0, 0, 0); __builtin_amdgcn_s_setprio(0); } while (0)
#define PG8_WAIT_V(n) asm volatile("s_waitcnt vmcnt(" #n ")" ::: "memory")
#define PG8_WAIT_L(n) asm volatile("s_waitcnt lgkmcnt(" #n ")" ::: "memory")
#define PG8_BAR __builtin_amdgcn_s_barrier()
#define PG8_SCHED __builtin_amdgcn_sched_barrier(0)
    Unit cur, nxt; int ui = 0;
    if (!S.next(0, cur)) return;
    f32x4 acc[2][2][4][2];
#pragma unroll
    for (int a = 0; a < 2; ++a)
#pragma unroll
        for (int b = 0; b < 2; ++b)
#pragma unroll
            for (int m = 0; m < 4; ++m)
#pragma unroll
                for (int n = 0; n < 2; ++n) acc[a][b][m][n] = (f32x4){0.f, 0.f, 0.f, 0.f};
    bf16x8 At[4][2], B0[2][2], B1[2][2];
    const char* cA = (const char*)(cur.w ? g.A2 : g.A) + (size_t)cur.pm * tstep; const char* cB = (const char*)(cur.w ? g.Bt2 : g.Bt) + (size_t)cur.pn * tstep;
    S.a_ready(cur);
    if constexpr (SP2) {
        PG8_STAGE(PG8_SB(0, 0), cB, voffB); PG8_STAGE(PG8_SB(0, 1), cB + hstep, voffB); PG8_STAGE(PG8_SA(0, 0), cA, voffA); PG8_STAGE(PG8_SA(0, 1), cA + hstep, voffA);
        if (wr == 1) PG8_BAR;
        PG8_WAIT_V(2); PG8_BAR;
        PG8_STAGE(PG8_SB(1, 0), cB + kstep, voffB); PG8_STAGE(PG8_SA(1, 0), cA + kstep, voffA); PG8_STAGE(PG8_SB(1, 1), cB + hstep + kstep, voffB);
        PG8_WAIT_V(6); PG8_BAR;
    } else {
        PG8_STAGE(PG8_SB(0, 0), cB, voffB); PG8_STAGE(PG8_SA(0, 0), cA, voffA); PG8_STAGE(PG8_SB(0, 1), cB + hstep, voffB); PG8_STAGE(PG8_SA(0, 1), cA + hstep, voffA);
        if (wr == 1) PG8_BAR;
        PG8_WAIT_V(4); PG8_BAR;
        PG8_STAGE(PG8_SB(1, 0), cB + kstep, voffB); PG8_STAGE(PG8_SA(1, 0), cA + kstep, voffA); PG8_STAGE(PG8_SB(1, 1), cB + hstep + kstep, voffB);
        PG8_WAIT_V(6); PG8_BAR;
    }
    for (;;) {
        const bool has_next = S.next(ui + 1, nxt);
        const char* nA = has_next ? (const char*)(nxt.w ? g.A2 : g.A) + (size_t)nxt.pm * tstep : cA; const char* nB = has_next ? (const char*)(nxt.w ? g.Bt2 : g.Bt) + (size_t)nxt.pn * tstep : cB;
        for (int t = 0; t < nt; t += 2) {
            const bool last = (t == nt - 2);
            const char* a1 = cA + (size_t)(t + 1) * kstep;
            const char* a2 = last ? nA : cA + (size_t)(t + 2) * kstep; const char* b2 = last ? nB : cB + (size_t)(t + 2) * kstep;
            const char* a3 = a2 + kstep; const char* b3 = b2 + kstep;
            if (last && has_next) S.a_ready(nxt);
            if constexpr (SP2) {
            PG8_LDB(B0, 0, 0); PG8_LDB(B1, 0, 1); PG8_SCHED; PG8_LDA(At, 0, 0); PG8_STAGE(PG8_SA(1, 1), a1 + hstep, voffA);
            PG8_WAIT_V(8); PG8_WAIT_L(0); PG8_BAR; PG8_MMA(0, 0, At, B0); PG8_MMA(0, 1, At, B1); PG8_BAR; PG8_SCHED;
            PG8_LDA(At, 0, 1); PG8_STAGE(PG8_SB(0, 0), b2, voffB); PG8_STAGE(PG8_SB(0, 1), b2 + hstep, voffB); PG8_STAGE(PG8_SA(0, 0), a2, voffA);
            PG8_WAIT_V(8); PG8_WAIT_L(0); PG8_BAR; PG8_MMA(1, 0, At, B0); PG8_MMA(1, 1, At, B1); PG8_BAR; PG8_SCHED;
            PG8_LDB(B0, 1, 0); PG8_LDB(B1, 1, 1); PG8_SCHED; PG8_LDA(At, 1, 0); PG8_STAGE(PG8_SA(0, 1), a2 + hstep, voffA);
            PG8_WAIT_V(8); PG8_WAIT_L(0); PG8_BAR; PG8_MMA(0, 0, At, B0); PG8_MMA(0, 1, At, B1); PG8_BAR; PG8_SCHED;
            PG8_LDA(At, 1, 1); PG8_STAGE(PG8_SB(1, 0), b3, voffB); PG8_STAGE(PG8_SB(1, 1), b3 + hstep, voffB); PG8_STAGE(PG8_SA(1, 0), a3, voffA);
            PG8_WAIT_V(8); PG8_WAIT_L(0); PG8_BAR; PG8_MMA(1, 0, At, B0); PG8_MMA(1, 1, At, B1); PG8_BAR; PG8_SCHED;
            } else {
            PG8_LDB(B0, 0, 0); PG8_SCHED; PG8_LDA(At, 0, 0); PG8_STAGE(PG8_SA(1, 1), a1 + hstep, voffA);
            PG8_WAIT_L(8); PG8_BAR; PG8_WAIT_L(0); PG8_MMA(0, 0, At, B0); PG8_BAR; PG8_SCHED;
            PG8_LDB(B1, 0, 1); PG8_STAGE(PG8_SB(0, 0), b2, voffB);
            PG8_BAR; PG8_WAIT_L(0); PG8_MMA(0, 1, At, B1); PG8_BAR;
            PG8_LDA(At, 0, 1); PG8_STAGE(PG8_SA(0, 0), a2, voffA);
            PG8_BAR; PG8_WAIT_L(0); PG8_MMA(1, 0, At, B0); PG8_BAR; PG8_SCHED;
            PG8_STAGE(PG8_SB(0, 1), b2 + hstep, voffB);
            PG8_WAIT_V(6); PG8_BAR; PG8_MMA(1, 1, At, B1); PG8_BAR;
            PG8_LDB(B0, 1, 0); PG8_SCHED; PG8_LDA(At, 1, 0); PG8_STAGE(PG8_SA(0, 1), a2 + hstep, voffA);
            PG8_WAIT_L(8); PG8_BAR; PG8_WAIT_L(0); PG8_MMA(0, 0, At, B0); PG8_BAR; PG8_SCHED;
            PG8_LDB(B1, 1, 1); PG8_STAGE(PG8_SB(1, 0), b3, voffB);
            PG8_BAR; PG8_WAIT_L(0); PG8_MMA(0, 1, At, B1); PG8_BAR;
            PG8_LDA(At, 1, 1); PG8_STAGE(PG8_SA(1, 0), a3, voffA);
            PG8_BAR; PG8_WAIT_L(0); PG8_MMA(1, 0, At, B0); PG8_BAR; PG8_SCHED;
            PG8_STAGE(PG8_SB(1, 1), b3 + hstep, voffB);
            PG8_WAIT_V(6); PG8_BAR; PG8_MMA(1, 1, At, B1); PG8_BAR;
            }
        }
        if constexpr (ALIGN_EPI) { if (wr == 0) PG8_BAR; }
        if constexpr (!Epi::AFTER_DRAIN) { E(acc, cur, wr, wc, fr, fq); S.done(cur); }
        if (!has_next) break;
#pragma unroll
        for (int a = 0; a < 2; ++a)
#pragma unroll
            for (int b = 0; b < 2; ++b)
#pragma unroll
                for (int m = 0; m < 4; ++m)
#pragma unroll
                    for (int n = 0; n < 2; ++n) acc[a][b][m][n] = (f32x4){0.f, 0.f, 0.f, 0.f};
        cur = nxt; cA = nA; cB = nB; ++ui;
        if constexpr (ALIGN_EPI) { if (wr == 1) PG8_BAR; }
    }
    PG8_WAIT_V(0);
    if constexpr (!ALIGN_EPI) { if (wr == 0) PG8_BAR; }
    PG8_BAR;
    if constexpr (Epi::AFTER_DRAIN) { E.fused(acc, cur, wr, wc, fr, fq, lds, wid, lane); S.done(cur); }
#undef PG8_SA
#undef PG8_SB
#undef PG8_STAGE
#undef PG8_LDA
#undef PG8_LDB
#undef PG8_MMA
#undef PG8_WAIT_V
#undef PG8_WAIT_L
#undef PG8_BAR
#undef PG8_SCHED
}
}
#ifndef PG8_SP2
#define PG8_SP2 true
#endif
#ifndef PG8_ALIGN
#define PG8_ALIGN true
#endif

#define LAS __attribute__((address_space(3)))
typedef unsigned short bf16_t;
typedef short bf16x8 __attribute__((ext_vector_type(8)));
typedef short bf16x4 __attribute__((ext_vector_type(4)));
typedef float f32x4 __attribute__((ext_vector_type(4)));
typedef float f32x16 __attribute__((ext_vector_type(16)));
typedef unsigned u32x4 __attribute__((ext_vector_type(4)));
typedef unsigned u32x2 __attribute__((ext_vector_type(2)));

constexpr int MTOK = 16384, DM = 1024, SEQ = 4096, NB = 4;
constexpr size_t MiB = 1u << 20;
constexpr size_t ARR = (size_t)MTOK * DM;
constexpr size_t WS_MODP = 0;
constexpr size_t WS_GATE = 786432;
constexpr size_t WS_AGG = 1 * MiB;
constexpr size_t WS_RSS = 5 * MiB;
constexpr size_t WS_WG = 6 * MiB;
constexpr size_t WS_WPA = 8 * MiB, WS_WPB = 10 * MiB, WS_WO = 12 * MiB, WS_WV = 14 * MiB;
constexpr size_t WS_WIN = 16 * MiB;
constexpr size_t WS_H = 32 * MiB;
constexpr size_t WS_XA = 64 * MiB, WS_ZA = 96 * MiB, WS_Q = 128 * MiB, WS_K = 160 * MiB, WS_ZB = 192 * MiB;
constexpr size_t WS_VT = 224 * MiB;
constexpr size_t WS_BAR = 802816;
constexpr int LDS_CIN = 131072, LDS_SEG = 131072 + 8192;
constexpr int LDS_MISC = 147456, LDS_RPB = 147456 + 256;
constexpr int LDS_BYTES = 147456 + 256 + 3840;

__device__ __forceinline__ float bf2f(unsigned short b) { return __uint_as_float(((unsigned)b) << 16); }
__device__ __forceinline__ unsigned pk2(float lo, float hi) { return pg8::cvt_pk_bf16(lo, hi); }
__device__ __forceinline__ float sigm(float v) { return __builtin_amdgcn_rcpf(1.f + __builtin_amdgcn_exp2f(-1.44269504089f * v)); }
__device__ __forceinline__ float wave_sum(float v) {
#pragma unroll
    for (int o = 1; o < 64; o <<= 1) v += __shfl_xor(v, o);
    return v;
}
#define LDS_WAIT() asm volatile("s_waitcnt lgkmcnt(0)" ::: "memory")

struct EpiProj {
    static constexpr bool PERM = true, AFTER_DRAIN = false;
    bf16_t* O5; bf16_t* OG;
    __device__ __forceinline__ void operator()(const f32x4 (&acc)[2][2][4][2], const pg8::Unit& u, int wr, int wc, int fr, int fq) const {
        const int arr = u.pn >> 2, colt = (u.pn & 3) * 256;
        bf16_t* base = arr < 5 ? O5 + (size_t)arr * ARR : OG + (size_t)(arr - 5) * ARR;
        const int mode = (arr == 1 || arr == 4) ? 1 : (arr >= 5 ? 2 : (arr == 2 ? 3 : 0));
        const int row0 = u.pm * 256 + wr * 64 + fr, col0 = colt + wc * 32 + 8 * fq;
#pragma unroll
        for (int ai = 0; ai < 2; ++ai)
#pragma unroll
            for (int m = 0; m < 4; ++m) { bf16_t* rowp = base + (size_t)(row0 + ai * 128 + m * 16) * DM + col0;
#pragma unroll
                for (int bj = 0; bj < 2; ++bj) { f32x4 v0 = acc[ai][bj][m][0], v1 = acc[ai][bj][m][1];
                    if (mode == 1) {
#pragma unroll
                        for (int j = 0; j < 4; ++j) { v0[j] = v0[j] * sigm(v0[j]); v1[j] = v1[j] * sigm(v1[j]); } }
                    else if (mode == 2) {
#pragma unroll
                        for (int j = 0; j < 4; ++j) { v0[j] = sigm(v0[j]); v1[j] = sigm(v1[j]); } }
                    else if (mode == 3) { v0 = v0 * (0.125f * 1.44269504089f); v1 = v1 * (0.125f * 1.44269504089f); }
                    u32x4 w; w.x = pk2(v0[0], v0[1]); w.y = pk2(v0[2], v0[3]); w.z = pk2(v1[0], v1[1]); w.w = pk2(v1[2], v1[3]);
                    *(u32x4*)(rowp + bj * 128) = w; } }
    }
};
struct EpiPlain {
    static constexpr bool PERM = true, AFTER_DRAIN = false;
    bf16_t* O; int ldc;
    __device__ __forceinline__ void operator()(const f32x4 (&acc)[2][2][4][2], const pg8::Unit& u, int wr, int wc, int fr, int fq) const {
        const int row0 = u.pm * 256 + wr * 64 + fr, col0 = u.pn * 256 + wc * 32 + 8 * fq;
#pragma unroll
        for (int ai = 0; ai < 2; ++ai)
#pragma unroll
            for (int m = 0; m < 4; ++m) { bf16_t* rowp = O + (size_t)(row0 + ai * 128 + m * 16) * ldc + col0;
#pragma unroll
                for (int bj = 0; bj < 2; ++bj) { const f32x4 v0 = acc[ai][bj][m][0], v1 = acc[ai][bj][m][1];
                    u32x4 w; w.x = pk2(v0[0], v0[1]); w.y = pk2(v0[2], v0[3]); w.z = pk2(v1[0], v1[1]); w.w = pk2(v1[2], v1[3]);
                    *(u32x4*)(rowp + bj * 128) = w; } }
    }
};
struct EpiProjVT {
    static constexpr bool PERM = true, AFTER_DRAIN = false;
    EpiProj p; EpiPlain v;
    __device__ __forceinline__ void operator()(const f32x4 (&acc)[2][2][4][2], const pg8::Unit& u, int wr, int wc, int fr, int fq) const { if (u.w) v(acc, u, wr, wc, fr, fq); else p(acc, u, wr, wc, fr, fq); }
};
struct EpiGate2 {
    static constexpr bool PERM = true, AFTER_DRAIN = false;
    const bf16_t* Ga; const bf16_t* Gb; bf16_t* Tb; bf16_t* O;
    __device__ __forceinline__ void operator()(const f32x4 (&acc)[2][2][4][2], const pg8::Unit& u, int wr, int wc, int fr, int fq) const {
        const int row0 = u.pm * 256 + wr * 64 + fr, col0 = u.pn * 256 + wc * 32 + 8 * fq;
        const bf16_t* G = u.w ? Gb : Ga; bf16_t* dst = u.w ? O : Tb;
#pragma unroll
        for (int ai = 0; ai < 2; ++ai) {
            bf16x8 g[4][2], t[4][2];
#pragma unroll
            for (int m = 0; m < 4; ++m)
#pragma unroll
                for (int bj = 0; bj < 2; ++bj) { const size_t off = (size_t)(row0 + ai * 128 + m * 16) * DM + col0 + bj * 128;
                    g[m][bj] = *(const bf16x8*)(G + off);
                    if (u.w) t[m][bj] = *(const bf16x8*)(Tb + off); else t[m][bj] = (bf16x8){0, 0, 0, 0, 0, 0, 0, 0}; }
            asm volatile("" ::: "memory");
#pragma unroll
            for (int m = 0; m < 4; ++m)
#pragma unroll
                for (int bj = 0; bj < 2; ++bj) { const size_t off = (size_t)(row0 + ai * 128 + m * 16) * DM + col0 + bj * 128;
                    const f32x4 v0 = acc[ai][bj][m][0], v1 = acc[ai][bj][m][1];
                    float o[8];
#pragma unroll
                    for (int j = 0; j < 4; ++j) { o[j] = fmaf(bf2f((unsigned short)g[m][bj][j]), v0[j], bf2f((unsigned short)t[m][bj][j])); o[4 + j] = fmaf(bf2f((unsigned short)g[m][bj][4 + j]), v1[j], bf2f((unsigned short)t[m][bj][4 + j])); }
                    u32x4 w; w.x = pk2(o[0], o[1]); w.y = pk2(o[2], o[3]); w.z = pk2(o[4], o[5]); w.w = pk2(o[6], o[7]);
                    *(u32x4*)(dst + off) = w; }
            asm volatile("" ::: "memory");
        }
    }
};
struct EpiOut {
    static constexpr bool PERM = true, AFTER_DRAIN = false;
    const float* gate; bf16_t* O;
    __device__ __forceinline__ void operator()(const f32x4 (&acc)[2][2][4][2], const pg8::Unit& u, int wr, int wc, int fr, int fq) const {
        const int row0 = u.pm * 256 + wr * 64 + fr, col0 = u.pn * 256 + wc * 32 + 8 * fq;
        const float* gp = gate + (size_t)(u.pm >> 4) * DM + col0;
        f32x4 gv[2][2];
#pragma unroll
        for (int bj = 0; bj < 2; ++bj)
#pragma unroll
            for (int n = 0; n < 2; ++n) gv[bj][n] = *(const f32x4*)(gp + bj * 128 + n * 4);
#pragma unroll
        for (int ai = 0; ai < 2; ++ai)
#pragma unroll
            for (int m = 0; m < 4; ++m) { bf16_t* rowp = O + (size_t)(row0 + ai * 128 + m * 16) * DM + col0;
#pragma unroll
                for (int bj = 0; bj < 2; ++bj) { const f32x4 v0 = gv[bj][0] * acc[ai][bj][m][0], v1 = gv[bj][1] * acc[ai][bj][m][1];
                    u32x4 w; w.x = pk2(v0[0], v0[1]); w.y = pk2(v0[2], v0[3]); w.z = pk2(v1[0], v1[1]); w.w = pk2(v1[2], v1[3]);
                    *(u32x4*)(rowp + bj * 128) = w; } }
    }
};

__device__ __forceinline__ void p0_transpose_item(const float* W, int K, int N, bf16_t* WT, int dst_row0, int k0, int n0, LAS float* scr, int lane, float scale = 1.f) {
    float wv[32];
#pragma unroll
    for (int i = 0; i < 32; ++i) { const int kk = 2 * i + (lane >> 5); wv[i] = W[(size_t)(k0 + kk) * N + n0 + (lane & 31)]; }
#pragma unroll
    for (int i = 0; i < 32; ++i) { const int kk = 2 * i + (lane >> 5); scr[kk * 33 + (lane & 31)] = wv[i] * scale; }
    LDS_WAIT(); asm volatile("" ::: "memory");
    const int c = lane & 7;
#pragma unroll
    for (int j = 0; j < 4; ++j) { const int n = (lane >> 3) + 8 * j; const LAS float* s = scr + (8 * c) * 33 + n;
        u32x4 o; o.x = pk2(s[0 * 33], s[1 * 33]); o.y = pk2(s[2 * 33], s[3 * 33]); o.z = pk2(s[4 * 33], s[5 * 33]); o.w = pk2(s[6 * 33], s[7 * 33]);
        *(u32x4*)(WT + (size_t)(dst_row0 + n) * K + k0 + 8 * c) = o; }
    LDS_WAIT(); asm volatile("" ::: "memory");
}

struct Args { const float* in[23]; float* out; unsigned char* ws; };

__device__ __forceinline__ void p0_prologue(const Args& a, LAS unsigned char* lds, int gw, int NGW, int wave, int lane) {
    LAS float* scr = (LAS float*)(lds + wave * 16384);
    unsigned char* ws = a.ws;
    const float* c = a.in[1]; const float* w_c = a.in[3]; const float* w_in = a.in[5];
    float* modp = (float*)(ws + WS_MODP);
    constexpr int I_MOD = 768, I_IN = 16 * 256, I_SQ = 16 * 32, I_G = 4 * 16 * 2;
    constexpr int NITEMS = I_MOD + I_IN + 3 * I_SQ + I_G;
    for (int it = gw; it < NITEMS; it += NGW) {
        int r = it;
        if (r < I_MOD) {
            const int cgi = r % 48, kc = r / 48, col = cgi * 64 + lane, k0 = kc * 64;
            float sv[4];
#pragma unroll
            for (int b = 0; b < 4; ++b) { const float cv = c[b * DM + k0 + lane]; sv[b] = cv * sigm(cv); }
            float acc[4] = {0.f, 0.f, 0.f, 0.f};
#pragma unroll 32
            for (int kk = 0; kk < 64; ++kk) { const float w = w_c[(size_t)(k0 + kk) * 3072 + col];
#pragma unroll
                for (int b = 0; b < 4; ++b) acc[b] += __shfl(sv[b], kk) * w; }
#pragma unroll
            for (int b = 0; b < 4; ++b) modp[(size_t)(kc * 4 + b) * 3072 + col] = acc[b];
            continue;
        }
        r -= I_MOD;
        if (r < I_IN) { const int kb = r / 256, nb = r % 256, n0 = nb * 32, cb = n0 >> 10;
            if (cb == 4) p0_transpose_item(w_in, 1024, 8192, (bf16_t*)(ws + WS_WV), n0 - 4096, kb * 64, n0, scr, lane);
            else p0_transpose_item(w_in, 1024, 8192, (bf16_t*)(ws + WS_WIN), (cb < 4 ? cb : cb - 1) * 1024 + (n0 & 1023), kb * 64, n0, scr, lane);
            continue; }
        r -= I_IN;
        if (r < 3 * I_SQ) { const int which = r / I_SQ, rr = r % I_SQ, kb = rr / 32, nb = rr % 32;
            const float* W = which == 0 ? a.in[19] : (which == 1 ? a.in[20] : a.in[21]);
            bf16_t* WT = (bf16_t*)(ws + (which == 0 ? WS_WPA : (which == 1 ? WS_WPB : WS_WO)));
            p0_transpose_item(W, 1024, 1024, WT, nb * 32, kb * 64, nb * 32, scr, lane);
            continue; }
        r -= 3 * I_SQ;
        { const int g = r / 32, rr = r % 32, hb = rr / 2, nb = rr % 2;
            const float* W = (g == 0 ? a.in[8] : (g == 1 ? a.in[10] : (g == 2 ? a.in[13] : a.in[15]))) + (size_t)hb * 4096;
            bf16_t* WT = (bf16_t*)(ws + WS_WG) + (size_t)(g * 16 + hb) * 4096;
            p0_transpose_item(W, 64, 64, WT, nb * 32, 0, nb * 32, scr, lane, -1.44269504089f); }
    }
}

__device__ __forceinline__ void p1_hpass(const Args& a, LAS unsigned char* lds, int G, int tid, int wave, int lane) {
    unsigned char* ws = a.ws;
    const float* x = a.in[0]; const float* g_pre = a.in[2]; const float* b_c = a.in[4];
    const float* modp = (const float*)(ws + WS_MODP);
    bf16_t* H = (bf16_t*)(ws + WS_H);
    LAS float* sh = (LAS float*)lds;
    for (int rb = blockIdx.x; rb < MTOK / 64; rb += G) {
        const int b = rb >> 6;
        __syncthreads();
        for (int idx = tid; idx < 2048; idx += 512) { float s = b_c[idx];
#pragma unroll
            for (int kc = 0; kc < 16; ++kc) s += modp[(size_t)(kc * 4 + b) * 3072 + idx];
            sh[idx] = idx < 1024 ? s : 1.f + s; }
        __syncthreads();
        for (int rr = wave; rr < 64; rr += 16) {
            const int row0 = rb * 64 + rr;
            f32x4 v[2][4]; float s[2] = {0.f, 0.f};
#pragma unroll
            for (int q = 0; q < 2; ++q) { const f32x4* xr = (const f32x4*)(x + (size_t)(row0 + 8 * q) * DM) + lane;
#pragma unroll
                for (int j = 0; j < 4; ++j) v[q][j] = xr[64 * j]; }
#pragma unroll
            for (int q = 0; q < 2; ++q)
#pragma unroll
                for (int j = 0; j < 4; ++j) s[q] += (v[q][j][0] * v[q][j][0] + v[q][j][1] * v[q][j][1]) + (v[q][j][2] * v[q][j][2] + v[q][j][3] * v[q][j][3]);
#pragma unroll
            for (int q = 0; q < 2; ++q) { const float rstd = __builtin_amdgcn_rsqf(wave_sum(s[q]) * (1.f / 1024.f) + 1e-6f);
#pragma unroll
                for (int j = 0; j < 4; ++j) { const int col = 4 * lane + 256 * j;
                    const f32x4 g = *(const f32x4*)(g_pre + col); const f32x4 sc = *(const LAS f32x4*)(sh + 1024 + col); const f32x4 sf = *(const LAS f32x4*)(sh + col);
                    const f32x4 o = (v[q][j] * rstd) * g * sc + sf;
                    u32x2 w; w.x = pk2(o[0], o[1]); w.y = pk2(o[2], o[3]);
                    *(u32x2*)(H + (size_t)(row0 + 8 * q) * DM + col) = w; } }
        }
    }
    float* gate = (float*)(ws + WS_GATE);
    for (int idx = blockIdx.x * 512 + tid; idx < 4096; idx += G * 512) { const int b = idx >> 10, col = idx & 1023; float s = b_c[2048 + col];
#pragma unroll
        for (int kc = 0; kc < 16; ++kc) s += modp[(size_t)(kc * 4 + b) * 3072 + 2048 + col];
        gate[idx] = s; }
}

__device__ __forceinline__ int attn_fk(int col) { return ((col >> 1) & 1) | (((col >> 3) & 3) << 1); }
__device__ __forceinline__ void attn_phase(const bf16_t* Q, const bf16_t* Kb, const bf16_t* VT, const bf16_t* ZB, const float* rpb, bf16_t* YB, LAS unsigned char* lds, int vcu, int G, int tid, int wave, int lane) {
    const int fr = lane & 15, fq = lane >> 4;
    constexpr float L2E = 1.44269504089f;
    LAS float* rpbL = (LAS float*)(lds + LDS_RPB);
    const int rsel = wave >> 2, j = wave & 3;
    const int cs = min(max(16 * j - 8, 0), 32);
    const int qc = 16 * j + fr, c0 = min(max(qc - 8, 0), 48);
    const int lcol = tid >> 3, lch = tid & 7;
    float maskadd[8];
#pragma unroll
    for (int e = 0; e < 8; ++e) { const int kcol = cs + 8 * fq + e; maskadd[e] = ((kcol >= c0) && (kcol < c0 + 16)) ? 0.f : -1e30f; }
    const int rpoff = cs + 8 * fq - qc + 31;
    for (int u = vcu; u < 256; u += G) {
        const int band = u & 3, h = (u >> 2) & 15, b = u >> 6, R0 = band * 16;
        __syncthreads();
        for (int i = tid; i < 15 * 64; i += 512) { const int dr = i >> 6, dc = (i & 63) - 16; rpbL[i] = (dc >= 0 && dc < 31) ? rpb[(size_t)(h * 15 + dr) * 31 + dc] * L2E : 0.f; }
        int loaded_hi = -1;
#pragma unroll 1
        for (int ss = 0; ss < 8; ++ss) {
            const int r = R0 + 2 * ss;
            const int lo = min(max(r - 4, 0), 56), hi = min(max(r - 3, 0), 56) + 7;
            const int first = loaded_hi < 0 ? lo : loaded_hi + 1;
            if (ss > 0) __syncthreads();
            {
                u32x4 kv[9], vv[9];
#pragma unroll
                for (int k = 0; k < 9; ++k) { const int row = first + k;
                    if (row <= hi) { const size_t tokrow = (size_t)b * SEQ + (size_t)row * 64;
                        kv[k] = *(const u32x4*)(Kb + (tokrow + lcol) * DM + h * 64 + lch * 8);
                        vv[k] = *(const u32x4*)(VT + (size_t)(h * 64 + lcol) * MTOK + tokrow + lch * 8); } }
#pragma unroll
                for (int k = 0; k < 9; ++k) { const int row = first + k;
                    if (row <= hi) { const int slot = row % 9;
                        *(LAS u32x4*)(lds + slot * 16384 + lcol * 128 + ((lch ^ attn_fk(lcol)) << 4)) = kv[k];
                        *(LAS u32x4*)(lds + slot * 16384 + 8192 + lcol * 128 + ((lch ^ ((lcol >> 1) & 7)) << 4)) = vv[k]; } }
            }
            loaded_hi = hi;
            __syncthreads();
            const int ro = r + rsel, r0 = min(max(ro - 4, 0), 56);
            const size_t tokq = (size_t)b * SEQ + ro * 64 + qc;
            bf16x8 qf[2];
#pragma unroll
            for (int ks = 0; ks < 2; ++ks) qf[ks] = *(const bf16x8*)(Q + tokq * DM + h * 64 + ks * 32 + fq * 8);
            f32x4 s[8][2];
            float mx = -1e30f;
#pragma unroll
            for (int w = 0; w < 8; ++w) { const int slot = (r0 + w) % 9; const LAS float* rp = rpbL + (r0 + w - ro + 7) * 64 + rpoff;
#pragma unroll
                for (int t = 0; t < 2; ++t) { const int kc = cs + 8 * (fr >> 2) + (fr & 3) + 4 * t; const int fk = attn_fk(kc);
                    f32x4 acc;
#pragma unroll
                    for (int i = 0; i < 4; ++i) acc[i] = rp[4 * t + i] + maskadd[4 * t + i];
#pragma unroll
                    for (int ks = 0; ks < 2; ++ks) { const bf16x8 kf = *(const LAS bf16x8*)(lds + slot * 16384 + kc * 128 + (((ks * 4 + fq) ^ fk) << 4));
                        acc = __builtin_amdgcn_mfma_f32_16x16x32_bf16(kf, qf[ks], acc, 0, 0, 0); }
                    s[w][t] = acc;
                    mx = fmaxf(fmaxf(mx, fmaxf(acc[0], acc[1])), fmaxf(acc[2], acc[3])); } }
            mx = fmaxf(mx, __shfl_xor(mx, 16)); mx = fmaxf(mx, __shfl_xor(mx, 32));
            float sum = 0.f; bf16x8 pf[8];
#pragma unroll
            for (int w = 0; w < 8; ++w) { float p[8];
#pragma unroll
                for (int t = 0; t < 2; ++t)
#pragma unroll
                    for (int i = 0; i < 4; ++i) { const float e = __builtin_amdgcn_exp2f(s[w][t][i] - mx); p[4 * t + i] = e; sum += e; }
                u32x4 pw; pw.x = pk2(p[0], p[1]); pw.y = pk2(p[2], p[3]); pw.z = pk2(p[4], p[5]); pw.w = pk2(p[6], p[7]);
                pf[w] = __builtin_bit_cast(bf16x8, pw); }
            sum += __shfl_xor(sum, 16); sum += __shfl_xor(sum, 32);
            const float inv = 1.f / sum;
            f32x4 o[4];
#pragma unroll
            for (int dt = 0; dt < 4; ++dt) o[dt] = (f32x4){0.f, 0.f, 0.f, 0.f};
#pragma unroll
            for (int w = 0; w < 8; ++w) { const int slot = (r0 + w) % 9;
#pragma unroll
                for (int dt = 0; dt < 4; ++dt) { const int d = dt * 16 + fr;
                    const bf16x8 vf = *(const LAS bf16x8*)(lds + slot * 16384 + 8192 + d * 128 + ((((cs >> 3) + fq) ^ ((d >> 1) & 7)) << 4));
                    o[dt] = __builtin_amdgcn_mfma_f32_16x16x32_bf16(vf, pf[w], o[dt], 0, 0, 0); } }
#pragma unroll
            for (int dt = 0; dt < 4; ++dt) { const size_t off = tokq * DM + h * 64 + dt * 16 + 4 * fq;
                const bf16x4 z = *(const bf16x4*)(ZB + off);
                u32x2 w; w.x = pk2(o[dt][0] * inv * bf2f((unsigned short)z[0]), o[dt][1] * inv * bf2f((unsigned short)z[1]));
                w.y = pk2(o[dt][2] * inv * bf2f((unsigned short)z[2]), o[dt][3] * inv * bf2f((unsigned short)z[3]));
                *(u32x2*)(YB + off) = w; }
        }
    }
    __syncthreads();
}

template <bool FINAL, int DIR>
__device__ __forceinline__ void scan_dir(const LAS bf16x8* afrL, int lane, int ct, const bf16_t* WGr, const bf16_t* WGi, float br, float bi, float cl, float Hin,
                                         const bf16x8 (&idf)[2], float& Aout, float& Uout, const bf16_t* ZAp, bf16_t* YAp, unsigned (&hp)[4][8]) {
    const int n = lane & 31, hf = lane >> 5;
    bf16x8 Br[4], Bi[4];
#pragma unroll
    for (int kk = 0; kk < 4; ++kk) { Br[kk] = *(const bf16x8*)(WGr + (size_t)(32 * ct + n) * 64 + 16 * kk + 8 * hf); Bi[kk] = *(const bf16x8*)(WGi + (size_t)(32 * ct + n) * 64 + 16 * kk + 8 * hf); }
    float H = Hin, Ap = 1.f;
#pragma unroll 1
    for (int si = 0; si < 4; ++si) { const int s = DIR ? 3 - si : si;
        f32x16 ar, ai, ax;
#pragma unroll
        for (int e = 0; e < 16; ++e) { ar[e] = br; ai[e] = bi; ax[e] = 0.f; }
#pragma unroll
        for (int kk = 0; kk < 4; ++kk) { const bf16x8 av = afrL[(s * 4 + kk) * 64 + lane];
            ar = __builtin_amdgcn_mfma_f32_32x32x16_bf16(av, Br[kk], ar, 0, 0, 0); ai = __builtin_amdgcn_mfma_f32_32x32x16_bf16(av, Bi[kk], ai, 0, 0, 0); }
        { const bf16x8 a0 = afrL[(s * 4 + 2 * ct) * 64 + lane], a1 = afrL[(s * 4 + 2 * ct + 1) * 64 + lane];
            ax = __builtin_amdgcn_mfma_f32_32x32x16_bf16(a0, idf[0], ax, 0, 0, 0); ax = __builtin_amdgcn_mfma_f32_32x32x16_bf16(a1, idf[1], ax, 0, 0, 0); }
        const bf16_t* zs = ZAp + (size_t)(16 * s) * DM; bf16_t* ys = YAp + (size_t)(16 * s) * DM;
        bf16_t zv[16];
        if (FINAL && DIR == 1) {
#pragma unroll
            for (int e = 0; e < 16; ++e) zv[e] = zs[(size_t)e * DM];
            asm volatile("" ::: "memory"); }
        float hv[16];
#pragma unroll
        for (int ei = 0; ei < 16; ++ei) { const int e = DIR ? 15 - ei : ei;
            const float r = __builtin_amdgcn_rcpf(1.f + __builtin_amdgcn_exp2f(ar[e])), ig = __builtin_amdgcn_rcpf(1.f + __builtin_amdgcn_exp2f(ai[e]));
            const float av = __builtin_amdgcn_exp2f(cl * r);
            const float om = fmaf(-av, av, 1.f);
            const float u = __builtin_amdgcn_sqrtf(om) * (ig * ax[e]);
            H = fmaf(av, H, u);
            hv[e] = H;
            if (!FINAL) Ap *= av; }
        if (FINAL) {
            if (DIR == 0) {
                unsigned pk[8];
#pragma unroll
                for (int e2 = 0; e2 < 8; ++e2) pk[e2] = pk2(hv[2 * e2], hv[2 * e2 + 1]);
#pragma unroll
                for (int sq = 0; sq < 4; ++sq) if (s == sq) {
#pragma unroll
                    for (int e2 = 0; e2 < 8; ++e2) hp[sq][e2] = pk[e2]; }
            } else {
                unsigned pws[8];
#pragma unroll
                for (int e2 = 0; e2 < 8; ++e2) pws[e2] = hp[0][e2];
#pragma unroll
                for (int sq = 1; sq < 4; ++sq) if (s == sq) {
#pragma unroll
                    for (int e2 = 0; e2 < 8; ++e2) pws[e2] = hp[sq][e2]; }
#pragma unroll
                for (int e2 = 0; e2 < 8; ++e2) { const unsigned pw = pws[e2];
                    const float y0 = (hv[2 * e2] + __uint_as_float(pw << 16)) * bf2f(zv[2 * e2]);
                    const float y1 = (hv[2 * e2 + 1] + __uint_as_float(pw & 0xffff0000u)) * bf2f(zv[2 * e2 + 1]);
                    const unsigned yw = pk2(y0, y1);
                    ys[(size_t)(2 * e2) * DM] = (bf16_t)(yw & 0xffffu); ys[(size_t)(2 * e2 + 1) * DM] = (bf16_t)(yw >> 16); }
            }
        }
    }
    Aout = Ap; Uout = H;
}

template <bool FINAL>
__device__ __forceinline__ void scan_phase(const Args& a, LAS unsigned char* lds, int gw, int NGW, int wave, int lane) {
    unsigned char* ws = a.ws;
    const bf16_t* XA = (const bf16_t*)(ws + WS_XA); const bf16_t* ZA = (const bf16_t*)(ws + WS_ZA);
    const bf16_t* WG = (const bf16_t*)(ws + WS_WG);
    const float* conv_w = a.in[6]; const float* conv_b = a.in[7];
    typedef float f32x2 __attribute__((ext_vector_type(2)));
    f32x2* AGG = (f32x2*)(ws + WS_AGG);
    bf16_t* YA = (bf16_t*)(ws + WS_H);
    LAS bf16x8* afrL = (LAS bf16x8*)(lds + wave * 16384);
    const int n = lane & 31, hf = lane >> 5;
    bf16x8 idf[2];
#pragma unroll
    for (int k2 = 0; k2 < 2; ++k2)
#pragma unroll
        for (int jj = 0; jj < 8; ++jj) idf[k2][jj] = (16 * k2 + 8 * hf + jj == n) ? (short)0x3F80 : (short)0;
    for (int wt = gw; wt < 2048; wt += NGW) {
        const int cp = wt & 31, jb = (wt >> 5) & 15, b = wt >> 9, ch0 = jb * 64;
        { const int a_half = (n >> 2) & 1, a_idx = (n & 3) + 4 * (n >> 3), a_chunk = 2 * cp + a_half;
#pragma unroll 1
          for (int kk = 0; kk < 4; ++kk) { const int ch = ch0 + 16 * kk + 8 * hf;
              float cw[4][8], cb[8];
#pragma unroll
              for (int w = 0; w < 4; ++w) { const f32x4 c0 = *(const f32x4*)(conv_w + w * DM + ch), c1 = *(const f32x4*)(conv_w + w * DM + ch + 4);
#pragma unroll
                  for (int jj = 0; jj < 4; ++jj) { cw[w][jj] = c0[jj]; cw[w][4 + jj] = c1[jj]; } }
              { const f32x4 c0 = *(const f32x4*)(conv_b + ch), c1 = *(const f32x4*)(conv_b + ch + 4);
#pragma unroll
                  for (int jj = 0; jj < 4; ++jj) { cb[jj] = c0[jj]; cb[4 + jj] = c1[jj]; } }
#pragma unroll
              for (int s = 0; s < 4; ++s) { const int p = a_chunk * 64 + 16 * s + a_idx;
                  float acc[8];
#pragma unroll
                  for (int jj = 0; jj < 8; ++jj) acc[jj] = cb[jj];
#pragma unroll
                  for (int w = 0; w < 4; ++w) { const int pp = p + w - 2; const bool ok = (pp >= 0) && (pp < SEQ); const int pc = min(max(pp, 0), SEQ - 1);
                      const bf16x8 xv = *(const bf16x8*)(XA + ((size_t)b * SEQ + pc) * DM + ch);
#pragma unroll
                      for (int jj = 0; jj < 8; ++jj) acc[jj] = fmaf(cw[w][jj], ok ? bf2f((unsigned short)xv[jj]) : 0.f, acc[jj]); }
                  u32x4 pw; pw.x = pk2(acc[0], acc[1]); pw.y = pk2(acc[2], acc[3]); pw.z = pk2(acc[4], acc[5]); pw.w = pk2(acc[6], acc[7]);
                  afrL[(s * 4 + kk) * 64 + lane] = __builtin_bit_cast(bf16x8, pw); } } }
        LDS_WAIT(); asm volatile("" ::: "memory");
        const int chunk = 2 * cp + hf;
        if (FINAL) {
            const int tid = threadIdx.x, pdir = tid >> 8, pseg = (tid >> 6) & 3, pch = tid & 63, q = cp >> 3;
            LAS f32x2* segL = (LAS f32x2*)(lds + LDS_SEG);
            LAS float* cinL = (LAS float*)(lds + LDS_CIN);
            f32x2 g[16];
#pragma unroll
            for (int i = 0; i < 16; ++i) g[i] = AGG[((size_t)(b * 2 + pdir) * 64 + 16 * pseg + i) * DM + ch0 + pch];
            float As = 1.f, Us = 0.f;
#pragma unroll
            for (int ii = 0; ii < 16; ++ii) { const int i = pdir ? 15 - ii : ii; Us = fmaf(g[i][0], Us, g[i][1]); As *= g[i][0]; }
            __syncthreads();
            segL[(pdir * 4 + pseg) * 64 + pch] = (f32x2){As, Us};
            __syncthreads();
            if (pseg == q) { float Hc = 0.f;
                if (pdir == 0) { for (int s2 = 0; s2 < pseg; ++s2) { const f32x2 sg = segL[(0 * 4 + s2) * 64 + pch]; Hc = fmaf(sg[0], Hc, sg[1]); } }
                else { for (int s2 = 3; s2 > pseg; --s2) { const f32x2 sg = segL[(1 * 4 + s2) * 64 + pch]; Hc = fmaf(sg[0], Hc, sg[1]); } }
#pragma unroll
                for (int ii = 0; ii < 16; ++ii) { const int i = pdir ? 15 - ii : ii; cinL[(pdir * 16 + i) * 64 + pch] = Hc; Hc = fmaf(g[i][0], Hc, g[i][1]); } }
            __syncthreads();
        }
#pragma unroll 1
        for (int ct = 0; ct < 2; ++ct) { const int ch = ch0 + 32 * ct + n;
            float Af, Uf, Ab, Ub;
            unsigned hp[4][8];
            {
                const float br = -1.44269504089f * a.in[9][ch], bi = -1.44269504089f * a.in[11][ch]; const float lam = a.in[12][ch];
                const float cl = -8.f * 1.44269504089f * log1pf(expf(-lam));
                float Hin = 0.f;
                if (FINAL) Hin = ((const LAS float*)(lds + LDS_CIN))[(0 * 16 + (chunk & 15)) * 64 + 32 * ct + n];
                scan_dir<FINAL, 0>(afrL, lane, ct, WG + (size_t)(0 * 16 + jb) * 4096, WG + (size_t)(1 * 16 + jb) * 4096, br, bi, cl, Hin, idf, Af, Uf, ZA + ((size_t)b * SEQ + chunk * 64) * DM + ch, YA + ((size_t)b * SEQ + chunk * 64) * DM + ch, hp);
            }
            {
                const float br = -1.44269504089f * a.in[14][ch], bi = -1.44269504089f * a.in[16][ch]; const float lam = a.in[17][ch];
                const float cl = -8.f * 1.44269504089f * log1pf(expf(-lam));
                float Hin = 0.f;
                if (FINAL) Hin = ((const LAS float*)(lds + LDS_CIN))[(1 * 16 + (chunk & 15)) * 64 + 32 * ct + n];
                scan_dir<FINAL, 1>(afrL, lane, ct, WG + (size_t)(2 * 16 + jb) * 4096, WG + (size_t)(3 * 16 + jb) * 4096, br, bi, cl, Hin, idf, Ab, Ub, ZA + ((size_t)b * SEQ + chunk * 64) * DM + ch, YA + ((size_t)b * SEQ + chunk * 64) * DM + ch, hp);
            }
            if (!FINAL) {
                AGG[((size_t)(b * 2 + 0) * 64 + chunk) * DM + ch] = (f32x2){Af, Uf};
                AGG[((size_t)(b * 2 + 1) * 64 + chunk) * DM + ch] = (f32x2){Ab, Ub};
            }
        }
        LDS_WAIT(); asm volatile("" ::: "memory");
    }
}

__device__ __forceinline__ void final_norm(const Args& a, int gw, int NGW, int lane) {
    const float* x = a.in[0]; const float* g_final = a.in[22]; float* out = a.out;
    f32x4 g[4];
#pragma unroll
    for (int j = 0; j < 4; ++j) g[j] = *((const f32x4*)g_final + lane + 64 * j);
    for (int row0 = gw; row0 < MTOK; row0 += 2 * NGW) {
        f32x4 v[2][4]; bf16x4 bb[2][4]; float ss[2] = {0.f, 0.f};
#pragma unroll
        for (int q = 0; q < 2; ++q) { const int row = min(row0 + q * NGW, MTOK - 1);
            const f32x4* xrow = (const f32x4*)(x + (size_t)row * DM) + lane; const bf16x4* brow = (const bf16x4*)((const bf16_t*)(a.ws + WS_ZB) + (size_t)row * DM) + lane;
#pragma unroll
            for (int j = 0; j < 4; ++j) { v[q][j] = xrow[64 * j]; bb[q][j] = brow[64 * j]; } }
#pragma unroll
        for (int q = 0; q < 2; ++q)
#pragma unroll
            for (int j = 0; j < 4; ++j) {
                v[q][j][0] += bf2f((unsigned short)bb[q][j][0]); v[q][j][1] += bf2f((unsigned short)bb[q][j][1]); v[q][j][2] += bf2f((unsigned short)bb[q][j][2]); v[q][j][3] += bf2f((unsigned short)bb[q][j][3]);
                ss[q] += (v[q][j][0] * v[q][j][0] + v[q][j][1] * v[q][j][1]) + (v[q][j][2] * v[q][j][2] + v[q][j][3] * v[q][j][3]); }
#pragma unroll
        for (int q = 0; q < 2; ++q) { const int row = row0 + q * NGW;
            const float rstd = __builtin_amdgcn_rsqf(wave_sum(ss[q]) * (1.f / 1024.f) + 1e-6f);
            if (row < MTOK) { f32x4* orow = (f32x4*)(out + (size_t)row * DM) + lane;
#pragma unroll
                for (int j = 0; j < 4; ++j) orow[64 * j] = v[q][j] * rstd * g[j]; } }
    }
}

#define XB_TMO      128
#define XB_XCNT(j)  (256  + 64 * (j))
#define XB_XSUB(j)  (1280 + 64 * (j))
#define XB_XGEN(j)  (2304 + 64 * (j))
#define XB_TOP      3328
#define XB_TOPGEN   3392
#define XCD_BAR_WORDS 3456
#define XB_SPIN_CAP (1u << 18)
__device__ __forceinline__ unsigned xb_ld(unsigned* p)              { return __hip_atomic_load(p, __ATOMIC_RELAXED, __HIP_MEMORY_SCOPE_AGENT); }
__device__ __forceinline__ unsigned xb_add(unsigned* p, unsigned v) { return __hip_atomic_fetch_add(p, v, __ATOMIC_RELAXED, __HIP_MEMORY_SCOPE_AGENT); }
__device__ __forceinline__ unsigned xb_xcc_id() { return (unsigned)__builtin_amdgcn_s_getreg((3 << 11) | 20) & 0xFu; }
#define XB_SPIN(cond, bar) do { unsigned _sp = 0; while (cond) { __builtin_amdgcn_s_sleep(1); \
    if ((++_sp & 255u) == 0u) { if (xb_ld(&(bar)[XB_TMO])) break; if (_sp > XB_SPIN_CAP) { atomicAdd(&(bar)[XB_TMO], 1u); break; } } } } while (0)
struct XcdBarrier { unsigned* bar; unsigned x; volatile LAS unsigned* st; };
__device__ __forceinline__ XcdBarrier xcd_barrier_post(unsigned* bar, volatile LAS unsigned* st) {
    XcdBarrier b; b.bar = bar; b.x = xb_xcc_id(); b.st = st;
    if (threadIdx.x == 0) (void)xb_add(&bar[XB_XCNT(b.x)], 1u);
    return b;
}
__device__ __forceinline__ void xcd_barrier_complete(unsigned* bar, unsigned x, unsigned& nloc, unsigned& nx) {
    const unsigned G = gridDim.x * gridDim.y * gridDim.z;
    unsigned sum, cnt, mine, sp = 0u;
    for (;;) {
        sum = 0u; cnt = 0u; mine = 0u;
#pragma unroll
        for (unsigned j = 0; j < 16; ++j) { const unsigned c = xb_ld(&bar[XB_XCNT(j)]); sum += c; cnt += (c > 0u) ? 1u : 0u; mine = (j == x) ? c : mine; }
        if (sum == G) break;
        __builtin_amdgcn_s_sleep(1);
        if ((++sp & 255u) == 0u) { if (xb_ld(&bar[XB_TMO])) break; if (sp > XB_SPIN_CAP) { atomicAdd(&bar[XB_TMO], 1u); break; } }
    }
    nloc = mine > 0u ? mine : 1u; nx = cnt > 0u ? cnt : 1u;
}
__device__ __forceinline__ void xcd_barrier(const XcdBarrier& b) {
    asm volatile("s_waitcnt vmcnt(0)" ::: "memory");
    __syncthreads();
    if (threadIdx.x == 0) {
        unsigned* bar = b.bar;
        __builtin_amdgcn_s_waitcnt(0);
        unsigned nloc = b.st[0], nx = b.st[1];
        if (nloc == 0u) { xcd_barrier_complete(bar, b.x, nloc, nx); b.st[0] = nloc; b.st[1] = nx; }
        const unsigned old = xb_add(&bar[XB_XSUB(b.x)], 1u);
        const unsigned gen = old / nloc;
        if (old + 1u == (gen + 1u) * nloc) {
            __builtin_amdgcn_fence(__ATOMIC_RELEASE, "agent");
            asm volatile("s_waitcnt vmcnt(0)" ::: "memory");
            const unsigned og = xb_add(&bar[XB_TOP], 1u);
            const unsigned tg = og / nx;
            if (og + 1u == (tg + 1u) * nx) xb_add(&bar[XB_TOPGEN], 1u);
            else XB_SPIN(xb_ld(&bar[XB_TOPGEN]) == tg, bar);
            __builtin_amdgcn_fence(__ATOMIC_ACQUIRE, "agent");
            xb_add(&bar[XB_XGEN(b.x)], 1u);
            asm volatile("s_waitcnt vmcnt(0)" ::: "memory");
        } else {
            XB_SPIN(xb_ld(&bar[XB_XGEN(b.x)]) == gen, bar);
            __builtin_amdgcn_fence(__ATOMIC_ACQUIRE, "agent");
            asm volatile("s_waitcnt vmcnt(0)" ::: "memory");
        }
    }
    __syncthreads();
}

__global__ void __launch_bounds__(512, 2) fwd_kernel(Args a) {
    extern __shared__ __attribute__((aligned(16))) unsigned char lds_raw[];
    LAS unsigned char* lds = (LAS unsigned char*)lds_raw;
    cg::grid_group grid = cg::this_grid();
    const int tid = threadIdx.x, lane = tid & 63, wave = __builtin_amdgcn_readfirstlane(tid >> 6);
    const int G = gridDim.x, bx = blockIdx.x;
    const int vcu = (G % 8 == 0) ? (bx % 8) * (G / 8) + bx / 8 : bx;
    const int gw = bx * 8 + wave, NGW = G * 8;
    unsigned char* ws = a.ws;
#ifdef PROBE_A0
    unsigned long long tA0 = 0, tA1 = 0, tB0 = 0, tB1 = 0;
#define STAMP(k) do { const unsigned long long _t = __builtin_amdgcn_s_memrealtime(); if ((k) == PROBE_A0) tA0 = _t; if ((k) == PROBE_A1) tA1 = _t; if ((k) == PROBE_B0) tB0 = _t; if ((k) == PROBE_B1) tB1 = _t; } while (0)
#else
#define STAMP(k) do {} while (0)
#endif
    STAMP(0);
    unsigned* barw = (unsigned*)(ws + WS_BAR);
    if (tid < 4) ((volatile LAS unsigned*)(lds + LDS_MISC))[tid] = 0u;
    __syncthreads();
    XcdBarrier xb = xcd_barrier_post(barw, (volatile LAS unsigned*)(lds + LDS_MISC));
    if (a.ws == nullptr) grid.sync();

#define PH(k) (!defined(ONLY) || ONLY == (k))
#if !defined(ONLY) || ONLY == 0
    p0_prologue(a, lds, gw, NGW, wave, lane);
#endif
    STAMP(1);
    xcd_barrier(xb);
    STAMP(2);
#if !defined(ONLY) || ONLY == 1
    p1_hpass(a, lds, G, tid, wave, lane);
#endif
    STAMP(3);
    xcd_barrier(xb);
    STAMP(4);
#if !defined(ONLY) || ONLY == 2
    {
        pg8::Gemm g{(const bf16_t*)(ws + WS_H), (const bf16_t*)(ws + WS_WIN), MTOK, 7168, 1024, (const bf16_t*)(ws + WS_WV), (const bf16_t*)(ws + WS_H)};
        pg8::ChainOrder S; S.init(MTOK, 7168, 1024, MTOK, G, bx);
        EpiProjVT E{EpiProj{(bf16_t*)(ws + WS_XA), (bf16_t*)a.out}, EpiPlain{(bf16_t*)(ws + WS_VT), MTOK}};
        pg8::gemm_phase<EpiProjVT, pg8::ChainOrder, PG8_ALIGN, PG8_SP2>(lds, g, S, E);
    }
    STAMP(5);
    STAMP(6);
#endif
    xcd_barrier(xb);
    STAMP(7);
#if !defined(ONLY) || ONLY == 3
    attn_phase((const bf16_t*)(ws + WS_Q), (const bf16_t*)(ws + WS_K), (const bf16_t*)(ws + WS_VT), (const bf16_t*)(ws + WS_ZB), a.in[18], (bf16_t*)(ws + WS_Q), lds, vcu, G, tid, wave, lane);
#endif
    STAMP(8);
#if !defined(ONLY) || ONLY == 4
    scan_phase<false>(a, lds, gw, NGW, wave, lane);
#endif
    STAMP(9);
    xcd_barrier(xb);
    STAMP(10);
#if !defined(ONLY) || ONLY == 5
    scan_phase<true>(a, lds, gw, NGW, wave, lane);
#endif
    STAMP(11);
    xcd_barrier(xb);
    STAMP(12);
#if !defined(ONLY) || ONLY == 6
    {
        pg8::Gemm g{(const bf16_t*)(ws + WS_H), (const bf16_t*)(ws + WS_WPA), MTOK, 1024, 1024, (const bf16_t*)(ws + WS_Q), (const bf16_t*)(ws + WS_WPB)}; pg8::PairOrder S; S.init(MTOK, 1024, G, bx);
        EpiGate2 E{(const bf16_t*)a.out, (const bf16_t*)a.out + ARR, (bf16_t*)(ws + WS_K), (bf16_t*)(ws + WS_XA)};
        pg8::gemm_phase<EpiGate2, pg8::PairOrder, PG8_ALIGN, PG8_SP2>(lds, g, S, E);
    }
    STAMP(14);
#endif
    xcd_barrier(xb);
    STAMP(15);
#if !defined(ONLY) || ONLY == 7
    {
        pg8::Gemm g{(const bf16_t*)(ws + WS_XA), (const bf16_t*)(ws + WS_WO), MTOK, 1024, 1024}; pg8::StaticOrder S; S.init(MTOK, 1024, G, bx);
        EpiOut E{(const float*)(ws + WS_GATE), (bf16_t*)(ws + WS_ZB)};
        pg8::gemm_phase<EpiOut, pg8::StaticOrder, PG8_ALIGN, PG8_SP2>(lds, g, S, E);
    }
    STAMP(16);
#endif
    xcd_barrier(xb);
    STAMP(17);
#if !defined(ONLY) || ONLY == 8
    final_norm(a, gw, NGW, lane);
#endif
#ifdef PROBE_A0
    STAMP(18);
    if (bx == 0) {
        const float dA = (float)(tA1 - tA0) * 0.01f, dB = (float)(tB1 - tB0) * 0.01f;
        __syncthreads();
        float* orow = a.out + (size_t)wave * DM;
        for (int i = lane; i < DM; i += 64) orow[i] += dB;
        __syncthreads();
        if (tid == 0) a.out[0] += dA;
    }
#endif
}

extern "C" void kernel_launch(void* const* d_in, const int* in_sizes, int n_in, void* d_out, int out_size, void* d_ws, size_t ws_size, hipStream_t stream) {
    static int grid = 0;
    if (grid == 0) {
        if (n_in != 23 || out_size != MTOK * DM || ws_size < 256 * MiB) { fprintf(stderr, "kernel_launch: unexpected problem shape (n_in %d, out %d, ws %zu)\n", n_in, out_size, ws_size); grid = -1; return; }
        int dev = 0, cus = 0, per_cu = 0;
        (void)hipGetDevice(&dev);
        (void)hipDeviceGetAttribute(&cus, hipDeviceAttributeMultiprocessorCount, dev);
        if (hipFuncSetAttribute((const void*)fwd_kernel, hipFuncAttributeMaxDynamicSharedMemorySize, LDS_BYTES) != hipSuccess) { fprintf(stderr, "kernel_launch: hipFuncSetAttribute failed\n"); grid = -1; return; }
        if (hipOccupancyMaxActiveBlocksPerMultiprocessor(&per_cu, (const void*)fwd_kernel, 512, LDS_BYTES) != hipSuccess || per_cu < 1) { fprintf(stderr, "kernel_launch: occupancy query failed (%d)\n", per_cu); per_cu = 1; (void)hipGetLastError(); }
        grid = cus * per_cu;
        if (grid <= 0) { grid = -1; return; }
    }
    if (grid < 0) return;
    Args a{};
    for (int i = 0; i < 23; ++i) a.in[i] = (const float*)d_in[i];
    a.out = (float*)d_out; a.ws = (unsigned char*)d_ws;
    void* args[] = {&a};
    if (hipMemsetAsync((unsigned char*)d_ws + WS_BAR, 0, XCD_BAR_WORDS * 4, stream) != hipSuccess) { fprintf(stderr, "kernel_launch: memset of the barrier words failed\n"); return; }
    hipError_t e = hipLaunchCooperativeKernel((const void*)fwd_kernel, dim3(grid), dim3(512), args, LDS_BYTES, stream);
    if (e != hipSuccess) fprintf(stderr, "kernel_launch: cooperative launch failed: %s (grid %d)\n", hipGetErrorString(e), grid);
}
```

```cpp
#include <hip/hip_runtime.h>
#include <hip/hip_cooperative_groups.h>
#include <cstdio>
#include <cstdint>
namespace cg = cooperative_groups;
namespace pg8 {
#define PG8_LAS __attribute__((address_space(3)))
typedef unsigned short bf16_t;
typedef short bf16x8 __attribute__((ext_vector_type(8)));
typedef float f32x4 __attribute__((ext_vector_type(4)));
typedef unsigned u32x4 __attribute__((ext_vector_type(4)));
constexpr int BM = 256, BK = 64, HALF = 128, HTB = HALF * BK * 2  , STAGE_BYTES = 8 * HTB, NXCD = 8, WGM = 8;

__host__ __device__ __forceinline__ int lds_byte(int r, int c) { const int st = (r >> 4) * 2 + (c >> 5), rr = r & 15, cc = c & 31, ob = rr * 64 + cc * 2; return st * 1024 + (ob ^ (((ob >> 9) & 1) << 5)); }
__host__ __device__ __forceinline__ void stage_rc(int b, int& R, int& C) { const int st = b / 1024, sb = b % 1024, swz = sb ^ (((sb >> 9) & 1) << 5); R = (st >> 1) * 16 + swz / 64; C = (st & 1) * 32 + (swz % 64) / 2; }
__host__ __device__ __forceinline__ int perm32(int rho) { const int n = rho >> 4, i = rho & 15; return 8 * (i >> 2) + 4 * n + (i & 3); }

struct Unit { int pm, pn, w; };
struct Gemm { const bf16_t* A; const bf16_t* Bt; int M, N, K; const bf16_t* A2; const bf16_t* Bt2; };

struct StaticOrder {
    int nM, nN, nwg, G, c;
    __host__ __device__ void init(int M, int N, int G_, int c_) { nM = M / BM; nN = N / BM; nwg = nM * nN; G = G_; c = c_; }
    __host__ __device__ bool next(int i, Unit& u) const {
        const long L = (long)i * G + c; if (L >= nwg) return false;
        int wgid = (int)L; { const int q = nwg / NXCD, r = nwg % NXCD, xcd = wgid % NXCD, off = wgid / NXCD; wgid = (xcd < r ? xcd * (q + 1) : r * (q + 1) + (xcd - r) * q) + off; }
        const int nig = WGM * nN, gid = wgid / nig, fm = gid * WGM, gsz = (nM - fm) < WGM ? (nM - fm) : WGM;
        u.pm = fm + ((wgid % nig) % gsz); u.pn = (wgid % nig) / gsz; u.w = 0; return true;
    }
    __device__ __forceinline__ void a_ready(const Unit&) const {}
    __device__ __forceinline__ void done(const Unit&) const {}
};
struct ChainOrder {
    StaticOrder s0, s1; int n0;
    __host__ __device__ void init(int M0, int N0, int M1, int N1, int G, int c) { s0.init(M0, N0, G, c); s1.init(M1, N1, G, c); n0 = 0; Unit t; while (s0.next(n0, t)) ++n0; }
    __host__ __device__ bool next(int i, Unit& u) const { if (i < n0) return s0.next(i, u); if (!s1.next(i - n0, u)) return false; u.w = 1; return true; }
    __device__ __forceinline__ void a_ready(const Unit&) const {}
    __device__ __forceinline__ void done(const Unit&) const {}
};
struct PairOrder : StaticOrder {
    __host__ __device__ bool next(int i, Unit& u) const { if (!StaticOrder::next(i >> 1, u)) return false; u.w = i & 1; return true; }
};
__device__ __forceinline__ unsigned cvt_pk_bf16(float lo, float hi) { unsigned r; asm volatile("v_cvt_pk_bf16_f32 %0, %1, %2" : "=v"(r) : "v"(lo), "v"(hi)); return r; }
typedef float f32x2 __attribute__((ext_vector_type(2)));
template <class Epi, class Sched, bool ALIGN_EPI = false, bool SP2 = false>
__device__ __forceinline__ void gemm_phase(PG8_LAS unsigned char* lds, const Gemm g, const Sched& S, const Epi& E) {
    const int tid = threadIdx.x, wid = __builtin_amdgcn_readfirstlane(tid >> 6), lane = tid & 63, wr = wid >> 2, wc = wid & 3, fr = lane & 15, fq = lane >> 4;
    const int K = g.K, nt = K / BK;
    unsigned voffA[2], voffB[2];
#pragma unroll
    for (int i = 0; i < 2; ++i) { int R, C; stage_rc(tid * 16 + i * 8192, R, C); const int Rb = Epi::PERM ? ((R & ~31) + perm32(R & 31)) : R;
        voffA[i] = (unsigned)(R * K + C) * 2u; voffB[i] = (unsigned)(Rb * K + C) * 2u; }
    const size_t kstep = (size_t)(BK * 2);
    const size_t hstep = (size_t)HALF * K * 2;
    const size_t tstep = 2 * hstep;
    const unsigned ldsw = (unsigned)wid * 1024u;
    const int aoff = lds_byte(wr * 64 + fr, fq * 8), boff = lds_byte(wc * 32 + fr, fq * 8);
#define PG8_SA(b, h) (((b) * 2 + (h)) * HTB)
#define PG8_SB(b, h) ((4 + (b) * 2 + (h)) * HTB)
#define PG8_STAGE(bufoff, gbase, voff) do { _Pragma("unroll") for (int _i = 0; _i < 2; ++_i) \
        __builtin_amdgcn_global_load_lds((const unsigned*)((const char*)(gbase) + (voff)[_i]), (PG8_LAS unsigned*)(lds + (bufoff) + ldsw + _i * 8192), 16, 0, 0); } while (0)
#define PG8_LDA(dst, b, h) do { _Pragma("unroll") for (int m = 0; m < 4; ++m) _Pragma("unroll") for (int k = 0; k < 2; ++k) dst[m][k] = *(const PG8_LAS bf16x8*)(lds + PG8_SA(b, h) + aoff + m * 2048 + k * 1024); } while (0)
#define PG8_LDB(dst, b, h) do { _Pragma("unroll") for (int n = 0; n < 2; ++n) _Pragma("unroll") for (int k = 0; k < 2; ++k) dst[n][k] = *(const PG8_LAS bf16x8*)(lds + PG8_SB(b, h) + boff + n * 2048 + k * 1024); } while (0)
#define PG8_MMA(ai, bj, At, Bt) do { __builtin_amdgcn_s_setprio(1); _Pragma("unroll") for (int m = 0; m < 4; ++m) _Pragma("unroll") for (int n = 0; n < 2; ++n) _Pragma("unroll") for (int k = 0; k < 2; ++k) \
        acc[ai][bj][m][n] = __builtin_amdgcn_mfma_f32_16x16x32_bf16(Bt[n][k], At[m][k], acc[ai][bj][m][n], 0, 0, 0); __builtin_amdgcn_s_setprio(0); } while (0)
#define PG8_WAIT_V(n) asm volatile("s_waitcnt vmcnt(" #n ")" ::: "memory")
#define PG8_WAIT_L(n) asm volatile("s_waitcnt lgkmcnt(" #n ")" ::: "memory")
#define PG8_BAR __builtin_amdgcn_s_barrier()
#define PG8_SCHED __builtin_amdgcn_sched_barrier(0)
    Unit cur, nxt; int ui = 0;
    if (!S.next(0, cur)) return;
    f32x4 acc[2][2][4][2];
#pragma unroll
    for (int a = 0; a < 2; ++a)
#pragma unroll
        for (int b = 0; b < 2; ++b)
#pragma unroll
            for (int m = 0; m < 4; ++m)
#pragma unroll
                for (int n = 0; n < 2; ++n) acc[a][b][m][n] = (f32x4){0.f, 0.f, 0.f, 0.f};
    bf16x8 At[4][2], B0[2][2], B1[2][2];
    const char* cA = (const char*)(cur.w ? g.A2 : g.A) + (size_t)cur.pm * tstep; const char* cB = (const char*)(cur.w ? g.Bt2 : g.Bt) + (size_t)cur.pn * tstep;
    S.a_ready(cur);
    if constexpr (SP2) {
        PG8_STAGE(PG8_SB(0, 0), cB, voffB); PG8_STAGE(PG8_SB(0, 1), cB + hstep, voffB); PG8_STAGE(PG8_SA(0, 0), cA, voffA); PG8_STAGE(PG8_SA(0, 1), cA + hstep, voffA);
        if (wr == 1) PG8_BAR;
        PG8_WAIT_V(2); PG8_BAR;
        PG8_STAGE(PG8_SB(1, 0), cB + kstep, voffB); PG8_STAGE(PG8_SA(1, 0), cA + kstep, voffA); PG8_STAGE(PG8_SB(1, 1), cB + hstep + kstep, voffB);
        PG8_WAIT_V(6); PG8_BAR;
    } else {
        PG8_STAGE(PG8_SB(0, 0), cB, voffB); PG8_STAGE(PG8_SA(0, 0), cA, voffA); PG8_STAGE(PG8_SB(0, 1), cB + hstep, voffB); PG8_STAGE(PG8_SA(0, 1), cA + hstep, voffA);
        if (wr == 1) PG8_BAR;
        PG8_WAIT_V(4); PG8_BAR;
        PG8_STAGE(PG8_SB(1, 0), cB + kstep, voffB); PG8_STAGE(PG8_SA(1, 0), cA + kstep, voffA); PG8_STAGE(PG8_SB(1, 1), cB + hstep + kstep, voffB);
        PG8_WAIT_V(6); PG8_BAR;
    }
    for (;;) {
        const bool has_next = S.next(ui + 1, nxt);
        const char* nA = has_next ? (const char*)(nxt.w ? g.A2 : g.A) + (size_t)nxt.pm * tstep : cA; const char* nB = has_next ? (const char*)(nxt.w ? g.Bt2 : g.Bt) + (size_t)nxt.pn * tstep : cB;
        for (int t = 0; t < nt; t += 2) {
            const bool last = (t == nt - 2);
            const char* a1 = cA + (size_t)(t + 1) * kstep;
            const char* a2 = last ? nA : cA + (size_t)(t + 2) * kstep; const char* b2 = last ? nB : cB + (size_t)(t + 2) * kstep;
            const char* a3 = a2 + kstep; const char* b3 = b2 + kstep;
            if (last && has_next) S.a_ready(nxt);
            if constexpr (SP2) {
            PG8_LDB(B0, 0, 0); PG8_LDB(B1, 0, 1); PG8_SCHED; PG8_LDA(At, 0, 0); PG8_STAGE(PG8_SA(1, 1), a1 + hstep, voffA);
            PG8_WAIT_V(8); PG8_WAIT_L(0); PG8_BAR; PG8_MMA(0, 0, At, B0); PG8_MMA(0, 1, At, B1); PG8_BAR; PG8_SCHED;
            PG8_LDA(At, 0, 1); PG8_STAGE(PG8_SB(0, 0), b2, voffB); PG8_STAGE(PG8_SB(0, 1), b2 + hstep, voffB); PG8_STAGE(PG8_SA(0, 0), a2, voffA);
            PG8_WAIT_V(8); PG8_WAIT_L(0); PG8_BAR; PG8_MMA(1, 0, At, B0); PG8_MMA(1, 1, At, B1); PG8_BAR; PG8_SCHED;
            PG8_LDB(B0, 1, 0); PG8_LDB(B1, 1, 1); PG8_SCHED; PG8_LDA(At, 1, 0); PG8_STAGE(PG8_SA(0, 1), a2 + hstep, voffA);
            PG8_WAIT_V(8); PG8_WAIT_L(0); PG8_BAR; PG8_MMA(0, 0, At, B0); PG8_MMA(0, 1, At, B1); PG8_BAR; PG8_SCHED;
            PG8_LDA(At, 1, 1); PG8_STAGE(PG8_SB(1, 0), b3, voffB); PG8_STAGE(PG8_SB(1, 1), b3 + hstep, voffB); PG8_STAGE(PG8_SA(1, 0), a3, voffA);
            PG8_WAIT_V(8); PG8_WAIT_L(0); PG8_BAR; PG8_MMA(1, 0, At, B0); PG8_MMA(1, 1, At, B1); PG8_BAR; PG8_SCHED;
            } else {
            PG8_LDB(B0, 0, 0); PG8_SCHED; PG8_LDA(At, 0, 0); PG8_STAGE(PG8_SA(1, 1), a1 + hstep, voffA);
            PG8_WAIT_L(8); PG8_BAR; PG8_WAIT_L(0); PG8_MMA(0, 0, At, B0); PG8_BAR; PG8_SCHED;
            PG8_LDB(B1, 0, 1); PG8_STAGE(PG8_SB(0, 0), b2, voffB);
            PG8_BAR; PG8_WAIT_L(0); PG8_MMA(0, 1, At, B1); PG8_BAR;
            PG8_LDA(At, 0, 1); PG8_STAGE(PG8_SA(0, 0), a2, voffA);
            PG8_BAR; PG8_WAIT_L(0); PG8_MMA(1, 0, At, B0); PG8_BAR; PG8_SCHED;
            PG8_STAGE(PG8_SB(0, 1), b2 + hstep, voffB);
            PG8_WAIT_V(6); PG8_BAR; PG8_MMA(1, 1, At, B1); PG8_BAR;
            PG8_LDB(B0, 1, 0); PG8_SCHED; PG8_LDA(At, 1, 0); PG8_STAGE(PG8_SA(0, 1), a2 + hstep, voffA);
            PG8_WAIT_L(8); PG8_BAR; PG8_WAIT_L(0); PG8_MMA(0, 0, At, B0); PG8_BAR; PG8_SCHED;
            PG8_LDB(B1, 1, 1); PG8_STAGE(PG8_SB(1, 0), b3, voffB);
            PG8_BAR; PG8_WAIT_L(0); PG8_MMA(0, 1, At, B1); PG8_BAR;
            PG8_LDA(At, 1, 1); PG8_STAGE(PG8_SA(1, 0), a3, voffA);
            PG8_BAR; PG8_WAIT_L(0); PG8_MMA(1, 0, At, B0); PG8_BAR; PG8_SCHED;
            PG8_STAGE(PG8_SB(1, 1), b3 + hstep, voffB);
            PG8_WAIT_V(6); PG8_BAR; PG8_MMA(1, 1, At, B1); PG8_BAR;
            }
        }
        if constexpr (ALIGN_EPI) { if (wr == 0) PG8_BAR; }
        if constexpr (!Epi::AFTER_DRAIN) { E(acc, cur, wr, wc, fr, fq); S.done(cur); }
        if (!has_next) break;
#pragma unroll
        for (int a = 0; a < 2; ++a)
#pragma unroll
            for (int b = 0; b < 2; ++b)
#pragma unroll
                for (int m = 0; m < 4; ++m)
#pragma unroll
                    for (int n = 0; n < 2; ++n) acc[a][b][m][n] = (f32x4){0.f, 0.f, 0.f, 0.f};
        cur = nxt; cA = nA; cB = nB; ++ui;
        if constexpr (ALIGN_EPI) { if (wr == 1) PG8_BAR; }
    }
    PG8_WAIT_V(0);
    if constexpr (!ALIGN_EPI) { if (wr == 0) PG8_BAR; }
    PG8_BAR;
    if constexpr (Epi::AFTER_DRAIN) { E.fused(acc, cur, wr, wc, fr, fq, lds, wid, lane); S.done(cur); }
#undef PG8_SA
#undef PG8_SB
#undef PG8_STAGE
#undef PG8_LDA
#undef PG8_LDB
#undef PG8_MMA
#undef PG8_WAIT_V
#undef PG8_WAIT_L
#undef PG8_BAR
#undef PG8_SCHED
}
}
#ifndef PG8_SP2
#define PG8_SP2 true
#endif
#ifndef PG8_ALIGN
#define PG8_ALIGN true
#endif

#define LAS __attribute__((address_space(3)))
typedef unsigned short bf16_t;
typedef short bf16x8 __attribute__((ext_vector_type(8)));
typedef short bf16x4 __attribute__((ext_vector_type(4)));
typedef float f32x4 __attribute__((ext_vector_type(4)));
typedef float f32x16 __attribute__((ext_vector_type(16)));
typedef unsigned u32x4 __attribute__((ext_vector_type(4)));
typedef unsigned u32x2 __attribute__((ext_vector_type(2)));

constexpr int MTOK = 16384, DM = 1024, SEQ = 4096, NB = 4;
constexpr size_t MiB = 1u << 20;
constexpr size_t ARR = (size_t)MTOK * DM;
constexpr size_t WS_MODP = 0;
constexpr size_t WS_GATE = 786432;
constexpr size_t WS_AGG = 1 * MiB;
constexpr size_t WS_RSS = 5 * MiB;
constexpr size_t WS_WG = 6 * MiB;
constexpr size_t WS_WPA = 8 * MiB, WS_WPB = 10 * MiB, WS_WO = 12 * MiB, WS_WV = 14 * MiB;
constexpr size_t WS_WIN = 16 * MiB;
constexpr size_t WS_H = 32 * MiB;
constexpr size_t WS_XA = 64 * MiB, WS_ZA = 96 * MiB, WS_Q = 128 * MiB, WS_K = 160 * MiB, WS_ZB = 192 * MiB;
constexpr size_t WS_VT = 224 * MiB;
constexpr size_t WS_BAR = 802816;
constexpr int LDS_CIN = 131072, LDS_SEG = 131072 + 8192;
constexpr int LDS_MISC = 147456, LDS_RPB = 147456 + 256;
constexpr int LDS_BYTES = 147456 + 256 + 3840;

__device__ __forceinline__ float bf2f(unsigned short b) { return __uint_as_float(((unsigned)b) << 16); }
__device__ __forceinline__ unsigned pk2(float lo, float hi) { return pg8::cvt_pk_bf16(lo, hi); }
__device__ __forceinline__ float sigm(float v) { return __builtin_amdgcn_rcpf(1.f + __builtin_amdgcn_exp2f(-1.44269504089f * v)); }
__device__ __forceinline__ float wave_sum(float v) {
#pragma unroll
    for (int o = 1; o < 64; o <<= 1) v += __shfl_xor(v, o);
    return v;
}
#define LDS_WAIT() asm volatile("s_waitcnt lgkmcnt(0)" ::: "memory")

struct EpiProj {
    static constexpr bool PERM = true, AFTER_DRAIN = false;
    bf16_t* O5; bf16_t* OG;
    __device__ __forceinline__ void operator()(const f32x4 (&acc)[2][2][4][2], const pg8::Unit& u, int wr, int wc, int fr, int fq) const {
        const int arr = u.pn >> 2, colt = (u.pn & 3) * 256;
        bf16_t* base = arr < 5 ? O5 + (size_t)arr * ARR : OG + (size_t)(arr - 5) * ARR;
        const int mode = (arr == 1 || arr == 4) ? 1 : (arr >= 5 ? 2 : (arr == 2 ? 3 : 0));
        const int row0 = u.pm * 256 + wr * 64 + fr, col0 = colt + wc * 32 + 8 * fq;
#pragma unroll
        for (int ai = 0; ai < 2; ++ai)
#pragma unroll
            for (int m = 0; m < 4; ++m) { bf16_t* rowp = base + (size_t)(row0 + ai * 128 + m * 16) * DM + col0;
#pragma unroll
                for (int bj = 0; bj < 2; ++bj) { f32x4 v0 = acc[ai][bj][m][0], v1 = acc[ai][bj][m][1];
                    if (mode == 1) {
#pragma unroll
                        for (int j = 0; j < 4; ++j) { v0[j] = v0[j] * sigm(v0[j]); v1[j] = v1[j] * sigm(v1[j]); } }
                    else if (mode == 2) {
#pragma unroll
                        for (int j = 0; j < 4; ++j) { v0[j] = sigm(v0[j]); v1[j] = sigm(v1[j]); } }
                    else if (mode == 3) { v0 = v0 * (0.125f * 1.44269504089f); v1 = v1 * (0.125f * 1.44269504089f); }
                    u32x4 w; w.x = pk2(v0[0], v0[1]); w.y = pk2(v0[2], v0[3]); w.z = pk2(v1[0], v1[1]); w.w = pk2(v1[2], v1[3]);
                    *(u32x4*)(rowp + bj * 128) = w; } }
    }
};
struct EpiPlain {
    static constexpr bool PERM = true, AFTER_DRAIN = false;
    bf16_t* O; int ldc;
    __device__ __forceinline__ void operator()(const f32x4 (&acc)[2][2][4][2], const pg8::Unit& u, int wr, int wc, int fr, int fq) const {
        const int row0 = u.pm * 256 + wr * 64 + fr, col0 = u.pn * 256 + wc * 32 + 8 * fq;
#pragma unroll
        for (int ai = 0; ai < 2; ++ai)
#pragma unroll
            for (int m = 0; m < 4; ++m) { bf16_t* rowp = O + (size_t)(row0 + ai * 128 + m * 16) * ldc + col0;
#pragma unroll
                for (int bj = 0; bj < 2; ++bj) { const f32x4 v0 = acc[ai][bj][m][0], v1 = acc[ai][bj][m][1];
                    u32x4 w; w.x = pk2(v0[0], v0[1]); w.y = pk2(v0[2], v0[3]); w.z = pk2(v1[0], v1[1]); w.w = pk2(v1[2], v1[3]);
                    *(u32x4*)(rowp + bj * 128) = w; } }
    }
};
struct EpiProjVT {
    static constexpr bool PERM = true, AFTER_DRAIN = false;
    EpiProj p; EpiPlain v;
    __device__ __forceinline__ void operator()(const f32x4 (&acc)[2][2][4][2], const pg8::Unit& u, int wr, int wc, int fr, int fq) const { if (u.w) v(acc, u, wr, wc, fr, fq); else p(acc, u, wr, wc, fr, fq); }
};
struct EpiGate2 {
    static constexpr bool PERM = true, AFTER_DRAIN = false;
    const bf16_t* Ga; const bf16_t* Gb; bf16_t* Tb; bf16_t* O;
    __device__ __forceinline__ void operator()(const f32x4 (&acc)[2][2][4][2], const pg8::Unit& u, int wr, int wc, int fr, int fq) const {
        const int row0 = u.pm * 256 + wr * 64 + fr, col0 = u.pn * 256 + wc * 32 + 8 * fq;
        const bf16_t* G = u.w ? Gb : Ga; bf16_t* dst = u.w ? O : Tb;
#pragma unroll
        for (int ai = 0; ai < 2; ++ai) {
            bf16x8 g[4][2], t[4][2];
#pragma unroll
            for (int m = 0; m < 4; ++m)
#pragma unroll
                for (int bj = 0; bj < 2; ++bj) { const size_t off = (size_t)(row0 + ai * 128 + m * 16) * DM + col0 + bj * 128;
                    g[m][bj] = *(const bf16x8*)(G + off);
                    if (u.w) t[m][bj] = *(const bf16x8*)(Tb + off); else t[m][bj] = (bf16x8){0, 0, 0, 0, 0, 0, 0, 0}; }
            asm volatile("" ::: "memory");
#pragma unroll
            for (int m = 0; m < 4; ++m)
#pragma unroll
                for (int bj = 0; bj < 2; ++bj) { const size_t off = (size_t)(row0 + ai * 128 + m * 16) * DM + col0 + bj * 128;
                    const f32x4 v0 = acc[ai][bj][m][0], v1 = acc[ai][bj][m][1];
                    float o[8];
#pragma unroll
                    for (int j = 0; j < 4; ++j) { o[j] = fmaf(bf2f((unsigned short)g[m][bj][j]), v0[j], bf2f((unsigned short)t[m][bj][j])); o[4 + j] = fmaf(bf2f((unsigned short)g[m][bj][4 + j]), v1[j], bf2f((unsigned short)t[m][bj][4 + j])); }
                    u32x4 w; w.x = pk2(o[0], o[1]); w.y = pk2(o[2], o[3]); w.z = pk2(o[4], o[5]); w.w = pk2(o[6], o[7]);
                    *(u32x4*)(dst + off) = w; }
            asm volatile("" ::: "memory");
        }
    }
};
struct EpiOut {
    static constexpr bool PERM = true, AFTER_DRAIN = false;
    const float* gate; bf16_t* O;
    __device__ __forceinline__ void operator()(const f32x4 (&acc)[2][2][4][2], const pg8::Unit& u, int wr, int wc, int fr, int fq) const {
        const int row0 = u.pm * 256 + wr * 64 + fr, col0 = u.pn * 256 + wc * 32 + 8 * fq;
        const float* gp = gate + (size_t)(u.pm >> 4) * DM + col0;
        f32x4 gv[2][2];
#pragma unroll
        for (int bj = 0; bj < 2; ++bj)
#pragma unroll
            for (int n = 0; n < 2; ++n) gv[bj][n] = *(const f32x4*)(gp + bj * 128 + n * 4);
#pragma unroll
        for (int ai = 0; ai < 2; ++ai)
#pragma unroll
            for (int m = 0; m < 4; ++m) { bf16_t* rowp = O + (size_t)(row0 + ai * 128 + m * 16) * DM + col0;
#pragma unroll
                for (int bj = 0; bj < 2; ++bj) { const f32x4 v0 = gv[bj][0] * acc[ai][bj][m][0], v1 = gv[bj][1] * acc[ai][bj][m][1];
                    u32x4 w; w.x = pk2(v0[0], v0[1]); w.y = pk2(v0[2], v0[3]); w.z = pk2(v1[0], v1[1]); w.w = pk2(v1[2], v1[3]);
                    *(u32x4*)(rowp + bj * 128) = w; } }
    }
};

__device__ __forceinline__ void p0_transpose_item(const float* W, int K, int N, bf16_t* WT, int dst_row0, int k0, int n0, LAS float* scr, int lane, float scale = 1.f) {
    float wv[32];
#pragma unroll
    for (int i = 0; i < 32; ++i) { const int kk = 2 * i + (lane >> 5); wv[i] = W[(size_t)(k0 + kk) * N + n0 + (lane & 31)]; }
#pragma unroll
    for (int i = 0; i < 32; ++i) { const int kk = 2 * i + (lane >> 5); scr[kk * 33 + (lane & 31)] = wv[i] * scale; }
    LDS_WAIT(); asm volatile("" ::: "memory");
    const int c = lane & 7;
#pragma unroll
    for (int j = 0; j < 4; ++j) { const int n = (lane >> 3) + 8 * j; const LAS float* s = scr + (8 * c) * 33 + n;
        u32x4 o; o.x = pk2(s[0 * 33], s[1 * 33]); o.y = pk2(s[2 * 33], s[3 * 33]); o.z = pk2(s[4 * 33], s[5 * 33]); o.w = pk2(s[6 * 33], s[7 * 33]);
        *(u32x4*)(WT + (size_t)(dst_row0 + n) * K + k0 + 8 * c) = o; }
    LDS_WAIT(); asm volatile("" ::: "memory");
}

struct Args { const float* in[23]; float* out; unsigned char* ws; };

__device__ __forceinline__ void p0_prologue(const Args& a, LAS unsigned char* lds, int gw, int NGW, int wave, int lane) {
    LAS float* scr = (LAS float*)(lds + wave * 16384);
    unsigned char* ws = a.ws;
    const float* c = a.in[1]; const float* w_c = a.in[3]; const float* w_in = a.in[5];
    float* modp = (float*)(ws + WS_MODP);
    constexpr int I_MOD = 768, I_IN = 16 * 256, I_SQ = 16 * 32, I_G = 4 * 16 * 2;
    constexpr int NITEMS = I_MOD + I_IN + 3 * I_SQ + I_G;
    for (int it = gw; it < NITEMS; it += NGW) {
        int r = it;
        if (r < I_MOD) {
            const int cgi = r % 48, kc = r / 48, col = cgi * 64 + lane, k0 = kc * 64;
            float sv[4];
#pragma unroll
            for (int b = 0; b < 4; ++b) { const float cv = c[b * DM + k0 + lane]; sv[b] = cv * sigm(cv); }
            float acc[4] = {0.f, 0.f, 0.f, 0.f};
#pragma unroll 32
            for (int kk = 0; kk < 64; ++kk) { const float w = w_c[(size_t)(k0 + kk) * 3072 + col];
#pragma unroll
                for (int b = 0; b < 4; ++b) acc[b] += __shfl(sv[b], kk) * w; }
#pragma unroll
            for (int b = 0; b < 4; ++b) modp[(size_t)(kc * 4 + b) * 3072 + col] = acc[b];
            continue;
        }
        r -= I_MOD;
        if (r < I_IN) { const int kb = r / 256, nb = r % 256, n0 = nb * 32, cb = n0 >> 10;
            if (cb == 4) p0_transpose_item(w_in, 1024, 8192, (bf16_t*)(ws + WS_WV), n0 - 4096, kb * 64, n0, scr, lane);
            else p0_transpose_item(w_in, 1024, 8192, (bf16_t*)(ws + WS_WIN), (cb < 4 ? cb : cb - 1) * 1024 + (n0 & 1023), kb * 64, n0, scr, lane);
            continue; }
        r -= I_IN;
        if (r < 3 * I_SQ) { const int which = r / I_SQ, rr = r % I_SQ, kb = rr / 32, nb = rr % 32;
            const float* W = which == 0 ? a.in[19] : (which == 1 ? a.in[20] : a.in[21]);
            bf16_t* WT = (bf16_t*)(ws + (which == 0 ? WS_WPA : (which == 1 ? WS_WPB : WS_WO)));
            p0_transpose_item(W, 1024, 1024, WT, nb * 32, kb * 64, nb * 32, scr, lane);
            continue; }
        r -= 3 * I_SQ;
        { const int g = r / 32, rr = r % 32, hb = rr / 2, nb = rr % 2;
            const float* W = (g == 0 ? a.in[8] : (g == 1 ? a.in[10] : (g == 2 ? a.in[13] : a.in[15]))) + (size_t)hb * 4096;
            bf16_t* WT = (bf16_t*)(ws + WS_WG) + (size_t)(g * 16 + hb) * 4096;
            p0_transpose_item(W, 64, 64, WT, nb * 32, 0, nb * 32, scr, lane, -1.44269504089f); }
    }
}

__device__ __forceinline__ void p1_hpass(const Args& a, LAS unsigned char* lds, int G, int tid, int wave, int lane) {
    unsigned char* ws = a.ws;
    const float* x = a.in[0]; const float* g_pre = a.in[2]; const float* b_c = a.in[4];
    const float* modp = (const float*)(ws + WS_MODP);
    bf16_t* H = (bf16_t*)(ws + WS_H);
    LAS float* sh = (LAS float*)lds;
    for (int rb = blockIdx.x; rb < MTOK / 64; rb += G) {
        const int b = rb >> 6;
        __syncthreads();
        for (int idx = tid; idx < 2048; idx += 512) { float s = b_c[idx];
#pragma unroll
            for (int kc = 0; kc < 16; ++kc) s += modp[(size_t)(kc * 4 + b) * 3072 + idx];
            sh[idx] = idx < 1024 ? s : 1.f + s; }
        __syncthreads();
        for (int rr = wave; rr < 64; rr += 16) {
            const int row0 = rb * 64 + rr;
            f32x4 v[2][4]; float s[2] = {0.f, 0.f};
#pragma unroll
            for (int q = 0; q < 2; ++q) { const f32x4* xr = (const f32x4*)(x + (size_t)(row0 + 8 * q) * DM) + lane;
#pragma unroll
                for (int j = 0; j < 4; ++j) v[q][j] = xr[64 * j]; }
#pragma unroll
            for (int q = 0; q < 2; ++q)
#pragma unroll
                for (int j = 0; j < 4; ++j) s[q] += (v[q][j][0] * v[q][j][0] + v[q][j][1] * v[q][j][1]) + (v[q][j][2] * v[q][j][2] + v[q][j][3] * v[q][j][3]);
#pragma unroll
            for (int q = 0; q < 2; ++q) { const float rstd = __builtin_amdgcn_rsqf(wave_sum(s[q]) * (1.f / 1024.f) + 1e-6f);
#pragma unroll
                for (int j = 0; j < 4; ++j) { const int col = 4 * lane + 256 * j;
                    const f32x4 g = *(const f32x4*)(g_pre + col); const f32x4 sc = *(const LAS f32x4*)(sh + 1024 + col); const f32x4 sf = *(const LAS f32x4*)(sh + col);
                    const f32x4 o = (v[q][j] * rstd) * g * sc + sf;
                    u32x2 w; w.x = pk2(o[0], o[1]); w.y = pk2(o[2], o[3]);
                    *(u32x2*)(H + (size_t)(row0 + 8 * q) * DM + col) = w; } }
        }
    }
    float* gate = (float*)(ws + WS_GATE);
    for (int idx = blockIdx.x * 512 + tid; idx < 4096; idx += G * 512) { const int b = idx >> 10, col = idx & 1023; float s = b_c[2048 + col];
#pragma unroll
        for (int kc = 0; kc < 16; ++kc) s += modp[(size_t)(kc * 4 + b) * 3072 + 2048 + col];
        gate[idx] = s; }
}

__device__ __forceinline__ int attn_fk(int col) { return ((col >> 1) & 1) | (((col >> 3) & 3) << 1); }
__device__ __forceinline__ void attn_phase(const bf16_t* Q, const bf16_t* Kb, const bf16_t* VT, const bf16_t* ZB, const float* rpb, bf16_t* YB, LAS unsigned char* lds, int vcu, int G, int tid, int wave, int lane) {
    const int fr = lane & 15, fq = lane >> 4;
    constexpr float L2E = 1.44269504089f;
    LAS float* rpbL = (LAS float*)(lds + LDS_RPB);
    const int rsel = wave >> 2, j = wave & 3;
    const int cs = min(max(16 * j - 8, 0), 32);
    const int qc = 16 * j + fr, c0 = min(max(qc - 8, 0), 48);
    const int lcol = tid >> 3, lch = tid & 7;
    float maskadd[8];
#pragma unroll
    for (int e = 0; e < 8; ++e) { const int kcol = cs + 8 * fq + e; maskadd[e] = ((kcol >= c0) && (kcol < c0 + 16)) ? 0.f : -1e30f; }
    const int rpoff = cs + 8 * fq - qc + 31;
    for (int u = vcu; u < 256; u += G) {
        const int band = u & 3, h = (u >> 2) & 15, b = u >> 6, R0 = band * 16;
        __syncthreads();
        for (int i = tid; i < 15 * 64; i += 512) { const int dr = i >> 6, dc = (i & 63) - 16; rpbL[i] = (dc >= 0 && dc < 31) ? rpb[(size_t)(h * 15 + dr) * 31 + dc] * L2E : 0.f; }
        int loaded_hi;
        {
            const int lo = min(max(R0 - 4, 0), 56), hi = min(max(R0 - 3, 0), 56) + 7;
#pragma unroll 1
            for (int k3 = 0; k3 < 9; k3 += 3) {
                u32x4 kv[3], vv[3];
#pragma unroll
                for (int k = 0; k < 3; ++k) { const int row = lo + k3 + k;
                    if (row <= hi) { const size_t tokrow = (size_t)b * SEQ + (size_t)row * 64;
                        kv[k] = *(const u32x4*)(Kb + (tokrow + lcol) * DM + h * 64 + lch * 8);
                        vv[k] = *(const u32x4*)(VT + (size_t)(h * 64 + lcol) * MTOK + tokrow + lch * 8); } }
#pragma unroll
                for (int k = 0; k < 3; ++k) { const int row = lo + k3 + k;
                    if (row <= hi) { const int slot = row % 9;
                        *(LAS u32x4*)(lds + slot * 16384 + lcol * 128 + ((lch ^ attn_fk(lcol)) << 4)) = kv[k];
                        *(LAS u32x4*)(lds + slot * 16384 + 8192 + lcol * 128 + ((lch ^ ((lcol >> 1) & 7)) << 4)) = vv[k]; } }
            }
            loaded_hi = hi;
        }
#pragma unroll 1
        for (int ss = 0; ss < 8; ++ss) {
            const int r = R0 + 2 * ss;
            __syncthreads();
            const int hi_next = ss < 7 ? min(max(r - 1, 0), 56) + 7 : loaded_hi;
            u32x4 pkv[2], pvv[2];
#pragma unroll
            for (int k = 0; k < 2; ++k) { const int row = loaded_hi + 1 + k;
                if (row <= hi_next) { const size_t tokrow = (size_t)b * SEQ + (size_t)row * 64;
                    pkv[k] = *(const u32x4*)(Kb + (tokrow + lcol) * DM + h * 64 + lch * 8);
                    pvv[k] = *(const u32x4*)(VT + (size_t)(h * 64 + lcol) * MTOK + tokrow + lch * 8); } }
            asm volatile("" ::: "memory");
            const int ro = r + rsel, r0 = min(max(ro - 4, 0), 56);
            const size_t tokq = (size_t)b * SEQ + ro * 64 + qc;
            bf16x8 qf[2];
#pragma unroll
            for (int ks = 0; ks < 2; ++ks) qf[ks] = *(const bf16x8*)(Q + tokq * DM + h * 64 + ks * 32 + fq * 8);
            f32x4 s[8][2];
            float mx = -1e30f;
#pragma unroll
            for (int w = 0; w < 8; ++w) { const int slot = (r0 + w) % 9; const LAS float* rp = rpbL + (r0 + w - ro + 7) * 64 + rpoff;
#pragma unroll
                for (int t = 0; t < 2; ++t) { const int kc = cs + 8 * (fr >> 2) + (fr & 3) + 4 * t; const int fk = attn_fk(kc);
                    f32x4 acc;
#pragma unroll
                    for (int i = 0; i < 4; ++i) acc[i] = rp[4 * t + i] + maskadd[4 * t + i];
#pragma unroll
                    for (int ks = 0; ks < 2; ++ks) { const bf16x8 kf = *(const LAS bf16x8*)(lds + slot * 16384 + kc * 128 + (((ks * 4 + fq) ^ fk) << 4));
                        acc = __builtin_amdgcn_mfma_f32_16x16x32_bf16(kf, qf[ks], acc, 0, 0, 0); }
                    s[w][t] = acc;
                    mx = fmaxf(fmaxf(mx, fmaxf(acc[0], acc[1])), fmaxf(acc[2], acc[3])); } }
            mx = fmaxf(mx, __shfl_xor(mx, 16)); mx = fmaxf(mx, __shfl_xor(mx, 32));
            float sum = 0.f; bf16x8 pf[8];
#pragma unroll
            for (int w = 0; w < 8; ++w) { float p[8];
#pragma unroll
                for (int t = 0; t < 2; ++t)
#pragma unroll
                    for (int i = 0; i < 4; ++i) { const float e = __builtin_amdgcn_exp2f(s[w][t][i] - mx); p[4 * t + i] = e; sum += e; }
                u32x4 pw; pw.x = pk2(p[0], p[1]); pw.y = pk2(p[2], p[3]); pw.z = pk2(p[4], p[5]); pw.w = pk2(p[6], p[7]);
                pf[w] = __builtin_bit_cast(bf16x8, pw); }
            sum += __shfl_xor(sum, 16); sum += __shfl_xor(sum, 32);
            const float inv = 1.f / sum;
            f32x4 o[4];
#pragma unroll
            for (int dt = 0; dt < 4; ++dt) o[dt] = (f32x4){0.f, 0.f, 0.f, 0.f};
#pragma unroll
            for (int w = 0; w < 8; ++w) { const int slot = (r0 + w) % 9;
#pragma unroll
                for (int dt = 0; dt < 4; ++dt) { const int d = dt * 16 + fr;
                    const bf16x8 vf = *(const LAS bf16x8*)(lds + slot * 16384 + 8192 + d * 128 + ((((cs >> 3) + fq) ^ ((d >> 1) & 7)) << 4));
                    o[dt] = __builtin_amdgcn_mfma_f32_16x16x32_bf16(vf, pf[w], o[dt], 0, 0, 0); } }
#pragma unroll
            for (int dt = 0; dt < 4; ++dt) { const size_t off = tokq * DM + h * 64 + dt * 16 + 4 * fq;
                const bf16x4 z = *(const bf16x4*)(ZB + off);
                u32x2 w; w.x = pk2(o[dt][0] * inv * bf2f((unsigned short)z[0]), o[dt][1] * inv * bf2f((unsigned short)z[1]));
                w.y = pk2(o[dt][2] * inv * bf2f((unsigned short)z[2]), o[dt][3] * inv * bf2f((unsigned short)z[3]));
                *(u32x2*)(YB + off) = w; }
            if (ss < 7) {
                __syncthreads();
#pragma unroll
                for (int k = 0; k < 2; ++k) { const int row = loaded_hi + 1 + k;
                    if (row <= hi_next) { const int slot = row % 9;
                        *(LAS u32x4*)(lds + slot * 16384 + lcol * 128 + ((lch ^ attn_fk(lcol)) << 4)) = pkv[k];
                        *(LAS u32x4*)(lds + slot * 16384 + 8192 + lcol * 128 + ((lch ^ ((lcol >> 1) & 7)) << 4)) = pvv[k]; } }
                loaded_hi = hi_next;
            }
        }
    }
    __syncthreads();
}

template <bool FINAL, int DIR>
__device__ __forceinline__ void scan_dir(const LAS bf16x8* afrL, int lane, int ct, const bf16_t* WGr, const bf16_t* WGi, float br, float bi, float cl, float Hin,
                                         const bf16x8 (&idf)[2], float& Aout, float& Uout, const bf16_t* ZAp, bf16_t* YAp, unsigned (&hp)[4][8]) {
    const int n = lane & 31, hf = lane >> 5;
    bf16x8 Br[4], Bi[4];
#pragma unroll
    for (int kk = 0; kk < 4; ++kk) { Br[kk] = *(const bf16x8*)(WGr + (size_t)(32 * ct + n) * 64 + 16 * kk + 8 * hf); Bi[kk] = *(const bf16x8*)(WGi + (size_t)(32 * ct + n) * 64 + 16 * kk + 8 * hf); }
    float H = Hin, Ap = 1.f;
#pragma unroll 1
    for (int si = 0; si < 4; ++si) { const int s = DIR ? 3 - si : si;
        f32x16 ar, ai, ax;
#pragma unroll
        for (int e = 0; e < 16; ++e) { ar[e] = br; ai[e] = bi; ax[e] = 0.f; }
#pragma unroll
        for (int kk = 0; kk < 4; ++kk) { const bf16x8 av = afrL[(s * 4 + kk) * 64 + lane];
            ar = __builtin_amdgcn_mfma_f32_32x32x16_bf16(av, Br[kk], ar, 0, 0, 0); ai = __builtin_amdgcn_mfma_f32_32x32x16_bf16(av, Bi[kk], ai, 0, 0, 0); }
        { const bf16x8 a0 = afrL[(s * 4 + 2 * ct) * 64 + lane], a1 = afrL[(s * 4 + 2 * ct + 1) * 64 + lane];
            ax = __builtin_amdgcn_mfma_f32_32x32x16_bf16(a0, idf[0], ax, 0, 0, 0); ax = __builtin_amdgcn_mfma_f32_32x32x16_bf16(a1, idf[1], ax, 0, 0, 0); }
        const bf16_t* zs = ZAp + (size_t)(16 * s) * DM; bf16_t* ys = YAp + (size_t)(16 * s) * DM;
        bf16_t zv[16];
        if (FINAL && DIR == 1) {
#pragma unroll
            for (int e = 0; e < 16; ++e) zv[e] = zs[(size_t)e * DM];
            asm volatile("" ::: "memory"); }
        float hv[16];
#pragma unroll
        for (int ei = 0; ei < 16; ++ei) { const int e = DIR ? 15 - ei : ei;
            const float r = __builtin_amdgcn_rcpf(1.f + __builtin_amdgcn_exp2f(ar[e])), ig = __builtin_amdgcn_rcpf(1.f + __builtin_amdgcn_exp2f(ai[e]));
            const float av = __builtin_amdgcn_exp2f(cl * r);
            const float om = fmaf(-av, av, 1.f);
            const float u = __builtin_amdgcn_sqrtf(om) * (ig * ax[e]);
            H = fmaf(av, H, u);
            hv[e] = H;
            if (!FINAL) Ap *= av; }
        if (FINAL) {
            if (DIR == 0) {
                unsigned pk[8];
#pragma unroll
                for (int e2 = 0; e2 < 8; ++e2) pk[e2] = pk2(hv[2 * e2], hv[2 * e2 + 1]);
#pragma unroll
                for (int sq = 0; sq < 4; ++sq) if (s == sq) {
#pragma unroll
                    for (int e2 = 0; e2 < 8; ++e2) hp[sq][e2] = pk[e2]; }
            } else {
                unsigned pws[8];
#pragma unroll
                for (int e2 = 0; e2 < 8; ++e2) pws[e2] = hp[0][e2];
#pragma unroll
                for (int sq = 1; sq < 4; ++sq) if (s == sq) {
#pragma unroll
                    for (int e2 = 0; e2 < 8; ++e2) pws[e2] = hp[sq][e2]; }
#pragma unroll
                for (int e2 = 0; e2 < 8; ++e2) { const unsigned pw = pws[e2];
                    const float y0 = (hv[2 * e2] + __uint_as_float(pw << 16)) * bf2f(zv[2 * e2]);
                    const float y1 = (hv[2 * e2 + 1] + __uint_as_float(pw & 0xffff0000u)) * bf2f(zv[2 * e2 + 1]);
                    const unsigned yw = pk2(y0, y1);
                    ys[(size_t)(2 * e2) * DM] = (bf16_t)(yw & 0xffffu); ys[(size_t)(2 * e2 + 1) * DM] = (bf16_t)(yw >> 16); }
            }
        }
    }
    Aout = Ap; Uout = H;
}

template <bool FINAL>
__device__ __forceinline__ void scan_phase(const Args& a, LAS unsigned char* lds, int gw, int NGW, int wave, int lane) {
    unsigned char* ws = a.ws;
    const bf16_t* XA = (const bf16_t*)(ws + WS_XA); const bf16_t* ZA = (const bf16_t*)(ws + WS_ZA);
    const bf16_t* WG = (const bf16_t*)(ws + WS_WG);
    const float* conv_w = a.in[6]; const float* conv_b = a.in[7];
    typedef float f32x2 __attribute__((ext_vector_type(2)));
    f32x2* AGG = (f32x2*)(ws + WS_AGG);
    bf16_t* YA = (bf16_t*)(ws + WS_H);
    LAS bf16x8* afrL = (LAS bf16x8*)(lds + wave * 16384);
    const int n = lane & 31, hf = lane >> 5;
    bf16x8 idf[2];
#pragma unroll
    for (int k2 = 0; k2 < 2; ++k2)
#pragma unroll
        for (int jj = 0; jj < 8; ++jj) idf[k2][jj] = (16 * k2 + 8 * hf + jj == n) ? (short)0x3F80 : (short)0;
    for (int wt = gw; wt < 2048; wt += NGW) {
        const int cp = wt & 31, jb = (wt >> 5) & 15, b = wt >> 9, ch0 = jb * 64;
        { const int a_half = (n >> 2) & 1, a_idx = (n & 3) + 4 * (n >> 3), a_chunk = 2 * cp + a_half;
#pragma unroll 1
          for (int kk = 0; kk < 4; ++kk) { const int ch = ch0 + 16 * kk + 8 * hf;
              float cw[4][8], cb[8];
#pragma unroll
              for (int w = 0; w < 4; ++w) { const f32x4 c0 = *(const f32x4*)(conv_w + w * DM + ch), c1 = *(const f32x4*)(conv_w + w * DM + ch + 4);
#pragma unroll
                  for (int jj = 0; jj < 4; ++jj) { cw[w][jj] = c0[jj]; cw[w][4 + jj] = c1[jj]; } }
              { const f32x4 c0 = *(const f32x4*)(conv_b + ch), c1 = *(const f32x4*)(conv_b + ch + 4);
#pragma unroll
                  for (int jj = 0; jj < 4; ++jj) { cb[jj] = c0[jj]; cb[4 + jj] = c1[jj]; } }
#pragma unroll
              for (int s = 0; s < 4; ++s) { const int p = a_chunk * 64 + 16 * s + a_idx;
                  float acc[8];
#pragma unroll
                  for (int jj = 0; jj < 8; ++jj) acc[jj] = cb[jj];
#pragma unroll
                  for (int w = 0; w < 4; ++w) { const int pp = p + w - 2; const bool ok = (pp >= 0) && (pp < SEQ); const int pc = min(max(pp, 0), SEQ - 1);
                      const bf16x8 xv = *(const bf16x8*)(XA + ((size_t)b * SEQ + pc) * DM + ch);
#pragma unroll
                      for (int jj = 0; jj < 8; ++jj) acc[jj] = fmaf(cw[w][jj], ok ? bf2f((unsigned short)xv[jj]) : 0.f, acc[jj]); }
                  u32x4 pw; pw.x = pk2(acc[0], acc[1]); pw.y = pk2(acc[2], acc[3]); pw.z = pk2(acc[4], acc[5]); pw.w = pk2(acc[6], acc[7]);
                  afrL[(s * 4 + kk) * 64 + lane] = __builtin_bit_cast(bf16x8, pw); } } }
        LDS_WAIT(); asm volatile("" ::: "memory");
        const int chunk = 2 * cp + hf;
        if (FINAL) {
            const int tid = threadIdx.x, pdir = tid >> 8, pseg = (tid >> 6) & 3, pch = tid & 63, q = cp >> 3;
            LAS f32x2* segL = (LAS f32x2*)(lds + LDS_SEG);
            LAS float* cinL = (LAS float*)(lds + LDS_CIN);
            f32x2 g[16];
#pragma unroll
            for (int i = 0; i < 16; ++i) g[i] = AGG[((size_t)(b * 2 + pdir) * 64 + 16 * pseg + i) * DM + ch0 + pch];
            float As = 1.f, Us = 0.f;
#pragma unroll
            for (int ii = 0; ii < 16; ++ii) { const int i = pdir ? 15 - ii : ii; Us = fmaf(g[i][0], Us, g[i][1]); As *= g[i][0]; }
            __syncthreads();
            segL[(pdir * 4 + pseg) * 64 + pch] = (f32x2){As, Us};
            __syncthreads();
            if (pseg == q) { float Hc = 0.f;
                if (pdir == 0) { for (int s2 = 0; s2 < pseg; ++s2) { const f32x2 sg = segL[(0 * 4 + s2) * 64 + pch]; Hc = fmaf(sg[0], Hc, sg[1]); } }
                else { for (int s2 = 3; s2 > pseg; --s2) { const f32x2 sg = segL[(1 * 4 + s2) * 64 + pch]; Hc = fmaf(sg[0], Hc, sg[1]); } }
#pragma unroll
                for (int ii = 0; ii < 16; ++ii) { const int i = pdir ? 15 - ii : ii; cinL[(pdir * 16 + i) * 64 + pch] = Hc; Hc = fmaf(g[i][0], Hc, g[i][1]); } }
            __syncthreads();
        }
#pragma unroll 1
        for (int ct = 0; ct < 2; ++ct) { const int ch = ch0 + 32 * ct + n;
            float Af, Uf, Ab, Ub;
            unsigned hp[4][8];
            {
                const float br = -1.44269504089f * a.in[9][ch], bi = -1.44269504089f * a.in[11][ch]; const float lam = a.in[12][ch];
                const float cl = -8.f * 1.44269504089f * log1pf(expf(-lam));
                float Hin = 0.f;
                if (FINAL) Hin = ((const LAS float*)(lds + LDS_CIN))[(0 * 16 + (chunk & 15)) * 64 + 32 * ct + n];
                scan_dir<FINAL, 0>(afrL, lane, ct, WG + (size_t)(0 * 16 + jb) * 4096, WG + (size_t)(1 * 16 + jb) * 4096, br, bi, cl, Hin, idf, Af, Uf, ZA + ((size_t)b * SEQ + chunk * 64) * DM + ch, YA + ((size_t)b * SEQ + chunk * 64) * DM + ch, hp);
            }
            {
                const float br = -1.44269504089f * a.in[14][ch], bi = -1.44269504089f * a.in[16][ch]; const float lam = a.in[17][ch];
                const float cl = -8.f * 1.44269504089f * log1pf(expf(-lam));
                float Hin = 0.f;
                if (FINAL) Hin = ((const LAS float*)(lds + LDS_CIN))[(1 * 16 + (chunk & 15)) * 64 + 32 * ct + n];
                scan_dir<FINAL, 1>(afrL, lane, ct, WG + (size_t)(2 * 16 + jb) * 4096, WG + (size_t)(3 * 16 + jb) * 4096, br, bi, cl, Hin, idf, Ab, Ub, ZA + ((size_t)b * SEQ + chunk * 64) * DM + ch, YA + ((size_t)b * SEQ + chunk * 64) * DM + ch, hp);
            }
            if (!FINAL) {
                AGG[((size_t)(b * 2 + 0) * 64 + chunk) * DM + ch] = (f32x2){Af, Uf};
                AGG[((size_t)(b * 2 + 1) * 64 + chunk) * DM + ch] = (f32x2){Ab, Ub};
            }
        }
        LDS_WAIT(); asm volatile("" ::: "memory");
    }
}

__device__ __forceinline__ void final_norm(const Args& a, int gw, int NGW, int lane) {
    const float* x = a.in[0]; const float* g_final = a.in[22]; float* out = a.out;
    f32x4 g[4];
#pragma unroll
    for (int j = 0; j < 4; ++j) g[j] = *((const f32x4*)g_final + lane + 64 * j);
    for (int row0 = gw; row0 < MTOK; row0 += 2 * NGW) {
        f32x4 v[2][4]; bf16x4 bb[2][4]; float ss[2] = {0.f, 0.f};
#pragma unroll
        for (int q = 0; q < 2; ++q) { const int row = min(row0 + q * NGW, MTOK - 1);
            const f32x4* xrow = (const f32x4*)(x + (size_t)row * DM) + lane; const bf16x4* brow = (const bf16x4*)((const bf16_t*)(a.ws + WS_ZB) + (size_t)row * DM) + lane;
#pragma unroll
            for (int j = 0; j < 4; ++j) { v[q][j] = xrow[64 * j]; bb[q][j] = brow[64 * j]; } }
#pragma unroll
        for (int q = 0; q < 2; ++q)
#pragma unroll
            for (int j = 0; j < 4; ++j) {
                v[q][j][0] += bf2f((unsigned short)bb[q][j][0]); v[q][j][1] += bf2f((unsigned short)bb[q][j][1]); v[q][j][2] += bf2f((unsigned short)bb[q][j][2]); v[q][j][3] += bf2f((unsigned short)bb[q][j][3]);
                ss[q] += (v[q][j][0] * v[q][j][0] + v[q][j][1] * v[q][j][1]) + (v[q][j][2] * v[q][j][2] + v[q][j][3] * v[q][j][3]); }
#pragma unroll
        for (int q = 0; q < 2; ++q) { const int row = row0 + q * NGW;
            const float rstd = __builtin_amdgcn_rsqf(wave_sum(ss[q]) * (1.f / 1024.f) + 1e-6f);
            if (row < MTOK) { f32x4* orow = (f32x4*)(out + (size_t)row * DM) + lane;
#pragma unroll
                for (int j = 0; j < 4; ++j) orow[64 * j] = v[q][j] * rstd * g[j]; } }
    }
}

#define XB_TMO      128
#define XB_XCNT(j)  (256  + 64 * (j))
#define XB_XSUB(j)  (1280 + 64 * (j))
#define XB_XGEN(j)  (2304 + 64 * (j))
#define XB_TOP      3328
#define XB_TOPGEN   3392
#define XCD_BAR_WORDS 3456
#define XB_SPIN_CAP (1u << 18)
__device__ __forceinline__ unsigned xb_ld(unsigned* p)              { return __hip_atomic_load(p, __ATOMIC_RELAXED, __HIP_MEMORY_SCOPE_AGENT); }
__device__ __forceinline__ unsigned xb_add(unsigned* p, unsigned v) { return __hip_atomic_fetch_add(p, v, __ATOMIC_RELAXED, __HIP_MEMORY_SCOPE_AGENT); }
__device__ __forceinline__ unsigned xb_xcc_id() { return (unsigned)__builtin_amdgcn_s_getreg((3 << 11) | 20) & 0xFu; }
#define XB_SPIN(cond, bar) do { unsigned _sp = 0; while (cond) { __builtin_amdgcn_s_sleep(1); \
    if ((++_sp & 255u) == 0u) { if (xb_ld(&(bar)[XB_TMO])) break; if (_sp > XB_SPIN_CAP) { atomicAdd(&(bar)[XB_TMO], 1u); break; } } } } while (0)
struct XcdBarrier { unsigned* bar; unsigned x; volatile LAS unsigned* st; };
__device__ __forceinline__ XcdBarrier xcd_barrier_post(unsigned* bar, volatile LAS unsigned* st) {
    XcdBarrier b; b.bar = bar; b.x = xb_xcc_id(); b.st = st;
    if (threadIdx.x == 0) (void)xb_add(&bar[XB_XCNT(b.x)], 1u);
    return b;
}
__device__ __forceinline__ void xcd_barrier_complete(unsigned* bar, unsigned x, unsigned& nloc, unsigned& nx) {
    const unsigned G = gridDim.x * gridDim.y * gridDim.z;
    unsigned sum, cnt, mine, sp = 0u;
    for (;;) {
        sum = 0u; cnt = 0u; mine = 0u;
#pragma unroll
        for (unsigned j = 0; j < 16; ++j) { const unsigned c = xb_ld(&bar[XB_XCNT(j)]); sum += c; cnt += (c > 0u) ? 1u : 0u; mine = (j == x) ? c : mine; }
        if (sum == G) break;
        __builtin_amdgcn_s_sleep(1);
        if ((++sp & 255u) == 0u) { if (xb_ld(&bar[XB_TMO])) break; if (sp > XB_SPIN_CAP) { atomicAdd(&bar[XB_TMO], 1u); break; } }
    }
    nloc = mine > 0u ? mine : 1u; nx = cnt > 0u ? cnt : 1u;
}
__device__ __forceinline__ void xcd_barrier(const XcdBarrier& b) {
    asm volatile("s_waitcnt vmcnt(0)" ::: "memory");
    __syncthreads();
    if (threadIdx.x == 0) {
        unsigned* bar = b.bar;
        __builtin_amdgcn_s_waitcnt(0);
        unsigned nloc = b.st[0], nx = b.st[1];
        if (nloc == 0u) { xcd_barrier_complete(bar, b.x, nloc, nx); b.st[0] = nloc; b.st[1] = nx; }
        const unsigned old = xb_add(&bar[XB_XSUB(b.x)], 1u);
        const unsigned gen = old / nloc;
        if (old + 1u == (gen + 1u) * nloc) {
            __builtin_amdgcn_fence(__ATOMIC_RELEASE, "agent");
            asm volatile("s_waitcnt vmcnt(0)" ::: "memory");
            const unsigned og = xb_add(&bar[XB_TOP], 1u);
            const unsigned tg = og / nx;
            if (og + 1u == (tg + 1u) * nx) xb_add(&bar[XB_TOPGEN], 1u);
            else XB_SPIN(xb_ld(&bar[XB_TOPGEN]) == tg, bar);
            __builtin_amdgcn_fence(__ATOMIC_ACQUIRE, "agent");
            xb_add(&bar[XB_XGEN(b.x)], 1u);
            asm volatile("s_waitcnt vmcnt(0)" ::: "memory");
        } else {
            XB_SPIN(xb_ld(&bar[XB_XGEN(b.x)]) == gen, bar);
            __builtin_amdgcn_fence(__ATOMIC_ACQUIRE, "agent");
            asm volatile("s_waitcnt vmcnt(0)" ::: "memory");
        }
    }
    __syncthreads();
}

__global__ void __launch_bounds__(512, 2) fwd_kernel(Args a) {
    extern __shared__ __attribute__((aligned(16))) unsigned char lds_raw[];
    LAS unsigned char* lds = (LAS unsigned char*)lds_raw;
    cg::grid_group grid = cg::this_grid();
    const int tid = threadIdx.x, lane = tid & 63, wave = __builtin_amdgcn_readfirstlane(tid >> 6);
    const int G = gridDim.x, bx = blockIdx.x;
    const int vcu = (G % 8 == 0) ? (bx % 8) * (G / 8) + bx / 8 : bx;
    const int gw = bx * 8 + wave, NGW = G * 8;
    unsigned char* ws = a.ws;
#ifdef PROBE_A0
    unsigned long long tA0 = 0, tA1 = 0, tB0 = 0, tB1 = 0;
#define STAMP(k) do { const unsigned long long _t = __builtin_amdgcn_s_memrealtime(); if ((k) == PROBE_A0) tA0 = _t; if ((k) == PROBE_A1) tA1 = _t; if ((k) == PROBE_B0) tB0 = _t; if ((k) == PROBE_B1) tB1 = _t; } while (0)
#else
#define STAMP(k) do {} while (0)
#endif
    STAMP(0);
    unsigned* barw = (unsigned*)(ws + WS_BAR);
    if (tid < 4) ((volatile LAS unsigned*)(lds + LDS_MISC))[tid] = 0u;
    __syncthreads();
    XcdBarrier xb = xcd_barrier_post(barw, (volatile LAS unsigned*)(lds + LDS_MISC));
    if (a.ws == nullptr) grid.sync();

#define PH(k) (!defined(ONLY) || ONLY == (k))
#if !defined(ONLY) || ONLY == 0
    p0_prologue(a, lds, gw, NGW, wave, lane);
#endif
    STAMP(1);
    xcd_barrier(xb);
    STAMP(2);
#if !defined(ONLY) || ONLY == 1
    p1_hpass(a, lds, G, tid, wave, lane);
#endif
    STAMP(3);
    xcd_barrier(xb);
    STAMP(4);
#if !defined(ONLY) || ONLY == 2
    {
        pg8::Gemm g{(const bf16_t*)(ws + WS_H), (const bf16_t*)(ws + WS_WIN), MTOK, 7168, 1024, (const bf16_t*)(ws + WS_WV), (const bf16_t*)(ws + WS_H)};
        pg8::ChainOrder S; S.init(MTOK, 7168, 1024, MTOK, G, bx);
        EpiProjVT E{EpiProj{(bf16_t*)(ws + WS_XA), (bf16_t*)a.out}, EpiPlain{(bf16_t*)(ws + WS_VT), MTOK}};
        pg8::gemm_phase<EpiProjVT, pg8::ChainOrder, PG8_ALIGN, PG8_SP2>(lds, g, S, E);
    }
    STAMP(5);
    STAMP(6);
#endif
    xcd_barrier(xb);
    STAMP(7);
#if !defined(ONLY) || ONLY == 3
    attn_phase((const bf16_t*)(ws + WS_Q), (const bf16_t*)(ws + WS_K), (const bf16_t*)(ws + WS_VT), (const bf16_t*)(ws + WS_ZB), a.in[18], (bf16_t*)(ws + WS_Q), lds, vcu, G, tid, wave, lane);
#endif
    STAMP(8);
#if !defined(ONLY) || ONLY == 4
    scan_phase<false>(a, lds, gw, NGW, wave, lane);
#endif
    STAMP(9);
    xcd_barrier(xb);
    STAMP(10);
#if !defined(ONLY) || ONLY == 5
    scan_phase<true>(a, lds, gw, NGW, wave, lane);
#endif
    STAMP(11);
    xcd_barrier(xb);
    STAMP(12);
#if !defined(ONLY) || ONLY == 6
    {
        pg8::Gemm g{(const bf16_t*)(ws + WS_H), (const bf16_t*)(ws + WS_WPA), MTOK, 1024, 1024, (const bf16_t*)(ws + WS_Q), (const bf16_t*)(ws + WS_WPB)}; pg8::PairOrder S; S.init(MTOK, 1024, G, bx);
        EpiGate2 E{(const bf16_t*)a.out, (const bf16_t*)a.out + ARR, (bf16_t*)(ws + WS_K), (bf16_t*)(ws + WS_XA)};
        pg8::gemm_phase<EpiGate2, pg8::PairOrder, PG8_ALIGN, PG8_SP2>(lds, g, S, E);
    }
    STAMP(14);
#endif
    xcd_barrier(xb);
    STAMP(15);
#if !defined(ONLY) || ONLY == 7
    {
        pg8::Gemm g{(const bf16_t*)(ws + WS_XA), (const bf16_t*)(ws + WS_WO), MTOK, 1024, 1024}; pg8::StaticOrder S; S.init(MTOK, 1024, G, bx);
        EpiOut E{(const float*)(ws + WS_GATE), (bf16_t*)(ws + WS_ZB)};
        pg8::gemm_phase<EpiOut, pg8::StaticOrder, PG8_ALIGN, PG8_SP2>(lds, g, S, E);
    }
    STAMP(16);
#endif
    xcd_barrier(xb);
    STAMP(17);
#if !defined(ONLY) || ONLY == 8
    final_norm(a, gw, NGW, lane);
#endif
#ifdef PROBE_A0
    STAMP(18);
    if (bx == 0) {
        const float dA = (float)(tA1 - tA0) * 0.01f, dB = (float)(tB1 - tB0) * 0.01f;
        __syncthreads();
        float* orow = a.out + (size_t)wave * DM;
        for (int i = lane; i < DM; i += 64) orow[i] += dB;
        __syncthreads();
        if (tid == 0) a.out[0] += dA;
    }
#endif
}

extern "C" void kernel_launch(void* const* d_in, const int* in_sizes, int n_in, void* d_out, int out_size, void* d_ws, size_t ws_size, hipStream_t stream) {
    static int grid = 0;
    if (grid == 0) {
        if (n_in != 23 || out_size != MTOK * DM || ws_size < 256 * MiB) { fprintf(stderr, "kernel_launch: unexpected problem shape (n_in %d, out %d, ws %zu)\n", n_in, out_size, ws_size); grid = -1; return; }
        int dev = 0, cus = 0, per_cu = 0;
        (void)hipGetDevice(&dev);
        (void)hipDeviceGetAttribute(&cus, hipDeviceAttributeMultiprocessorCount, dev);
        if (hipFuncSetAttribute((const void*)fwd_kernel, hipFuncAttributeMaxDynamicSharedMemorySize, LDS_BYTES) != hipSuccess) { fprintf(stderr, "kernel_launch: hipFuncSetAttribute failed\n"); grid = -1; return; }
        if (hipOccupancyMaxActiveBlocksPerMultiprocessor(&per_cu, (const void*)fwd_kernel, 512, LDS_BYTES) != hipSuccess || per_cu < 1) { fprintf(stderr, "kernel_launch: occupancy query failed (%d)\n", per_cu); per_cu = 1; (void)hipGetLastError(); }
        grid = cus * per_cu;
        if (grid <= 0) { grid = -1; return; }
    }
    if (grid < 0) return;
    Args a{};
    for (int i = 0; i < 23; ++i) a.in[i] = (const float*)d_in[i];
    a.out = (float*)d_out; a.ws = (unsigned char*)d_ws;
    void* args[] = {&a};
    if (hipMemsetAsync((unsigned char*)d_ws + WS_BAR, 0, XCD_BAR_WORDS * 4, stream) != hipSuccess) { fprintf(stderr, "kernel_launch: memset of the barrier words failed\n"); return; }
    hipError_t e = hipLaunchCooperativeKernel((const void*)fwd_kernel, dim3(grid), dim3(512), args, LDS_BYTES, stream);
    if (e != hipSuccess) fprintf(stderr, "kernel_launch: cooperative launch failed: %s (grid %d)\n", hipGetErrorString(e), grid);
}
```
